# Optimizing an MI355X kernel written in HIP

```python
import math
import jax, jax.numpy as jnp
from jax import lax
import numpy as np

D_MODEL = 2048
BATCH = 2
SEQ = 4096
DEPTH = 2

GRID_W = 64
CTX_LEN = 256
HEAD_DIM = 128
N_HEADS_NA = 6
N_HEADS_MLA = 5
N_HEADS_DIFF = 5
NA_KH = 8
NA_KW = 16
MLA_Q_RANK = 768
MLA_KV_RANK = 512
MLA_NOPE_DIM = 128
MLA_ROPE_DIM = 64
MLA_V_DIM = 128
DIFF_QK_DIM = HEAD_DIM // 2
FFN_DIM = 5632
N_MOD = 9
ROPE_THETA = 10000.0
NORM_EPS = 1e-6
Q_BLOCK = 128
NEG_INF = -1e30
NA_W = N_HEADS_NA * HEAD_DIM
MLA_W = N_HEADS_MLA * MLA_V_DIM
DIFF_W = N_HEADS_DIFF * HEAD_DIM
MIX_W = NA_W + MLA_W + DIFF_W
IN_SPLITS = (NA_W, NA_W, NA_W, MLA_Q_RANK, MLA_KV_RANK, MLA_ROPE_DIM, DIFF_W, DIFF_W, DIFF_W, D_MODEL, D_MODEL, D_MODEL)
IN_W = sum(IN_SPLITS)
NA_SCALE = HEAD_DIM ** -0.5
MLA_SCALE = (MLA_NOPE_DIM + MLA_ROPE_DIM) ** -0.5
DIFF_SCALE = DIFF_QK_DIM ** -0.5

kernel_name = "hybrid_dit_na_mla_diffattn_macaron"


def rmsnorm(x, g):
    xf = x.astype(jnp.float32)
    y = xf * lax.rsqrt(jnp.mean(xf * xf, axis=-1, keepdims=True) + NORM_EPS)
    return (y * g.astype(jnp.float32)).astype(x.dtype)


def modulate(x, g, shift, scale):
    return rmsnorm(x, g) * (1 + scale) + shift


def swiglu(h, w_in, w_out):
    a, b = jnp.split(h @ w_in, 2, axis=-1)
    return (jax.nn.silu(a) * b) @ w_out


def split_cols(p, sizes):
    return jnp.split(p, [int(i) for i in np.cumsum(sizes)[:-1]], axis=-1)


def to_heads(t, n_heads):
    return t.reshape(*t.shape[:2], n_heads, -1)


def rope_2d(x, rows, cols):
    half = x.shape[-1] // 2
    quarter = half // 2
    freqs = ROPE_THETA ** (-jnp.arange(quarter, dtype=jnp.float32) / quarter)

    def rotate(xp, pos):
        ang = pos.astype(jnp.float32)[:, None] * freqs
        cos = jnp.cos(ang)[:, None, :].astype(xp.dtype)
        sin = jnp.sin(ang)[:, None, :].astype(xp.dtype)
        x1, x2 = xp[..., :quarter], xp[..., quarter:]
        return jnp.concatenate([x1 * cos - x2 * sin, x1 * sin + x2 * cos], axis=-1)

    return jnp.concatenate([rotate(x[..., :half], rows), rotate(x[..., half:], cols)], axis=-1)


def scores(q, k, scale):
    return jnp.einsum('bqhd,bkhd->bhqk', q, k).astype(jnp.float32) * scale


def attend(q, k, v, scale):
    p = jax.nn.softmax(scores(q, k, scale), axis=-1).astype(v.dtype)
    return jnp.einsum('bhqk,bkhd->bqhd', p, v)


def diff_attend(q1, q2, k1, k2, v, lam, subln, lambda_init):
    p1 = jax.nn.softmax(scores(q1, k1, DIFF_SCALE), axis=-1)
    p2 = jax.nn.softmax(scores(q2, k2, DIFF_SCALE), axis=-1)
    o = jnp.einsum('bhqk,bkhd->bqhd', (p1 - lam * p2).astype(v.dtype), v)
    return rmsnorm(o, subln) * (1.0 - lambda_init)


def sweep_query_blocks(fn, *qs):
    B, S = qs[0].shape[:2]
    nb = S // Q_BLOCK
    blocks = tuple(jnp.moveaxis(q.reshape(B, nb, Q_BLOCK, *q.shape[2:]), 1, 0) for q in qs)
    out = lax.map(lambda xs: fn(*xs), blocks)
    out = jnp.moveaxis(out, 0, 1)
    return out.reshape(B, S, *out.shape[3:])


def neighbourhood_attention(q, k, v, k_ctx, v_ctx, rpb):
    B, S, H, Dh = q.shape
    rows_n = S // GRID_W
    kh = min(NA_KH, rows_n)
    kw = NA_KW
    r = jnp.arange(rows_n)
    col = jnp.arange(GRID_W)
    r0 = jnp.clip(r - kh // 2, 0, rows_n - kh)
    row_idx = r0[:, None] + jnp.arange(kh)[None, :]
    c0 = jnp.clip(col - kw // 2, 0, GRID_W - kw)
    col_ok = (col[None, :] >= c0[:, None]) & (col[None, :] < c0[:, None] + kw)
    grid = lambda t: t.reshape(B, rows_n, GRID_W, H, Dh)
    qg = grid(q)
    kg = jnp.take(grid(k), row_idx.reshape(-1), axis=1).reshape(B, rows_n, kh, GRID_W, H, Dh)
    vg = jnp.take(grid(v), row_idx.reshape(-1), axis=1).reshape(B, rows_n, kh, GRID_W, H, Dh)
    s_loc = jnp.einsum('brqhd,brjkhd->bhrqjk', qg, kg).astype(jnp.float32) * NA_SCALE
    row_off = row_idx - r[:, None] + (NA_KH - 1)
    col_off = jnp.clip(col[None, :] - col[:, None], -(NA_KW - 1), NA_KW - 1) + (NA_KW - 1)
    bias = rpb[:, row_off[:, None, :, None], col_off[None, :, None, :]]
    s_loc = jnp.where(col_ok[:, None, :], s_loc + bias.astype(jnp.float32), NEG_INF)
    n_loc = kh * GRID_W
    s_loc = s_loc.reshape(B, H, rows_n, GRID_W, n_loc)
    s_ctx = jnp.einsum('brqhd,bkhd->bhrqk', qg, k_ctx).astype(jnp.float32) * NA_SCALE
    p = jax.nn.softmax(jnp.concatenate([s_loc, s_ctx], axis=-1), axis=-1).astype(v.dtype)
    p_loc = p[..., :n_loc].reshape(B, H, rows_n, GRID_W, kh, GRID_W)
    o = (jnp.einsum('bhrqjk,brjkhd->brqhd', p_loc, vg)
         + jnp.einsum('bhrqk,bkhd->brqhd', p[..., n_loc:], v_ctx))
    return o.reshape(B, S, H * Dh)


def token_mixer(h, hc, w_in, na_rpb, mla_q_norm, mla_kv_norm, mla_w_uq, mla_w_ukv,
                diff_lambda, diff_subln, w_branch, w_out, lambda_init, rows, cols, with_ctx_out):
    p = split_cols(h @ w_in, IN_SPLITS)
    pc = split_cols(hc @ w_in, IN_SPLITS)

    na_q, na_k, na_v = (to_heads(t, N_HEADS_NA) for t in p[0:3])
    na_qc, na_kc, na_vc = (to_heads(t, N_HEADS_NA) for t in pc[0:3])
    o_na = neighbourhood_attention(na_q, na_k, na_v, na_kc, na_vc, na_rpb)

    def mla_queries(cq):
        return to_heads(rmsnorm(cq, mla_q_norm) @ mla_w_uq, N_HEADS_MLA)

    def mla_keys_values(ckv, k_pe):
        kv = to_heads(rmsnorm(ckv, mla_kv_norm) @ mla_w_ukv, N_HEADS_MLA)
        k_nope, v = kv[..., :MLA_NOPE_DIM], kv[..., MLA_NOPE_DIM:]
        k_pe = jnp.broadcast_to(k_pe, k_nope.shape[:-1] + (MLA_ROPE_DIM,))
        return jnp.concatenate([k_nope, k_pe], axis=-1), v

    mq = mla_queries(p[3])
    mq = jnp.concatenate([mq[..., :MLA_NOPE_DIM], rope_2d(mq[..., MLA_NOPE_DIM:], rows, cols)], axis=-1)
    mk, mv = mla_keys_values(p[4], rope_2d(p[5][:, :, None, :], rows, cols))
    mkc, mvc = mla_keys_values(pc[4], pc[5][:, :, None, :])
    mk_all = jnp.concatenate([mkc, mk], axis=1)
    mv_all = jnp.concatenate([mvc, mv], axis=1)
    o_mla = sweep_query_blocks(lambda qb: attend(qb, mk_all, mv_all, MLA_SCALE), mq)

    lam = (jnp.exp(jnp.sum(diff_lambda[0] * diff_lambda[1]))
           - jnp.exp(jnp.sum(diff_lambda[2] * diff_lambda[3])) + lambda_init)
    dq, dk, dv = (to_heads(t, N_HEADS_DIFF) for t in p[6:9])
    dqc, dkc, dvc = (to_heads(t, N_HEADS_DIFF) for t in pc[6:9])
    halves = lambda t: (t[..., :DIFF_QK_DIM], t[..., DIFF_QK_DIM:])
    rot = lambda t: rope_2d(t, rows, cols)
    dq1, dq2 = (rot(t) for t in halves(dq))
    dk1, dk2 = (rot(t) for t in halves(dk))
    dk1c, dk2c = halves(dkc)
    dk1_all = jnp.concatenate([dk1c, dk1], axis=1)
    dk2_all = jnp.concatenate([dk2c, dk2], axis=1)
    dv_all = jnp.concatenate([dvc, dv], axis=1)
    o_diff = sweep_query_blocks(
        lambda q1b, q2b: diff_attend(q1b, q2b, dk1_all, dk2_all, dv_all, lam, diff_subln, lambda_init),
        dq1, dq2)

    def merge(a, b, d, g_a, g_b, g_d):
        flat = lambda t: t.reshape(*t.shape[:2], -1)
        y = (jax.nn.sigmoid(g_a) * (flat(a) @ w_branch[:NA_W])
             + jax.nn.sigmoid(g_b) * (flat(b) @ w_branch[NA_W:NA_W + MLA_W])
             + jax.nn.sigmoid(g_d) * (flat(d) @ w_branch[NA_W + MLA_W:]))
        return y @ w_out

    out = merge(o_na, o_mla, o_diff, p[9], p[10], p[11])
    if not with_ctx_out:
        return out, None
    dq1c, dq2c = halves(dqc)
    oc = merge(attend(na_qc, na_kc, na_vc, NA_SCALE),
               attend(mla_queries(pc[3]), mkc, mvc, MLA_SCALE),
               diff_attend(dq1c, dq2c, dk1c, dk2c, dvc, lam, diff_subln, lambda_init),
               pc[9], pc[10], pc[11])
    return out, oc


def setup_inputs(seed: int = 0) -> dict:
    key = jax.random.key(seed)
    ks = jax.random.split(key, 20)
    nrm = lambda k, shape: jax.random.normal(k, shape, jnp.float32)
    w = lambda k, shape, fan_in, gain=1.0: nrm(k, shape) * (gain * fan_in ** -0.5)
    gn = lambda k, shape: 1.0 + 0.1 * nrm(k, shape)
    return {
        "x": nrm(ks[0], (BATCH, SEQ, D_MODEL)),
        "c": nrm(ks[1], (BATCH, D_MODEL)),
        "ctx": nrm(ks[2], (BATCH, CTX_LEN, D_MODEL)),
        "c_ctx": nrm(ks[3], (D_MODEL,)),
        "w_ada": w(ks[4], (DEPTH, D_MODEL, N_MOD * D_MODEL), D_MODEL, 0.5),
        "b_ada": 0.02 * nrm(ks[5], (DEPTH, N_MOD * D_MODEL)),
        "norm_w": gn(ks[6], (DEPTH, 3, D_MODEL)),
        "ffn_w_in": w(ks[7], (DEPTH, 2, D_MODEL, 2 * FFN_DIM), D_MODEL),
        "ffn_w_out": w(ks[8], (DEPTH, 2, FFN_DIM, D_MODEL), FFN_DIM),
        "w_in": w(ks[9], (DEPTH, D_MODEL, IN_W), D_MODEL),
        "na_rpb": 0.1 * nrm(ks[10], (DEPTH, N_HEADS_NA, 2 * NA_KH - 1, 2 * NA_KW - 1)),
        "mla_q_norm": gn(ks[11], (DEPTH, MLA_Q_RANK)),
        "mla_kv_norm": gn(ks[12], (DEPTH, MLA_KV_RANK)),
        "mla_w_uq": w(ks[13], (DEPTH, MLA_Q_RANK, N_HEADS_MLA * (MLA_NOPE_DIM + MLA_ROPE_DIM)), MLA_Q_RANK),
        "mla_w_ukv": w(ks[14], (DEPTH, MLA_KV_RANK, N_HEADS_MLA * (MLA_NOPE_DIM + MLA_V_DIM)), MLA_KV_RANK),
        "diff_lambda": 0.1 * nrm(ks[15], (DEPTH, 4, DIFF_QK_DIM)),
        "diff_subln": gn(ks[16], (DEPTH, HEAD_DIM)),
        "w_branch": w(ks[17], (DEPTH, MIX_W, D_MODEL), MIX_W),
        "w_out": w(ks[18], (DEPTH, D_MODEL, D_MODEL), D_MODEL),
        "final_norm": gn(ks[19], (D_MODEL,)),
    }


def reference(x, c, ctx, c_ctx, w_ada, b_ada, norm_w, ffn_w_in, ffn_w_out, w_in, na_rpb,
              mla_q_norm, mla_kv_norm, mla_w_uq, mla_w_ukv, diff_lambda, diff_subln,
              w_branch, w_out, final_norm):
    S = x.shape[1]
    t = jnp.arange(S)
    rows, cols = t // GRID_W, t % GRID_W
    xc = ctx
    for l in range(DEPTH):
        last = l == DEPTH - 1
        lambda_init = 0.8 - 0.6 * math.exp(-0.3 * l)
        m = [mm[:, None, :] for mm in jnp.split(jax.nn.silu(c) @ w_ada[l] + b_ada[l], N_MOD, axis=-1)]
        mc = jnp.split(jax.nn.silu(c_ctx) @ w_ada[l] + b_ada[l], N_MOD, axis=-1)
        x = x + 0.5 * m[2] * swiglu(modulate(x, norm_w[l, 0], m[0], m[1]), ffn_w_in[l, 0], ffn_w_out[l, 0])
        xc = xc + 0.5 * mc[2] * swiglu(modulate(xc, norm_w[l, 0], mc[0], mc[1]), ffn_w_in[l, 0], ffn_w_out[l, 0])
        o, oc = token_mixer(modulate(x, norm_w[l, 1], m[3], m[4]), modulate(xc, norm_w[l, 1], mc[3], mc[4]),
                            w_in[l], na_rpb[l], mla_q_norm[l], mla_kv_norm[l], mla_w_uq[l], mla_w_ukv[l],
                            diff_lambda[l], diff_subln[l], w_branch[l], w_out[l], lambda_init, rows, cols,
                            not last)
        x = x + m[5] * o
        x = x + 0.5 * m[8] * swiglu(modulate(x, norm_w[l, 2], m[6], m[7]), ffn_w_in[l, 1], ffn_w_out[l, 1])
        if not last:
            xc = xc + mc[5] * oc
            xc = xc + 0.5 * mc[8] * swiglu(modulate(xc, norm_w[l, 2], mc[6], mc[7]), ffn_w_in[l, 1], ffn_w_out[l, 1])
    return rmsnorm(x, final_norm)
```

```cpp
#include <hip/hip_runtime.h>
#include <cstdio>
#include <cstdint>

#define GAS __attribute__((address_space(1)))
#define LAS __attribute__((address_space(3)))
typedef unsigned short bf16_t;
typedef short bf16x8 __attribute__((ext_vector_type(8)));
typedef float f32x4 __attribute__((ext_vector_type(4)));
typedef float f32x2 __attribute__((ext_vector_type(2)));
typedef unsigned u32x4 __attribute__((ext_vector_type(4)));
typedef unsigned u32x2 __attribute__((ext_vector_type(2)));

constexpr int D = 2048, NBATCH = 2, SEQ = 4096, DEPTH = 2, CTXL = 256, FF = 5632, NMOD = 9, GRIDW = 64;
constexpr int ML = NBATCH * SEQ;
constexpr int MC = NBATCH * CTXL;
constexpr int M = ML + MC;
constexpr int INW = 11712, MODLD = NMOD * D;
constexpr int NA_W = 768, MLA_W = 640, DF_W = 640, QRANK = 768, KVRANK = 512;
constexpr int H_NA = 6, H_MLA = 5, H_DF = 5;
constexpr float NORM_EPS = 1e-6f, LOG2E = 1.4426950408889634f;
constexpr float NA_SCALE = 0.08838834764831845f, MLA_SCALE = 0.07216878364870322f, DF_SCALE = 0.125f;
constexpr int NWAVES = 8, NTHREADS = 512;
constexpr int LDH = D + 64;
constexpr int LDX = D + 32;

constexpr size_t al256(size_t x) { return (x + 255) & ~(size_t)255; }
constexpr size_t WS_CTL = 0, CTL_ZERO_BYTES = 1u << 20;
constexpr int CW_TMO = 0, CW_AQ = 1024, CW_BAR = 4096, CW_WCV = 8192;
constexpr size_t WS_MOD = 65536;
constexpr size_t WS_SSQ = 524288;
constexpr int NFUSE = 3 * DEPTH;
constexpr size_t WS_SSQX = WS_SSQ + (size_t)DEPTH * 2 * M * 4;
constexpr size_t WS_PCNT = WS_SSQX + (size_t)NFUSE * ML * 4;
static_assert(WS_MOD + (size_t)DEPTH * 3 * MODLD * 4 <= WS_SSQ && WS_SSQX % 256 == 0 && WS_PCNT % 256 == 0 && WS_PCNT + (size_t)NFUSE * 32 * 256 <= CTL_ZERO_BYTES, "ctl map");
constexpr size_t WS_ROPE = CTL_ZERO_BYTES;
constexpr size_t WS_XS   = WS_ROPE + 8192;
constexpr size_t WS_H    = WS_XS   + al256((size_t)M * LDX * 4);
constexpr size_t WS_U    = WS_H    + al256((size_t)M * LDH * 2);
constexpr size_t WS_NAQ  = WS_U    + al256((size_t)M * FF * 2);
constexpr size_t WS_NAK  = WS_NAQ  + al256((size_t)M * 768 * 2);
constexpr size_t WS_CQ   = WS_NAK  + al256((size_t)M * 768 * 2);
constexpr size_t WS_CKV  = WS_CQ   + al256((size_t)M * 768 * 2);
constexpr size_t WS_DQ   = WS_CKV  + al256((size_t)M * 512 * 2);
constexpr size_t WS_DK   = WS_DQ   + al256((size_t)M * 640 * 2);
constexpr size_t WS_G    = WS_DK   + al256((size_t)M * 640 * 2);
constexpr size_t WS_VTIN = WS_G    + al256((size_t)M * 6144 * 2);
constexpr size_t WS_MQ   = WS_VTIN + al256((size_t)1536 * M * 2);
constexpr size_t WS_MK   = WS_MQ   + al256((size_t)M * 1024 * 2);
constexpr size_t WS_VTM  = WS_MK   + al256((size_t)M * 960 * 2);
constexpr size_t WS_OMIX = WS_VTM  + al256((size_t)768 * M * 2);
constexpr size_t WS_YF   = WS_OMIX + al256((size_t)M * D * 2);
constexpr size_t WS_Y    = WS_YF   + al256((size_t)M * LDX * 4);
constexpr size_t WS_WFI  = WS_Y    + al256((size_t)M * D * 2);
constexpr size_t WFI_SZ = (size_t)2 * FF * D * 2, WFO_SZ = (size_t)D * FF * 2, WIN_ROWS = 10496, WIN_SZ = WIN_ROWS * D * 2, WVT_SZ = (size_t)1536 * D * 2;
constexpr size_t WUQ_SZ = (size_t)1024 * 768 * 2, WUK_SZ = (size_t)768 * 512 * 2, WSQ_SZ = (size_t)D * D * 2;
constexpr size_t WS_WFO  = WS_WFI + 4 * WFI_SZ;
constexpr size_t WS_WIN  = WS_WFO + 4 * WFO_SZ;
constexpr size_t WS_WVT  = WS_WIN + 2 * WIN_SZ;
constexpr size_t WS_WUQ  = WS_WVT + 2 * WVT_SZ;
constexpr size_t WS_WUK  = WS_WUQ + 2 * WUQ_SZ;
constexpr size_t WS_WUV  = WS_WUK + 2 * WUK_SZ;
constexpr size_t WS_WBR  = WS_WUV + 2 * WUK_SZ;
constexpr size_t WS_WO   = WS_WBR + 2 * WSQ_SZ;
constexpr size_t WS_PART = WS_WO  + 2 * WSQ_SZ;
constexpr int LDXH = D + 64, LDXL = D + 128;
constexpr size_t WS_XH   = WS_PART + (size_t)11 * MC * LDX * 4;
constexpr size_t WS_XL   = WS_XH + (size_t)ML * LDXH * 2;
constexpr size_t WS_END  = WS_XL + (size_t)ML * LDXL;

constexpr int RING_OFF = 0, RING_BYTES = 131072;
constexpr int LDSCTL_OFF = RING_BYTES, MISC_OFF = LDSCTL_OFF + 320;
constexpr int ROPE_LDS = LDSCTL_OFF + 1024;
constexpr int LDS_BYTES = 147456;

typedef GAS unsigned gu32;
#define RLX_AGENT __ATOMIC_RELAXED, __HIP_MEMORY_SCOPE_AGENT
#define LDS_WAIT() asm volatile("s_waitcnt lgkmcnt(0)" ::: "memory")
#define VM_WAIT() asm volatile("s_waitcnt vmcnt(0)" ::: "memory")
__device__ __forceinline__ unsigned f2bf(float f) { unsigned u = __builtin_bit_cast(unsigned, f); return (u + 0x7fffu + ((u >> 16) & 1u)) >> 16; }
__device__ __forceinline__ unsigned pk2(float lo, float hi) { return f2bf(lo) | (f2bf(hi) << 16); }
__device__ __forceinline__ float bf2f(unsigned short b) { return __builtin_bit_cast(float, ((unsigned)b) << 16); }
__device__ __forceinline__ float bflo(unsigned w) { return __builtin_bit_cast(float, w << 16); }
__device__ __forceinline__ float bfhi(unsigned w) { return __builtin_bit_cast(float, w & 0xffff0000u); }
__device__ __forceinline__ unsigned cvt_pk_bf16(float lo, float hi) { unsigned r; asm volatile("v_cvt_pk_bf16_f32 %0, %1, %2" : "=v"(r) : "v"(lo), "v"(hi)); return r; }
template <int X> __device__ __forceinline__ float xor_lane(float v) {
    static_assert(X == 1 || X == 2 || X == 4 || X == 8 || X == 16, "xor_lane: within a 32-lane half (ds_swizzle bit mode)");
    return __builtin_bit_cast(float, __builtin_amdgcn_ds_swizzle(__builtin_bit_cast(int, v), (X << 10) | 0x1F));
}
__device__ __forceinline__ float half_sum(float v) { const unsigned u = __builtin_bit_cast(unsigned, v); auto rr = __builtin_amdgcn_permlane32_swap(u, u, false, false); return __builtin_bit_cast(float, (unsigned)rr[0]) + __builtin_bit_cast(float, (unsigned)rr[1]); }
__device__ __forceinline__ float half_max(float v) { const unsigned u = __builtin_bit_cast(unsigned, v); auto rr = __builtin_amdgcn_permlane32_swap(u, u, false, false); return fmaxf(__builtin_bit_cast(float, (unsigned)rr[0]), __builtin_bit_cast(float, (unsigned)rr[1])); }
__device__ __forceinline__ float wave_sum(float v) {
    v += xor_lane<1>(v); v += xor_lane<2>(v); v += xor_lane<4>(v); v += xor_lane<8>(v); v += xor_lane<16>(v); return half_sum(v);
}
__device__ __forceinline__ float wave_max(float v) {
    v = fmaxf(v, xor_lane<1>(v)); v = fmaxf(v, xor_lane<2>(v)); v = fmaxf(v, xor_lane<4>(v)); v = fmaxf(v, xor_lane<8>(v)); v = fmaxf(v, xor_lane<16>(v)); return half_max(v);
}
__device__ __forceinline__ float fast_exp2(float x) { return __builtin_amdgcn_exp2f(x); }
__device__ __forceinline__ float fast_rcp(float x) { return __builtin_amdgcn_rcpf(x); }
__device__ __forceinline__ float silu_f(float a) { return a * fast_rcp(1.0f + fast_exp2(-a * LOG2E)); }
__device__ __forceinline__ float sigmoid_f(float a) { return fast_rcp(1.0f + fast_exp2(-a * LOG2E)); }
__device__ __forceinline__ void atomic_add_f32(float* p, float v) { unsafeAtomicAdd(p, v); }
__device__ __forceinline__ int opaque_v(int x) { asm volatile("" : "+v"(x)); return x; }
__device__ __forceinline__ int opaque_s(int x) { asm volatile("" : "+s"(x)); return x; }
__device__ __forceinline__ int lane_id() { int r; asm volatile("v_mbcnt_lo_u32_b32 %0, -1, 0\n\tv_mbcnt_hi_u32_b32 %0, -1, %0" : "=v"(r)); return r; }
__device__ __forceinline__ int tid_of(int wave) { return wave * 64 + lane_id(); }
#define XB_TMO      128
#define XB_XCNT(j)  (256  + 64 * (j))
#define XB_XSUB(j)  (1280 + 64 * (j))
#define XB_XGEN(j)  (2304 + 64 * (j))
#define XB_TOP      3328
#define XB_TOPGEN   3392
#define XCD_BAR_WORDS 3456
#define XB_SPIN_CAP (1u << 23)

__device__ __forceinline__ unsigned xb_ld(unsigned* p)              { return __hip_atomic_load(p, __ATOMIC_RELAXED, __HIP_MEMORY_SCOPE_AGENT); }
__device__ __forceinline__ unsigned xb_add(unsigned* p, unsigned v) { return __hip_atomic_fetch_add(p, v, __ATOMIC_RELAXED, __HIP_MEMORY_SCOPE_AGENT); }
__device__ __forceinline__ unsigned xb_xcc_id() { return (unsigned)__builtin_amdgcn_s_getreg((3 << 11) | 20) & 0xFu; }
#define XB_SPIN(cond, bar) do { unsigned _sp = 0; while (cond) { __builtin_amdgcn_s_sleep(1); \
    if ((++_sp & 255u) == 0u) { if (xb_ld(&(bar)[XB_TMO])) break; if (_sp > XB_SPIN_CAP) { atomicAdd(&(bar)[XB_TMO], 1u); break; } } } } while (0)

struct XcdBarrier {
    unsigned* bar; unsigned x; int wave;
    volatile LAS unsigned* st;
};

__device__ __forceinline__ XcdBarrier xcd_barrier_post(unsigned* bar, volatile LAS unsigned* st, int wave) {
    XcdBarrier b; b.bar = bar; b.x = xb_xcc_id(); b.st = st; b.wave = wave;
    if (threadIdx.x == 0) (void)xb_add(&bar[XB_XCNT(b.x)], 1u);
    return b;
}
__device__ __forceinline__ void xcd_barrier_complete(unsigned* bar, unsigned x, unsigned& nloc, unsigned& nx) {
    const unsigned G = gridDim.x * gridDim.y * gridDim.z;
    unsigned sum, cnt, mine, sp = 0u;
    for (;;) {
        sum = 0u; cnt = 0u; mine = 0u;
#pragma unroll
        for (unsigned j = 0; j < 16; ++j) { const unsigned c = xb_ld(&bar[XB_XCNT(j)]); sum += c; cnt += (c > 0u) ? 1u : 0u; mine = (j == x) ? c : mine; }
        if (sum == G) break;
        __builtin_amdgcn_s_sleep(1);
        if ((++sp & 255u) == 0u) { if (xb_ld(&bar[XB_TMO])) break; if (sp > XB_SPIN_CAP) { atomicAdd(&bar[XB_TMO], 1u); break; } }
    }
    nloc = mine > 0u ? mine : 1u; nx = cnt > 0u ? cnt : 1u;
}

__device__ __forceinline__ void xcd_barrier(const XcdBarrier& b) {
    asm volatile("s_waitcnt vmcnt(0)" ::: "memory");
    __syncthreads();
    if (b.wave == 0 && lane_id() == 0) {
        unsigned* bar = b.bar;
        __builtin_amdgcn_s_waitcnt(0);
        unsigned nloc = b.st[0], nx = b.st[1];
        if (nloc == 0u) { xcd_barrier_complete(bar, b.x, nloc, nx); b.st[0] = nloc; b.st[1] = nx; }
        const unsigned old = xb_add(&bar[XB_XSUB(b.x)], 1u);
        const unsigned gen = old / nloc;
        if (old + 1u == (gen + 1u) * nloc) {
            __builtin_amdgcn_fence(__ATOMIC_RELEASE, "agent");
            asm volatile("s_waitcnt vmcnt(0)" ::: "memory");
            const unsigned og = xb_add(&bar[XB_TOP], 1u);
            const unsigned tg = og / nx;
            if (og + 1u == (tg + 1u) * nx) xb_add(&bar[XB_TOPGEN], 1u);
            else XB_SPIN(xb_ld(&bar[XB_TOPGEN]) == tg, bar);
            __builtin_amdgcn_fence(__ATOMIC_ACQUIRE, "agent");
            xb_add(&bar[XB_XGEN(b.x)], 1u);
            asm volatile("s_waitcnt vmcnt(0)" ::: "memory");
        } else {
            XB_SPIN(xb_ld(&bar[XB_XGEN(b.x)]) == gen, bar);
            __builtin_amdgcn_fence(__ATOMIC_ACQUIRE, "agent");
            asm volatile("s_waitcnt vmcnt(0)" ::: "memory");
        }
    }
    __syncthreads();
}

#ifndef MERGE_CTX_ATOMIC
#define MERGE_CTX_ATOMIC 1
#endif
namespace pg8 {
constexpr int BM = 256, BK = 64, HALF = 128, HTB = HALF * BK * 2, STAGE_BYTES = 8 * HTB, NXCD = 8, WGM = 8;
__host__ __device__ __forceinline__ int lds_byte(int r, int c) { const int st = (r >> 4) * 2 + (c >> 5), rr = r & 15, cc = c & 31, ob = rr * 64 + cc * 2; return st * 1024 + (ob ^ (((ob >> 9) & 1) << 5)); }
__host__ __device__ __forceinline__ void stage_rc(int b, int& R, int& C) { const int st = b / 1024, sb = b % 1024, swz = sb ^ (((sb >> 9) & 1) << 5); R = (st >> 1) * 16 + swz / 64; C = (st & 1) * 32 + (swz % 64) / 2; }
__host__ __device__ __forceinline__ int perm32(int rho) { const int n = rho >> 4, i = rho & 15; return 8 * (i >> 2) + 4 * n + (i & 3); }

struct Unit { int pm, pn, kofs, nkt, aux; };
struct Gemm { const bf16_t* A; const bf16_t* Bt; };

struct SegSched {
    int n, nM, nN, G, first, kofs, nkt, lim;
    __device__ __forceinline__ void init(int lo, int nM_, int nN_, int G_, int c, int kofs_, int nkt_) {
        nM = nM_; nN = nN_; n = nM * nN; G = G_; kofs = kofs_; nkt = nkt_; lim = n;
        int f = (c - lo) % G; if (f < 0) f += G; first = f;
    }
    __device__ __forceinline__ bool next(int i, Unit& u) const {
        const long L = (long)first + (long)i * G; if (L >= lim) return false;
        int wgid = (int)L; { const int q = n / NXCD, r = n % NXCD, xcd = wgid % NXCD, off = wgid / NXCD; wgid = (xcd < r ? xcd * (q + 1) : r * (q + 1) + (xcd - r) * q) + off; }
        const int nig = WGM * nN, gid = wgid / nig, fm = gid * WGM, gsz = (nM - fm) < WGM ? (nM - fm) : WGM;
        u.pm = fm + ((wgid % nig) % gsz); u.pn = (wgid % nig) / gsz; u.kofs = kofs; u.nkt = nkt; u.aux = 0; return true;
    }
};
template <int NSPLIT, int KCHUNK> struct ResidSched {
    SegSched lat; int G, c, nctx;
    __device__ __forceinline__ void init(int nN, int G_, int c_, int nkt_full, bool with_ctx) { lat.init(0, 32, nN, G_, c_, 0, nkt_full); G = G_; c = c_; nctx = with_ctx ? 2 * nN * NSPLIT : 0; }
    __device__ __forceinline__ bool next(int i, Unit& u) const {
        const long L = (long)c + (long)i * G;
        if (L < lat.n) return lat.next(i, u);
        const int x = (int)(L - lat.n); if (x >= nctx) return false;
        const int t = x / NSPLIT, ks = x - t * NSPLIT;
        u.pm = 32 + (t >> 3); u.pn = t & 7; u.kofs = ks * KCHUNK;        u.nkt = KCHUNK / BK; u.aux = 1 + ks; return true;
    }
};
struct InProjSched {
    SegSched a; int G, c, nctx;
    __device__ __forceinline__ void init(bool last, int G_, int c_) { a.init(0, last ? 32 : 34, 41, G_, c_, 0, 32); G = G_; c = c_; nctx = last ? 18 : 0; }
    __device__ __forceinline__ int total() const { return a.n + nctx; }
    __device__ __forceinline__ bool next(int i, Unit& u) const {
        const long L = (long)c + (long)i * G;
        if (L < a.n) return a.next(i, u);
        const int x = (int)(L - a.n); if (x >= nctx) return false;
        const int p = x / 9, j = x - 9 * p;
        u.pm = 32 + p; u.pn = j < 3 ? 3 + j : (j < 5 ? 6 + j : 8 + j); u.kofs = 0; u.nkt = 32; u.aux = 0; return true;
    }
};
struct MergeSched {
    SegSched s; int G, c, ntl, nctx;
    __device__ __forceinline__ void init(int G_, int c_, bool with_ctx) {
#if MERGE_CTX_ATOMIC
        s.init(0, 32, 8, G_, c_, 0, 0); G = G_; c = c_; ntl = c_ < 256 ? (256 - c_ + G_ - 1) / G_ : 0; nctx = with_ctx ? 48 : 0;
#else
        const int nt_ = with_ctx ? 272 : 256; s.init(0, with_ctx ? 34 : 32, 8, G_, c_, 0, 0); G = G_; c = c_; ntl = c_ < nt_ ? (nt_ - c_ + G_ - 1) / G_ : 0; nctx = 0;
#endif
    }
    __device__ __forceinline__ bool next(int i, Unit& u) const {
        int br;
        if (i < 3 * ntl) { const int t = i / 3; br = i - 3 * t; if (!s.next(t, u)) return false; u.aux = br; }
        else { const int x = c + (i - 3 * ntl) * G; if (x >= nctx) return false; const int t = x / 3; br = x - 3 * t; u.pm = 32 + (t >> 3); u.pn = t & 7; u.aux = 4 + br; }
        u.kofs = br == 0 ? 0 : (br == 1 ? 768 : 1408); u.nkt = br == 0 ? 12 : 10; return true;
    }
};

template <class Epi, class Sched, int LDA, int LDB, bool ALIGN_EPI = true>
__device__ __forceinline__ void gemm_phase(LAS unsigned char* lds, const Gemm g, const Sched& S, const Epi& E, int wave) {
    const int tid = tid_of(wave), wid = wave, lane = tid & 63, wr = wid >> 2, wc = wid & 3, fr = lane & 15, fq = lane >> 4;
    unsigned voffA[2], voffB[2];
#pragma unroll
    for (int i = 0; i < 2; ++i) { int R, C; stage_rc(tid * 16 + i * 8192, R, C); const int Rb = Epi::PERM ? ((R & ~31) + perm32(R & 31)) : R;
        voffA[i] = (unsigned)(R * LDA + C) * 2u; voffB[i] = (unsigned)(Rb * LDB + C) * 2u; }
    constexpr size_t kstep = (size_t)(BK * 2);
    constexpr size_t hstepA = (size_t)HALF * LDA * 2, hstepB = (size_t)HALF * LDB * 2;
    constexpr size_t tstepA = 2 * hstepA, tstepB = 2 * hstepB;
    const unsigned ldsw = (unsigned)wid * 1024u;
    const int aoff = lds_byte(wr * 64 + fr, fq * 8), boff = lds_byte(wc * 32 + fr, fq * 8);
#define PG8_SA(b, h) (((b) * 2 + (h)) * HTB)
#define PG8_SB(b, h) ((4 + (b) * 2 + (h)) * HTB)
#define PG8_STAGE(bufoff, gbase, voff) do { _Pragma("unroll") for (int _i = 0; _i < 2; ++_i) \
        __builtin_amdgcn_global_load_lds((const unsigned*)((const char*)(gbase) + (voff)[_i]), (LAS unsigned*)(lds + (bufoff) + ldsw + _i * 8192), 16, 0, 0); } while (0)
#define PG8_LDA(dst, b, h) do { _Pragma("unroll") for (int m = 0; m < 4; ++m) _Pragma("unroll") for (int k = 0; k < 2; ++k) dst[m][k] = *(const LAS bf16x8*)(lds + PG8_SA(b, h) + aoff + m * 2048 + k * 1024); } while (0)
#define PG8_LDB(dst, b, h) do { _Pragma("unroll") for (int n = 0; n < 2; ++n) _Pragma("unroll") for (int k = 0; k < 2; ++k) dst[n][k] = *(const LAS bf16x8*)(lds + PG8_SB(b, h) + boff + n * 2048 + k * 1024); } while (0)
#define PG8_MMA(ai, bj, At, Bt) do { __builtin_amdgcn_s_setprio(1); _Pragma("unroll") for (int m = 0; m < 4; ++m) _Pragma("unroll") for (int n = 0; n < 2; ++n) _Pragma("unroll") for (int k = 0; k < 2; ++k) \
        acc[ai][bj][m][n] = __builtin_amdgcn_mfma_f32_16x16x32_bf16(Bt[n][k], At[m][k], acc[ai][bj][m][n], 0, 0, 0); __builtin_amdgcn_s_setprio(0); } while (0)
#define PG8_WAIT_V(n) asm volatile("s_waitcnt vmcnt(" #n ")" ::: "memory")
#define PG8_WAIT_L(n) asm volatile("s_waitcnt lgkmcnt(" #n ")" ::: "memory")
#define PG8_BAR __builtin_amdgcn_s_barrier()
#define PG8_SCHED __builtin_amdgcn_sched_barrier(0)
    Unit cur, nxt; int ui = 0;
    if (!S.next(0, cur)) return;
    f32x4 acc[2][2][4][2];
#pragma unroll
    for (int a = 0; a < 2; ++a)
#pragma unroll
        for (int b = 0; b < 2; ++b)
#pragma unroll
            for (int m = 0; m < 4; ++m)
#pragma unroll
                for (int n = 0; n < 2; ++n) acc[a][b][m][n] = (f32x4){0.f, 0.f, 0.f, 0.f};
    bf16x8 At[4][2], B0[2][2], B1[2][2];
    const char* cA = (const char*)g.A + (size_t)cur.pm * tstepA + (size_t)cur.kofs * 2; const char* cB = (const char*)g.Bt + (size_t)cur.pn * tstepB + (size_t)cur.kofs * 2;
    PG8_STAGE(PG8_SB(0, 0), cB, voffB); PG8_STAGE(PG8_SB(0, 1), cB + hstepB, voffB); PG8_STAGE(PG8_SA(0, 0), cA, voffA); PG8_STAGE(PG8_SA(0, 1), cA + hstepA, voffA);
    if (wr == 1) PG8_BAR;
    PG8_WAIT_V(2); PG8_BAR;
    PG8_STAGE(PG8_SB(1, 0), cB + kstep, voffB); PG8_STAGE(PG8_SA(1, 0), cA + kstep, voffA); PG8_STAGE(PG8_SB(1, 1), cB + hstepB + kstep, voffB);
    PG8_WAIT_V(6); PG8_BAR;
    for (;;) {
        const bool has_next = S.next(ui + 1, nxt);
        const char* nA = has_next ? (const char*)g.A + (size_t)nxt.pm * tstepA + (size_t)nxt.kofs * 2 : cA; const char* nB = has_next ? (const char*)g.Bt + (size_t)nxt.pn * tstepB + (size_t)nxt.kofs * 2 : cB;
        const int nt = cur.nkt;
        for (int t = 0; t < nt; t += 2) {
            const bool last = (t == nt - 2);
            const char* a1 = cA + (size_t)(t + 1) * kstep;
            const char* a2 = last ? nA : cA + (size_t)(t + 2) * kstep; const char* b2 = last ? nB : cB + (size_t)(t + 2) * kstep;
            const char* a3 = a2 + kstep; const char* b3 = b2 + kstep;
            PG8_LDB(B0, 0, 0); PG8_LDB(B1, 0, 1); PG8_SCHED; PG8_LDA(At, 0, 0); PG8_STAGE(PG8_SA(1, 1), a1 + hstepA, voffA);
            PG8_WAIT_V(8); PG8_WAIT_L(0); PG8_BAR; PG8_MMA(0, 0, At, B0); PG8_MMA(0, 1, At, B1); PG8_BAR; PG8_SCHED;
            PG8_LDA(At, 0, 1); PG8_STAGE(PG8_SB(0, 0), b2, voffB); PG8_STAGE(PG8_SB(0, 1), b2 + hstepB, voffB); PG8_STAGE(PG8_SA(0, 0), a2, voffA);
            PG8_WAIT_V(8); PG8_WAIT_L(0); PG8_BAR; PG8_MMA(1, 0, At, B0); PG8_MMA(1, 1, At, B1); PG8_BAR; PG8_SCHED;
            PG8_LDB(B0, 1, 0); PG8_LDB(B1, 1, 1); PG8_SCHED; PG8_LDA(At, 1, 0); PG8_STAGE(PG8_SA(0, 1), a2 + hstepA, voffA);
            PG8_WAIT_V(8); PG8_WAIT_L(0); PG8_BAR; PG8_MMA(0, 0, At, B0); PG8_MMA(0, 1, At, B1); PG8_BAR; PG8_SCHED;
            PG8_LDA(At, 1, 1); PG8_STAGE(PG8_SB(1, 0), b3, voffB); PG8_STAGE(PG8_SB(1, 1), b3 + hstepB, voffB); PG8_STAGE(PG8_SA(1, 0), a3, voffA);
            PG8_WAIT_V(8); PG8_WAIT_L(0); PG8_BAR; PG8_MMA(1, 0, At, B0); PG8_MMA(1, 1, At, B1); PG8_BAR; PG8_SCHED;
        }
        if constexpr (ALIGN_EPI) { if (wr == 0) PG8_BAR; }
        E(acc, cur, wr, wc, fr, fq);
        if (!has_next) break;
#pragma unroll
        for (int a = 0; a < 2; ++a)
#pragma unroll
            for (int b = 0; b < 2; ++b)
#pragma unroll
                for (int m = 0; m < 4; ++m)
#pragma unroll
                    for (int n = 0; n < 2; ++n) acc[a][b][m][n] = (f32x4){0.f, 0.f, 0.f, 0.f};
        cur = nxt; cA = nA; cB = nB; ++ui;
        if constexpr (ALIGN_EPI) { if (wr == 1) PG8_BAR; }
    }
    PG8_WAIT_V(0);
    if constexpr (!ALIGN_EPI) { if (wr == 0) PG8_BAR; }
    PG8_BAR;
#undef PG8_SA
#undef PG8_SB
#undef PG8_STAGE
#undef PG8_LDA
#undef PG8_LDB
#undef PG8_MMA
#undef PG8_WAIT_V
#undef PG8_WAIT_L
#undef PG8_BAR
#undef PG8_SCHED
}
}
namespace pg8 {
__device__ __forceinline__ int mod_row(int pm) { return pm < 16 ? 0 : (pm < 32 ? 1 : 2); }

struct EpiSwiGLU {
    static constexpr bool PERM = true;
    bf16_t* U;
    __device__ __forceinline__ void operator()(const f32x4 (&acc)[2][2][4][2], const Unit& u, int wr, int wc, int fr, int fq) const {
        const int row0 = u.pm * BM + wr * 64 + fr, col0 = u.pn * HALF + wc * 32 + 8 * fq;
#pragma unroll
        for (int ai = 0; ai < 2; ++ai)
#pragma unroll
            for (int m = 0; m < 4; ++m) { bf16_t* p = U + (size_t)(row0 + ai * HALF + m * 16) * FF + col0;
                const f32x4 a0 = acc[ai][0][m][0], a1 = acc[ai][0][m][1], b0 = acc[ai][1][m][0], b1 = acc[ai][1][m][1];
                float v[8];
#pragma unroll
                for (int e = 0; e < 4; ++e) { v[e] = silu_f(a0[e]) * b0[e]; v[4 + e] = silu_f(a1[e]) * b1[e]; }
                u32x4 w; w.x = cvt_pk_bf16(v[0], v[1]); w.y = cvt_pk_bf16(v[2], v[3]); w.z = cvt_pk_bf16(v[4], v[5]); w.w = cvt_pk_bf16(v[6], v[7]);
                *(u32x4*)p = w; }
    }
};

struct EpiNull {
    static constexpr bool PERM = true;
    float* dummy;
    __device__ __forceinline__ void operator()(const f32x4 (&acc)[2][2][4][2], const Unit& u, int wr, int wc, int fr, int fq) const {
        f32x4 s = {0.f, 0.f, 0.f, 0.f};
#pragma unroll
        for (int ai = 0; ai < 2; ++ai)
#pragma unroll
            for (int bj = 0; bj < 2; ++bj)
#pragma unroll
                for (int m = 0; m < 4; ++m)
#pragma unroll
                    for (int n = 0; n < 2; ++n) s = s + acc[ai][bj][m][n];
        dummy[(size_t)(u.pm * 64 + u.pn) * 512 + (wr * 4 + wc) * 64 + fq * 16 + fr] = (s[0] + s[1]) + (s[2] + s[3]);
    }
};

struct EpiResidNorm {
    static constexpr bool PERM = true;
    unsigned char* ws; const float* gate; const float* g; const float* shift; float* out; const float* xin; float gs; int fs;
    __device__ __forceinline__ void operator()(const f32x4 (&acc)[2][2][4][2], const Unit& u, int wr, int wc, int fr, int fq) const {
        const int row0 = u.pm * BM + wr * 64 + fr, col0 = u.pn * BM + wc * 32 + 8 * fq, mr = mod_row(u.pm);
        const float* gp = gate + (size_t)mr * MODLD + col0;
        f32x4 gv[2][2];
#pragma unroll
        for (int bj = 0; bj < 2; ++bj)
#pragma unroll
            for (int n = 0; n < 2; ++n) gv[bj][n] = *(const f32x4*)(gp + bj * HALF + n * 4) * gs;
        if (u.aux == 0) {
            bf16_t* XH = (bf16_t*)(ws + WS_XH); unsigned char* XL = ws + WS_XL; float* ssq = (float*)(ws + WS_SSQX) + (size_t)fs * ML; unsigned* cnt = (unsigned*)(ws + WS_PCNT) + (size_t)(fs * 32 + u.pm) * 64;
            const bool fin = out != nullptr;
            f32x4 xn[2][4][2][2];
#pragma unroll
            for (int ai = 0; ai < 2; ++ai)
#pragma unroll
                for (int m = 0; m < 4; ++m) { const int row = row0 + ai * HALF + m * 16; bf16_t* rowh = XH + (size_t)row * LDXH + col0; unsigned char* rowl = XL + (size_t)row * LDXL + col0; float ss = 0.f;
#pragma unroll
                    for (int bj = 0; bj < 2; ++bj) { f32x4 x0, x1;
                        if (xin) { const float* rin = xin + (size_t)row * D + col0 + bj * HALF; x0 = *(const f32x4*)rin; x1 = *(const f32x4*)(rin + 4); }
                        else { const u32x4 hw = *(const u32x4*)(rowh + bj * HALF); const u32x2 lw = *(const u32x2*)(rowl + bj * HALF);
#define XUNP(h, l, k) __builtin_bit_cast(float, __builtin_amdgcn_perm((h), (l), ((k) & 1) ? (0x07060000u | ((unsigned)((k) & 3) << 8) | 0x0cu) : (0x05040000u | ((unsigned)((k) & 3) << 8) | 0x0cu)))
                            x0 = (f32x4){XUNP(hw.x, lw.x, 0), XUNP(hw.x, lw.x, 1), XUNP(hw.y, lw.x, 2), XUNP(hw.y, lw.x, 3)};
                            x1 = (f32x4){XUNP(hw.z, lw.y, 4), XUNP(hw.z, lw.y, 5), XUNP(hw.w, lw.y, 6), XUNP(hw.w, lw.y, 7)};
#undef XUNP
                        }
                        const f32x4 t0 = x0 + gv[bj][0] * acc[ai][bj][m][0], t1 = x1 + gv[bj][1] * acc[ai][bj][m][1];
                        if (!fin) {
                            unsigned b[8];
#pragma unroll
                            for (int e = 0; e < 4; ++e) { const float f0 = t0[e], f1 = t1[e]; b[e] = __builtin_bit_cast(unsigned, f0); b[4 + e] = __builtin_bit_cast(unsigned, f1); }
                            u32x4 hw; hw.x = __builtin_amdgcn_perm(b[1], b[0], 0x07060302u); hw.y = __builtin_amdgcn_perm(b[3], b[2], 0x07060302u); hw.z = __builtin_amdgcn_perm(b[5], b[4], 0x07060302u); hw.w = __builtin_amdgcn_perm(b[7], b[6], 0x07060302u);
                            u32x2 lw; lw.x = __builtin_amdgcn_perm(__builtin_amdgcn_perm(b[3], b[2], 0x0c0c0501u), __builtin_amdgcn_perm(b[1], b[0], 0x0c0c0501u), 0x05040100u);
                            lw.y = __builtin_amdgcn_perm(__builtin_amdgcn_perm(b[7], b[6], 0x0c0c0501u), __builtin_amdgcn_perm(b[5], b[4], 0x0c0c0501u), 0x05040100u);
                            *(u32x4*)(rowh + bj * HALF) = hw; *(u32x2*)(rowl + bj * HALF) = lw; }
                        xn[ai][m][bj][0] = t0; xn[ai][m][bj][1] = t1;
                        ss += ((t0[0] * t0[0] + t0[1] * t0[1]) + (t0[2] * t0[2] + t0[3] * t0[3])) + ((t1[0] * t1[0] + t1[1] * t1[1]) + (t1[2] * t1[2] + t1[3] * t1[3])); }
                    ss += xor_lane<16>(ss); ss = half_sum(ss);
                    if (fq == 0) atomic_add_f32(ssq + row, ss);
                    asm volatile("" ::: "memory"); }
            f32x4 gm[2][2], sh[2][2];
#pragma unroll
            for (int bj = 0; bj < 2; ++bj)
#pragma unroll
                for (int n = 0; n < 2; ++n) { const int c = col0 + bj * HALF + n * 4; const f32x4 gw = *(const f32x4*)(g + c);
                    if (fin) { gm[bj][n] = gw; sh[bj][n] = (f32x4){0.f, 0.f, 0.f, 0.f}; }
                    else { gm[bj][n] = gw * (*(const f32x4*)(shift + (size_t)mr * MODLD + D + c) + 1.0f); sh[bj][n] = *(const f32x4*)(shift + (size_t)mr * MODLD + c); } }
            asm volatile("s_waitcnt vmcnt(0)" ::: "memory");
            if (lane_id() == 0) (void)xb_add(cnt, 1u);
            { unsigned sp = 0; unsigned* tmo = (unsigned*)(ws + WS_CTL) + CW_BAR + XB_TMO;
              while ((unsigned)__builtin_amdgcn_readfirstlane((int)xb_ld(cnt)) < 64u) { __builtin_amdgcn_s_sleep(2);
                  if ((++sp & 255u) == 0u) { if (xb_ld(tmo)) break; if (sp > XB_SPIN_CAP) { atomicAdd(tmo, 1u); break; } } } }
            float rs[2][4];
#pragma unroll
            for (int ai = 0; ai < 2; ++ai)
#pragma unroll
                for (int m = 0; m < 4; ++m) rs[ai][m] = __hip_atomic_load(ssq + row0 + ai * HALF + m * 16, __ATOMIC_RELAXED, __HIP_MEMORY_SCOPE_AGENT);
#pragma unroll
            for (int ai = 0; ai < 2; ++ai)
#pragma unroll
                for (int m = 0; m < 4; ++m) { const int row = row0 + ai * HALF + m * 16; const float rstd = 1.0f / sqrtf(rs[ai][m] * (1.0f / D) + NORM_EPS);
#pragma unroll
                    for (int bj = 0; bj < 2; ++bj) { const f32x4 y0 = xn[ai][m][bj][0] * rstd * gm[bj][0] + sh[bj][0], y1 = xn[ai][m][bj][1] * rstd * gm[bj][1] + sh[bj][1];
                        if (fin) { float* o = out + (size_t)row * D + col0 + bj * HALF; *(f32x4*)o = y0; *(f32x4*)(o + 4) = y1; }
                        else { u32x4 w; w.x = cvt_pk_bf16(y0[0], y0[1]); w.y = cvt_pk_bf16(y0[2], y0[3]); w.z = cvt_pk_bf16(y1[0], y1[1]); w.w = cvt_pk_bf16(y1[2], y1[3]);
                            *(u32x4*)((bf16_t*)(ws + WS_H) + (size_t)row * LDH + col0 + bj * HALF) = w; } }
                    asm volatile("" ::: "memory"); }
        } else {
            float* pb = (float*)(ws + WS_PART) + (size_t)(u.aux - 1) * MC * LDX;
#pragma unroll
            for (int ai = 0; ai < 2; ++ai)
#pragma unroll
                for (int m = 0; m < 4; ++m) { float* rowp = pb + (size_t)(row0 + ai * HALF + m * 16 - ML) * LDX + col0;
#pragma unroll
                    for (int bj = 0; bj < 2; ++bj)
#pragma unroll
                        for (int n = 0; n < 2; ++n) *(f32x4*)(rowp + bj * HALF + n * 4) = gv[bj][n] * acc[ai][bj][m][n]; }
        }
    }
};

struct ProjCtx { unsigned char* ws; int l; int probe; LAS unsigned char* lds; };
template <class T> __device__ __forceinline__ T* pws(const ProjCtx& c, size_t off) { return (T*)(c.ws + off); }
template <int LD, bool SSQ, bool RS, bool ACT, bool ROPE, int NCOPY>
__device__ __forceinline__ void proj_group(const f32x4 (&acc)[2][2][4][2], const int bj, bf16_t* p0, const float cs, float* ssq_out, const float* ssq_in, const float inv_n,
                                           const int rk, const int row0, const int fq, const LAS unsigned char* ldsb) {
    float sqv[2][4];
    if constexpr (RS) {
#pragma unroll
        for (int ai = 0; ai < 2; ++ai)
#pragma unroll
            for (int m = 0; m < 4; ++m) sqv[ai][m] = ssq_in[ai * HALF + m * 16];
    }
#pragma unroll
    for (int ai = 0; ai < 2; ++ai)
#pragma unroll
        for (int m = 0; m < 4; ++m) {
            const int ro = ai * HALF + m * 16;
            f32x4 v0 = acc[ai][bj][m][0], v1 = acc[ai][bj][m][1];
            if constexpr (SSQ) {
                float ss = (v0[0] * v0[0] + v0[1] * v0[1]) + (v0[2] * v0[2] + v0[3] * v0[3]) + (v1[0] * v1[0] + v1[1] * v1[1]) + (v1[2] * v1[2] + v1[3] * v1[3]);
                ss += xor_lane<16>(ss); ss = half_sum(ss);
                if (fq == 0) atomic_add_f32(ssq_out + ro, ss);
            }
            if constexpr (RS) { const float rs = cs * (1.0f / sqrtf(sqv[ai][m] * inv_n + NORM_EPS)); v0 = v0 * rs; v1 = v1 * rs; }
            else if constexpr (!SSQ && !ACT) { v0 = v0 * cs; v1 = v1 * cs; }
            if constexpr (ACT) {
#pragma unroll
                for (int e = 0; e < 4; ++e) { v0[e] = sigmoid_f(v0[e]); v1[e] = sigmoid_f(v1[e]); }
            }
            if constexpr (ROPE) {
                if (rk != 0) {
                    const int t = (row0 + ro) & (SEQ - 1), pos = (rk == 1) ? (t >> 6) : (t & 63);
                    const LAS float* tb = (const LAS float*)(ldsb + ROPE_LDS) + pos * 16 + 8 * (fq & 1);
                    const f32x4 c0 = *(const LAS f32x4*)tb, c1 = *(const LAS f32x4*)(tb + 4), s0 = *(const LAS f32x4*)(tb + 1024), s1 = *(const LAS f32x4*)(tb + 1028);
                    const bool lowh = fq < 2;
#pragma unroll
                    for (int e = 0; e < 4; ++e) {
                        { const float f = v0[e]; const unsigned w = __builtin_bit_cast(unsigned, f); auto rr = __builtin_amdgcn_permlane32_swap(w, w, false, false);
                          const float x1 = __builtin_bit_cast(float, (unsigned)rr[0]), x2 = __builtin_bit_cast(float, (unsigned)rr[1]);
                          v0[e] = lowh ? x1 * c0[e] - x2 * s0[e] : x1 * s0[e] + x2 * c0[e]; }
                        { const float f = v1[e]; const unsigned w = __builtin_bit_cast(unsigned, f); auto rr = __builtin_amdgcn_permlane32_swap(w, w, false, false);
                          const float x1 = __builtin_bit_cast(float, (unsigned)rr[0]), x2 = __builtin_bit_cast(float, (unsigned)rr[1]);
                          v1[e] = lowh ? x1 * c1[e] - x2 * s1[e] : x1 * s1[e] + x2 * c1[e]; }
                    }
                }
            }
            if constexpr (ACT) {
                unsigned g0 = 0u, g1 = 0u;
                g0 = __builtin_amdgcn_cvt_pk_u8_f32(__builtin_rintf(v0[0] * 255.0f), 0, g0); g0 = __builtin_amdgcn_cvt_pk_u8_f32(__builtin_rintf(v0[1] * 255.0f), 1, g0); g0 = __builtin_amdgcn_cvt_pk_u8_f32(__builtin_rintf(v0[2] * 255.0f), 2, g0); g0 = __builtin_amdgcn_cvt_pk_u8_f32(__builtin_rintf(v0[3] * 255.0f), 3, g0);
                g1 = __builtin_amdgcn_cvt_pk_u8_f32(__builtin_rintf(v1[0] * 255.0f), 0, g1); g1 = __builtin_amdgcn_cvt_pk_u8_f32(__builtin_rintf(v1[1] * 255.0f), 1, g1); g1 = __builtin_amdgcn_cvt_pk_u8_f32(__builtin_rintf(v1[2] * 255.0f), 2, g1); g1 = __builtin_amdgcn_cvt_pk_u8_f32(__builtin_rintf(v1[3] * 255.0f), 3, g1);
                u32x2 w; w.x = g0; w.y = g1;
                *(u32x2*)((unsigned char*)p0 + (size_t)ro * LD) = w;
            } else {
            u32x4 w; w.x = cvt_pk_bf16(v0[0], v0[1]); w.y = cvt_pk_bf16(v0[2], v0[3]); w.z = cvt_pk_bf16(v1[0], v1[1]); w.w = cvt_pk_bf16(v1[2], v1[3]);
            bf16_t* p = p0 + (size_t)ro * LD;
#pragma unroll
            for (int cp = 0; cp < NCOPY; ++cp) *(u32x4*)(p + cp * 192) = w;
            }
        }
}
template <int KIND> struct EpiProj {
    static constexpr bool PERM = true;
    ProjCtx c;
    __device__ __forceinline__ void operator()(const f32x4 (&acc)[2][2][4][2], const Unit& u, int wr, int wc, int fr, int fq) const {
        const int row0 = u.pm * BM + wr * 64 + fr, lc = wc * 32 + 8 * fq;
        const LAS unsigned char* tab = c.lds;
        if constexpr (KIND == 0) {
            if (u.pn >= 17) {
#pragma unroll
                for (int bj = 0; bj < 2; ++bj) proj_group<256, false, false, true, false, 1>(acc, bj, (bf16_t*)(pws<unsigned char>(c, WS_G) + ((size_t)(u.pm * 24 + u.pn - 17) << 16) + (row0 & 255) * 256 + bj * 128 + lc), 1.f, nullptr, nullptr, 0.f, 0, row0, fq, tab);
            } else if (u.pn < 6) {
                bf16_t* base = pws<bf16_t>(c, u.pn < 3 ? WS_NAQ : WS_NAK) + (size_t)row0 * 768 + (u.pn < 3 ? u.pn : u.pn - 3) * 256 + lc;
                const float cs = u.pn < 3 ? NA_SCALE * LOG2E : 1.f;
#pragma unroll
                for (int bj = 0; bj < 2; ++bj) proj_group<768, false, false, false, false, 1>(acc, bj, base + bj * 128, cs, nullptr, nullptr, 0.f, 0, row0, fq, tab);
            } else if (u.pn < 9) {
                bf16_t* base = pws<bf16_t>(c, WS_CQ) + (size_t)row0 * 768 + (u.pn - 6) * 256 + lc; float* sq = (c.probe ? pws<float>(c, WS_PART) : pws<float>(c, WS_SSQ) + (size_t)(2 * c.l) * M) + row0;
#pragma unroll
                for (int bj = 0; bj < 2; ++bj) proj_group<768, true, false, false, false, 1>(acc, bj, base + bj * 128, 1.f, sq, nullptr, 0.f, 0, row0, fq, tab);
            } else if (u.pn < 11) {
                bf16_t* base = pws<bf16_t>(c, WS_CKV) + (size_t)row0 * 512 + (u.pn - 9) * 256 + lc; float* sq = (c.probe ? pws<float>(c, WS_PART) : pws<float>(c, WS_SSQ) + (size_t)(2 * c.l + 1) * M) + row0;
#pragma unroll
                for (int bj = 0; bj < 2; ++bj) proj_group<512, true, false, false, false, 1>(acc, bj, base + bj * 128, 1.f, sq, nullptr, 0.f, 0, row0, fq, tab);
            } else if (u.pn < 16) {
                const int rk = row0 < ML ? 1 + (wc & 1) : 0;
#pragma unroll
                for (int bj = 0; bj < 2; ++bj) { const int g = 2 * u.pn + bj; const bool q = g < 27;
                    bf16_t* p0 = pws<bf16_t>(c, q ? WS_DQ : WS_DK) + (size_t)row0 * 640 + (q ? g - 22 : g - 27) * 128 + lc;
                    proj_group<640, false, false, false, true, 1>(acc, bj, p0, q ? DF_SCALE * LOG2E : 1.f, nullptr, nullptr, 0.f, rk, row0, fq, tab); }
            } else {
                if (wc < 2) proj_group<960, false, false, false, true, 5>(acc, 0, pws<bf16_t>(c, WS_MK) + (size_t)row0 * 960 + 128 + lc, 1.f, nullptr, nullptr, 0.f, row0 < ML ? 1 + (wc & 1) : 0, row0, fq, tab);
            }
        } else if constexpr (KIND == 1) {
            const float* sq = pws<float>(c, WS_SSQ) + (size_t)(2 * c.l) * M + row0;
#pragma unroll
            for (int bj = 0; bj < 2; ++bj) { const int g = 2 * u.pn + bj, b32 = 4 * g + wc, bb = b32 % 6;
                if (b32 >= 30) continue;
                bf16_t* p0 = pws<bf16_t>(c, WS_MQ) + (size_t)row0 * 960 + g * 128 + lc;
                if (bb >= 4) proj_group<960, false, true, false, true, 1>(acc, bj, p0, MLA_SCALE * LOG2E, nullptr, sq, 1.0f / 768.0f, row0 < ML ? bb - 3 : 0, row0, fq, tab);
                else proj_group<960, false, true, false, false, 1>(acc, bj, p0, MLA_SCALE * LOG2E, nullptr, sq, 1.0f / 768.0f, 0, row0, fq, tab); }
        } else {
            const float* sq = pws<float>(c, WS_SSQ) + (size_t)(2 * c.l + 1) * M + row0;
#pragma unroll
            for (int bj = 0; bj < 2; ++bj) { const int g = 2 * u.pn + bj; if (g >= 5) continue;
                proj_group<960, false, true, false, false, 1>(acc, bj, pws<bf16_t>(c, WS_MK) + (size_t)row0 * 960 + g * 192 + lc, 1.f, nullptr, sq, 1.0f / 512.0f, 0, row0, fq, tab); }
        }
    }
};

template <int KIND> struct EpiVT {
    static constexpr bool PERM = true;
    bf16_t* VT; const float* ssq;
    __device__ __forceinline__ void operator()(const f32x4 (&acc)[2][2][4][2], const Unit& u, int wr, int wc, int fr, int fq) const {
        const int ch0 = u.pm * BM + wr * 64 + fr, tok0 = u.pn * BM + wc * 32 + 8 * fq;
        constexpr int NCH = KIND == 0 ? 1408 : 640;
        f32x4 sc[2][2];
#pragma unroll
        for (int bj = 0; bj < 2; ++bj)
#pragma unroll
            for (int n = 0; n < 2; ++n) {
                if constexpr (KIND == 1) { const f32x4 s = *(const f32x4*)(ssq + tok0 + bj * HALF + 4 * n);
#pragma unroll
                    for (int e = 0; e < 4; ++e) sc[bj][n][e] = 1.0f / sqrtf(s[e] * (1.0f / 512.0f) + NORM_EPS); }
                else sc[bj][n] = (f32x4){1.f, 1.f, 1.f, 1.f};
            }
#pragma unroll
        for (int ai = 0; ai < 2; ++ai)
#pragma unroll
            for (int m = 0; m < 4; ++m) { const int ch = ch0 + ai * HALF + m * 16; if (ch >= NCH) continue;
                bf16_t* rowp = VT + (size_t)ch * M + tok0;
#pragma unroll
                for (int bj = 0; bj < 2; ++bj) { const f32x4 v0 = acc[ai][bj][m][0] * sc[bj][0], v1 = acc[ai][bj][m][1] * sc[bj][1];
                    u32x4 w; w.x = cvt_pk_bf16(v0[0], v0[1]); w.y = cvt_pk_bf16(v0[2], v0[3]); w.z = cvt_pk_bf16(v1[0], v1[1]); w.w = cvt_pk_bf16(v1[2], v1[3]);
                    *(u32x4*)(rowp + bj * HALF) = w; } }
    }
};

struct EpiMerge {
    static constexpr bool PERM = true;
    unsigned char* ws;
    __device__ __forceinline__ void operator()(const f32x4 (&acc)[2][2][4][2], const Unit& u, int wr, int wc, int fr, int fq) const {
        const int row0 = u.pm * BM + wr * 64 + fr, col0 = u.pn * BM + wc * 32 + 8 * fq, br = u.aux & 3; const bool atom = u.aux >= 4;
        const bf16_t* G = (const bf16_t*)(ws + WS_G); bf16_t* Y = (bf16_t*)(ws + WS_Y);
#pragma unroll
        for (int ai = 0; ai < 2; ++ai)
#pragma unroll
            for (int m = 0; m < 4; ++m) { const int row = row0 + ai * HALF + m * 16;
#pragma unroll
                for (int bj = 0; bj < 2; ++bj) { const int col = col0 + bj * HALF;
                    const u32x2 gw = *(const u32x2*)((const unsigned char*)G + ((size_t)(u.pm * 24 + br * 8 + u.pn) << 16) + (row & 255) * 256 + (col & 255));
                    f32x4 v0 = acc[ai][bj][m][0] * (1.0f / 255.0f), v1 = acc[ai][bj][m][1] * (1.0f / 255.0f);
                    v0[0] *= (float)(gw.x & 0xffu); v0[1] *= (float)((gw.x >> 8) & 0xffu); v0[2] *= (float)((gw.x >> 16) & 0xffu); v0[3] *= (float)(gw.x >> 24);
                    v1[0] *= (float)(gw.y & 0xffu); v1[1] *= (float)((gw.y >> 8) & 0xffu); v1[2] *= (float)((gw.y >> 16) & 0xffu); v1[3] *= (float)(gw.y >> 24);
                    bf16_t* yp = Y + (size_t)row * D + col;
                    if (!atom && br != 0) { const u32x4 yw = *(const u32x4*)yp;
                        v0[0] += bflo(yw.x); v0[1] += bfhi(yw.x); v0[2] += bflo(yw.y); v0[3] += bfhi(yw.y);
                        v1[0] += bflo(yw.z); v1[1] += bfhi(yw.z); v1[2] += bflo(yw.w); v1[3] += bfhi(yw.w); }
                    const unsigned a0 = cvt_pk_bf16(v0[0], v0[1]), a1 = cvt_pk_bf16(v0[2], v0[3]), a2 = cvt_pk_bf16(v1[0], v1[1]), a3 = cvt_pk_bf16(v1[2], v1[3]);
                    if (!atom) { u32x4 w; w.x = a0; w.y = a1; w.z = a2; w.w = a3; *(u32x4*)yp = w; }
                    else { typedef short s16x2 __attribute__((ext_vector_type(2))); GAS s16x2* ap = (GAS s16x2*)yp;
                        s16x2 b0 = __builtin_bit_cast(s16x2, a0), b1 = __builtin_bit_cast(s16x2, a1), b2 = __builtin_bit_cast(s16x2, a2), b3 = __builtin_bit_cast(s16x2, a3);
                        __builtin_amdgcn_global_atomic_fadd_v2bf16(ap, b0); __builtin_amdgcn_global_atomic_fadd_v2bf16(ap + 1, b1);
                        __builtin_amdgcn_global_atomic_fadd_v2bf16(ap + 2, b2); __builtin_amdgcn_global_atomic_fadd_v2bf16(ap + 3, b3); } }
                asm volatile("" ::: "memory"); }
    }
};
}
struct Frame {
    LAS unsigned char* lds;
    volatile LAS unsigned* MISC;
    gu32* ctl;
    unsigned char* ws;
    int wave, vcu, G;
};
struct Args { const float* in[20]; float* out; unsigned char* ws; int ph_lo, ph_hi; };
enum { I_X = 0, I_C, I_CTX, I_CCTX, I_WADA, I_BADA, I_NORMW, I_FFNIN, I_FFNOUT, I_WIN, I_RPB, I_QNORM, I_KVNORM, I_WUQ, I_WUKV, I_DLAM, I_SUBLN, I_WBR, I_WOUT, I_FNORM };
template <class T> __device__ __forceinline__ T* wsp(const Frame& F, size_t off) { return (T*)(F.ws + off); }

__device__ __forceinline__ bf16_t* dest_row(const Frame& F, int mat, int li, int n) {
    switch (mat) {
    case 0: { const int half = n >= FF ? 1 : 0, jj = n - half * FF; return wsp<bf16_t>(F, WS_WFI + (size_t)li * WFI_SZ) + (size_t)(256 * (jj >> 7) + 128 * half + (jj & 127)) * D; }
    case 1: return wsp<bf16_t>(F, WS_WFO + (size_t)li * WFO_SZ) + (size_t)n * FF;
    case 2: { bf16_t* win = wsp<bf16_t>(F, WS_WIN + (size_t)li * WIN_SZ); bf16_t* wvt = wsp<bf16_t>(F, WS_WVT + (size_t)li * WVT_SZ);
        if (n < 1536) return win + (size_t)n * D;
        if (n < 2304) return wvt + (size_t)(n - 1536) * D;
        if (n < 3584) return win + (size_t)(n - 2304 + 1536) * D;
        if (n < 3648) return win + (size_t)(n - 3584 + 4096) * D;
        if (n < 4928) return win + (size_t)(n - 3648 + 2816) * D;
        if (n < 5568) return wvt + (size_t)(n - 4928 + 768) * D;
        return win + (size_t)(n - 5568 + 4352) * D; }
    case 3: return wsp<bf16_t>(F, WS_WUQ + (size_t)li * WUQ_SZ) + (size_t)n * 768;
    case 4: { const int h = n >> 8, r = n & 255; return r < 128 ? wsp<bf16_t>(F, WS_WUK + (size_t)li * WUK_SZ) + (size_t)(h * 128 + r) * 512 : wsp<bf16_t>(F, WS_WUV + (size_t)li * WUK_SZ) + (size_t)(h * 128 + r - 128) * 512; }
    case 5: return wsp<bf16_t>(F, WS_WBR + (size_t)li * WSQ_SZ) + (size_t)n * D;
    default: return wsp<bf16_t>(F, WS_WO + (size_t)li * WSQ_SZ) + (size_t)n * D;
    }
}
__device__ __forceinline__ void transpose_item(const Frame& F, const float* W, int N, const float* gk, int mat, int li, LAS float* scr, int kb, int nb, int lane) {
    const int k0 = 64 * kb, n0 = 32 * nb, kr = lane >> 3, c4 = 4 * (lane & 7);
    f32x4 v[8];
#pragma unroll
    for (int i = 0; i < 8; ++i) v[i] = *(const f32x4*)(W + (size_t)(k0 + 8 * i + kr) * N + n0 + c4);
#pragma unroll
    for (int i = 0; i < 8; ++i) { const int kk = 8 * i + kr; f32x4 x = v[i]; if (gk) x = x * gk[k0 + kk];
        LAS float* d = scr + kk * 33 + c4; d[0] = x[0]; d[1] = x[1]; d[2] = x[2]; d[3] = x[3]; }
    LDS_WAIT(); asm volatile("" ::: "memory");
    const int c = lane & 7;
#pragma unroll
    for (int j = 0; j < 4; ++j) { const int n = (lane >> 3) + 8 * j; const LAS float* s = scr + (8 * c) * 33 + n;
        u32x4 o; o.x = pk2(s[0 * 33], s[1 * 33]); o.y = pk2(s[2 * 33], s[3 * 33]); o.z = pk2(s[4 * 33], s[5 * 33]); o.w = pk2(s[6 * 33], s[7 * 33]);
        bf16_t* dr = dest_row(F, mat, li, n0 + n);
        *(GAS u32x4*)(dr + k0 + 8 * c) = o; }
    LDS_WAIT(); asm volatile("" ::: "memory");
}
__device__ __forceinline__ void zero_rows(bf16_t* p, size_t nelem, int gtid, int gthreads) {
    const u32x4 z = {0u, 0u, 0u, 0u};
    for (size_t i = (size_t)gtid; i < nelem / 8; i += gthreads) ((u32x4*)p)[i] = z;
}
constexpr int WCV_TAKE = 12;
namespace wcv {
constexpr int I_FI = (D / 64) * (2 * FF / 32), I_FO = (FF / 64) * (D / 32), I_IN = (D / 64) * (INW / 32), I_UQ = (768 / 64) * (960 / 32), I_UKV = (512 / 64) * (1280 / 32), I_SQ = (D / 64) * (D / 32);
constexpr int NH0 = I_FI + I_FO + I_IN + I_UQ + I_UKV, NH1 = I_FI + I_FO + 2 * I_SQ;
__host__ __device__ constexpr int nitems(int half) { return half == 0 ? NH0 : NH1; }
}
__device__ __forceinline__ void convert_item(const Frame& F, const Args& args, int L, int half, int j, LAS float* scr, int lane) {
    using namespace wcv;
    int r = j, mat, li = L, N, nbs; const float* W; const float* gk = nullptr;
    if (r < I_FI) { li = 2 * L + half; mat = 0; W = args.in[I_FFNIN] + (size_t)li * D * 2 * FF; N = 2 * FF; nbs = 2 * FF / 32; }
    else if (half == 0) {
        if ((r -= I_FI) < I_FO) { li = 2 * L; mat = 1; W = args.in[I_FFNOUT] + (size_t)li * FF * D; N = D; nbs = D / 32; }
        else if ((r -= I_FO) < I_IN) { mat = 2; W = args.in[I_WIN] + (size_t)L * D * INW; N = INW; nbs = INW / 32; }
        else if ((r -= I_IN) < I_UQ) { mat = 3; W = args.in[I_WUQ] + (size_t)L * 768 * 960; N = 960; nbs = 30; gk = args.in[I_QNORM] + L * 768; }
        else { r -= I_UQ; mat = 4; W = args.in[I_WUKV] + (size_t)L * 512 * 1280; N = 1280; nbs = 40; gk = args.in[I_KVNORM] + L * 512; }
    } else {
        if ((r -= I_FI) < I_SQ) { mat = 5; W = args.in[I_WBR] + (size_t)L * D * D; N = D; nbs = 64; }
        else if ((r -= I_SQ) < I_SQ) { mat = 6; W = args.in[I_WOUT] + (size_t)L * D * D; N = D; nbs = 64; }
        else { r -= I_SQ; li = 2 * L + 1; mat = 1; W = args.in[I_FFNOUT] + (size_t)li * FF * D; N = D; nbs = D / 32; }
    }
    transpose_item(F, W, N, gk, mat, li, scr, r / nbs, r % nbs, lane);
}
struct CvItem { const float* W; const float* gk; int N, mat, li, kb, nb; };
__device__ __forceinline__ CvItem convert_decode(const Args& args, int L, int half, int j) {
    using namespace wcv;
    int r = j, mat, li = L, N, nbs; const float* W; const float* gk = nullptr;
    if (r < I_FI) { li = 2 * L + half; mat = 0; W = args.in[I_FFNIN] + (size_t)li * D * 2 * FF; N = 2 * FF; nbs = 2 * FF / 32; }
    else if (half == 0) {
        if ((r -= I_FI) < I_FO) { li = 2 * L; mat = 1; W = args.in[I_FFNOUT] + (size_t)li * FF * D; N = D; nbs = D / 32; }
        else if ((r -= I_FO) < I_IN) { mat = 2; W = args.in[I_WIN] + (size_t)L * D * INW; N = INW; nbs = INW / 32; }
        else if ((r -= I_IN) < I_UQ) { mat = 3; W = args.in[I_WUQ] + (size_t)L * 768 * 960; N = 960; nbs = 30; gk = args.in[I_QNORM] + L * 768; }
        else { r -= I_UQ; mat = 4; W = args.in[I_WUKV] + (size_t)L * 512 * 1280; N = 1280; nbs = 40; gk = args.in[I_KVNORM] + L * 512; }
    } else {
        if ((r -= I_FI) < I_SQ) { mat = 5; W = args.in[I_WBR] + (size_t)L * D * D; N = D; nbs = 64; }
        else if ((r -= I_SQ) < I_SQ) { mat = 6; W = args.in[I_WOUT] + (size_t)L * D * D; N = D; nbs = 64; }
        else { r -= I_SQ; li = 2 * L + 1; mat = 1; W = args.in[I_FFNOUT] + (size_t)li * FF * D; N = D; nbs = D / 32; }
    }
    CvItem c; c.W = W; c.gk = gk; c.N = N; c.mat = mat; c.li = li; c.kb = r / nbs; c.nb = r % nbs; return c;
}
__device__ __forceinline__ void cv_load(const CvItem& c, int lane, f32x4 (&v)[8]) {
    const int k0 = 64 * c.kb, n0 = 32 * c.nb, kr = lane >> 3, c4 = 4 * (lane & 7);
#pragma unroll
    for (int i = 0; i < 8; ++i) v[i] = __builtin_nontemporal_load((const f32x4*)(c.W + (size_t)(k0 + 8 * i + kr) * c.N + n0 + c4));
}
__device__ __forceinline__ void cv_finish(const Frame& F, const CvItem& c, LAS float* scr, int lane, const f32x4 (&v)[8]) {
    const int k0 = 64 * c.kb, n0 = 32 * c.nb, kr = lane >> 3, c4 = 4 * (lane & 7);
#pragma unroll
    for (int i = 0; i < 8; ++i) { const int kk = 8 * i + kr; f32x4 x = v[i]; if (c.gk) x = x * c.gk[k0 + kk];
        LAS float* d = scr + kk * 33 + c4; d[0] = x[0]; d[1] = x[1]; d[2] = x[2]; d[3] = x[3]; }
    LDS_WAIT(); asm volatile("" ::: "memory");
    const int cc = lane & 7;
#pragma unroll
    for (int j = 0; j < 4; ++j) { const int n = (lane >> 3) + 8 * j; const LAS float* sp = scr + (8 * cc) * 33 + n;
        u32x4 o; o.x = pk2(sp[0 * 33], sp[1 * 33]); o.y = pk2(sp[2 * 33], sp[3 * 33]); o.z = pk2(sp[4 * 33], sp[5 * 33]); o.w = pk2(sp[6 * 33], sp[7 * 33]);
        bf16_t* dr = dest_row(F, c.mat, c.li, n0 + n);
        __builtin_nontemporal_store(o, (u32x4*)(dr + k0 + 8 * cc)); }
    LDS_WAIT(); asm volatile("" ::: "memory");
}
__device__ __forceinline__ void convert_fill(const Frame& F, const Args& args, int L, int half, gu32* ctr, int jlo, int jhi) {
    LAS float* scr = (LAS float*)(F.lds + RING_OFF + F.wave * 16384);
    const int lane = (tid_of(F.wave) & 63), x0 = (int)(xb_xcc_id() & 7u);
    const int NI = jhi - jlo, NLC = (NI + 7) / 8;
    unsigned long long live;
    { const int xl = lane & 7, lol = xl * NLC, nl = (lol + NLC <= NI) ? NLC : (NI - lol);
      const unsigned cv = __hip_atomic_load(ctr + 64 * xl, RLX_AGENT);
      live = __builtin_amdgcn_ballot_w64((int)cv < nl); }
    for (int k = 0; k < 8; ++k) {
        const int x = (x0 + k) & 7, lo = x * NLC, n = (lo + NLC <= NI) ? NLC : (NI - lo);
        if (!((live >> x) & 1ull)) continue;
        for (;;) {
            unsigned b = 0u;
            if (lane == 0) b = __hip_atomic_fetch_add(ctr + 64 * x, (unsigned)WCV_TAKE, RLX_AGENT);
            b = (unsigned)__builtin_amdgcn_readfirstlane((int)b);
            if ((int)b >= n) break;
            const int cnt = (n - (int)b < WCV_TAKE) ? n - (int)b : WCV_TAKE, j0 = jlo + lo + (int)b;
            f32x4 va[8], vb[8], vc[8];
            if (cnt == WCV_TAKE) {
                CvItem ca = convert_decode(args, L, half, j0), cb = convert_decode(args, L, half, j0 + 1), cc = ca;
                cv_load(ca, lane, va); cv_load(cb, lane, vb);
                int i = 0;
                for (; i + 5 < WCV_TAKE; i += 3) {
                    cc = convert_decode(args, L, half, j0 + i + 2); cv_load(cc, lane, vc); cv_finish(F, ca, scr, lane, va);
                    ca = convert_decode(args, L, half, j0 + i + 3); cv_load(ca, lane, va); cv_finish(F, cb, scr, lane, vb);
                    cb = convert_decode(args, L, half, j0 + i + 4); cv_load(cb, lane, vb); cv_finish(F, cc, scr, lane, vc);
                }
                cc = convert_decode(args, L, half, j0 + WCV_TAKE - 1); cv_load(cc, lane, vc);
                cv_finish(F, ca, scr, lane, va); cv_finish(F, cb, scr, lane, vb); cv_finish(F, cc, scr, lane, vc);
            } else {
                for (int i = 0; i < cnt; ++i) { const CvItem ca = convert_decode(args, L, half, j0 + i); cv_load(ca, lane, va); cv_finish(F, ca, scr, lane, va); }
            }
        }
    }
}
__device__ __forceinline__ void p0_prologue(Frame& F, const Args& args, bool with_mod) {
    LAS float* scr = (LAS float*)(F.lds + RING_OFF + F.wave * 16384);
    const int gw = F.vcu * NWAVES + F.wave, NGW = F.G * NWAVES, lane = (tid_of(F.wave) & 63);
    if (with_mod)
    {
        float* mod = wsp<float>(F, WS_MOD);
        constexpr int NCH = MODLD / 256, NKS = D / 32, NIT = DEPTH * NKS * NCH;
        for (int it = gw; it < NIT; it += NGW) {
            const int l = it / (NKS * NCH), r = it % (NKS * NCH), ks = r / NCH, cc = r % NCH, n = cc * 256 + 4 * lane;
            f32x4 a0 = {0.f, 0.f, 0.f, 0.f}, a1 = a0, a2 = a0;
            const float* wp = args.in[I_WADA] + ((size_t)l * D + (size_t)ks * 32) * MODLD + n;
#pragma unroll 16
            for (int kk = 0; kk < 32; ++kk) { const int k = ks * 32 + kk; const f32x4 w = *(const f32x4*)(wp + (size_t)kk * MODLD);
                const float s0 = silu_f(args.in[I_C][k]), s1 = silu_f(args.in[I_C][D + k]), s2 = silu_f(args.in[I_CCTX][k]);
                a0 = a0 + w * s0; a1 = a1 + w * s1; a2 = a2 + w * s2; }
            if (ks == 0) { const f32x4 b = *(const f32x4*)(args.in[I_BADA] + (size_t)l * MODLD + n); a0 = a0 + b; a1 = a1 + b; a2 = a2 + b; }
            float* mp = mod + (size_t)l * 3 * MODLD + n;
#pragma unroll
            for (int e = 0; e < 4; ++e) { atomic_add_f32(mp + e, a0[e]); atomic_add_f32(mp + MODLD + e, a1[e]); atomic_add_f32(mp + 2 * MODLD + e, a2[e]); }
        }
    }
    for (int j = gw; j < wcv::NH0 - wcv::I_FO; j += NGW) convert_item(F, args, 0, 0, j < wcv::I_FI ? j : j + wcv::I_FO, scr, lane);
    {
        const int gtid = (F.vcu * NWAVES + F.wave) * 64 + lane, gth = F.G * NTHREADS;
        for (int l = 0; l < DEPTH; ++l) {
            zero_rows(wsp<bf16_t>(F, WS_WIN + (size_t)l * WIN_SZ) + (size_t)4160 * D, (size_t)192 * D, gtid, gth);
            zero_rows(wsp<bf16_t>(F, WS_WVT + (size_t)l * WVT_SZ) + (size_t)1408 * D, (size_t)128 * D, gtid, gth);
            zero_rows(wsp<bf16_t>(F, WS_WUQ + (size_t)l * WUQ_SZ) + (size_t)960 * 768, (size_t)64 * 768, gtid, gth);
            zero_rows(wsp<bf16_t>(F, WS_WUK + (size_t)l * WUK_SZ) + (size_t)640 * 512, (size_t)128 * 512, gtid, gth);
            zero_rows(wsp<bf16_t>(F, WS_WUV + (size_t)l * WUK_SZ) + (size_t)640 * 512, (size_t)128 * 512, gtid, gth);
        }
    }
}

__device__ __forceinline__ void norm_mod_phase(Frame& F, const float* g, const float* shift0, const float* scale0, int row_lo, int nrows, int nsplit, const float* xin_lat = nullptr, const float* xin_ctx = nullptr) {
    const int gw = F.vcu * NWAVES + F.wave, NGW = F.G * NWAVES, lane = (tid_of(F.wave) & 63);
    float* xs = wsp<float>(F, WS_XS); bf16_t* H = wsp<bf16_t>(F, WS_H);
    for (int m = row_lo + gw; m < nrows; m += NGW) {
        const int mr = m < SEQ ? 0 : (m < ML ? 1 : 2);
        const f32x4* xr = (const f32x4*)(xin_lat ? (m < ML ? xin_lat + (size_t)m * D : xin_ctx + (size_t)(m - ML) * D) : xs + (size_t)m * LDX) + lane;
        const f32x4* g4 = (const f32x4*)g + lane; const f32x4* sh4 = (const f32x4*)(shift0 + (size_t)mr * MODLD) + lane; const f32x4* sc4 = (const f32x4*)(scale0 + (size_t)mr * MODLD) + lane;
        f32x4 v[8], gv[8], shv[8], scv[8]; float s = 0.f;
#pragma unroll
        for (int j = 0; j < 8; ++j) v[j] = xr[64 * j];
#pragma unroll
        for (int j = 0; j < 8; ++j) { gv[j] = g4[64 * j]; shv[j] = sh4[64 * j]; scv[j] = sc4[64 * j]; }
        if (m >= ML && (nsplit > 0 || xin_lat)) {
            const f32x4* pr = (const f32x4*)(wsp<float>(F, WS_PART) + (size_t)(m - ML) * LDX) + lane;
            for (int sp = 0; sp < nsplit; ++sp) {
#pragma unroll
                for (int j = 0; j < 8; ++j) v[j] = v[j] + pr[(size_t)sp * (MC * LDX / 4) + 64 * j]; }
            f32x4* xw = (f32x4*)(xs + (size_t)m * LDX) + lane;
#pragma unroll
            for (int j = 0; j < 8; ++j) xw[64 * j] = v[j];
        }
#pragma unroll
        for (int j = 0; j < 8; ++j) s += (v[j][0] * v[j][0] + v[j][1] * v[j][1]) + (v[j][2] * v[j][2] + v[j][3] * v[j][3]);
        const float rstd = 1.0f / sqrtf(wave_sum(s) * (1.0f / D) + NORM_EPS);
        u32x2* o8 = (u32x2*)(H + (size_t)m * LDH) + lane;
#pragma unroll
        for (int j = 0; j < 8; ++j) { const f32x4 gg = gv[j], sh = shv[j], sc = scv[j];
            const f32x4 y = v[j] * rstd * gg * (sc + 1.0f) + sh;
            u32x2 w; w.x = pk2(y[0], y[1]); w.y = pk2(y[2], y[3]); o8[64 * j] = w; }
    }
}
template <int NSPLIT>
__device__ __forceinline__ void ctx_norm_phase(Frame& F, const float* g, const float* shift0, const float* scale0) {
    const int lane = (tid_of(F.wave) & 63), q = F.wave & 3, col = 512 * q + 4 * lane;
    LAS float* red = (LAS float*)(F.lds + RING_OFF);
    float* xs = wsp<float>(F, WS_XS); bf16_t* H = wsp<bf16_t>(F, WS_H);
    for (int r0 = 2 * F.vcu; r0 < MC; r0 += 2 * F.G) {
        const int rc = r0 + (F.wave >> 2), m = ML + rc;
        float* xr = xs + (size_t)m * LDX + col; const float* pr = wsp<float>(F, WS_PART) + (size_t)rc * LDX + col;
        f32x4 v0 = *(const f32x4*)xr, v1 = *(const f32x4*)(xr + 256), p0[NSPLIT], p1[NSPLIT];
#pragma unroll
        for (int sp = 0; sp < NSPLIT; ++sp) { p0[sp] = *(const f32x4*)(pr + (size_t)sp * MC * LDX); p1[sp] = *(const f32x4*)(pr + (size_t)sp * MC * LDX + 256); }
        const f32x4 g0 = *(const f32x4*)(g + col), g1 = *(const f32x4*)(g + col + 256);
        const f32x4 sh0 = *(const f32x4*)(shift0 + (size_t)2 * MODLD + col), sh1 = *(const f32x4*)(shift0 + (size_t)2 * MODLD + col + 256);
        const f32x4 sc0 = *(const f32x4*)(scale0 + (size_t)2 * MODLD + col), sc1 = *(const f32x4*)(scale0 + (size_t)2 * MODLD + col + 256);
#pragma unroll
        for (int sp = 0; sp < NSPLIT; ++sp) { v0 = v0 + p0[sp]; v1 = v1 + p1[sp]; }
        *(f32x4*)xr = v0; *(f32x4*)(xr + 256) = v1;
        const float ssum = wave_sum(((v0[0] * v0[0] + v0[1] * v0[1]) + (v0[2] * v0[2] + v0[3] * v0[3])) + ((v1[0] * v1[0] + v1[1] * v1[1]) + (v1[2] * v1[2] + v1[3] * v1[3])));
        if (lane == 0) red[F.wave] = ssum;
        __syncthreads();
        const int wb = F.wave & 4;
        const float rstd = 1.0f / sqrtf(((red[wb] + red[wb + 1]) + (red[wb + 2] + red[wb + 3])) * (1.0f / D) + NORM_EPS);
        const f32x4 y0 = v0 * rstd * g0 * (sc0 + 1.0f) + sh0, y1 = v1 * rstd * g1 * (sc1 + 1.0f) + sh1;
        u32x2 w0, w1; w0.x = pk2(y0[0], y0[1]); w0.y = pk2(y0[2], y0[3]); w1.x = pk2(y1[0], y1[1]); w1.y = pk2(y1[2], y1[3]);
        *(u32x2*)(H + (size_t)m * LDH + col) = w0; *(u32x2*)(H + (size_t)m * LDH + col + 256) = w1;
        __syncthreads();
    }
}
struct AttnCtx {
    const bf16_t *naq, *nak, *dq, *dk, *mq, *mk, *vtin, *vtm; bf16_t* omix;
    const float* rpb;
    const float* subln;
    float lam, one_m_li;
};
constexpr int ANQ = 4;
template <int TYPE>
__device__ __forceinline__ void attn_naive_task(const AttnCtx& A, LAS float* Qs, LAS float* Ps, int lane, int b, int h, int qrow0  , bool is_ctx) {
    constexpr int DQ = TYPE == 1 ? 192 : 128;
    constexpr int NS = TYPE == 2 ? 2 : 1;
    const bf16_t* Q; const bf16_t* K; const bf16_t* VT; int ldq, ocol;
    if (TYPE == 0) { Q = A.naq + h * 128; K = A.nak + h * 128; ldq = 768; VT = A.vtin + (size_t)(h * 128) * M; ocol = h * 128; }
    else if (TYPE == 1) { Q = A.mq + h * 192; K = A.mk + h * 192; ldq = 960; VT = A.vtm + (size_t)(h * 128) * M; ocol = 768 + h * 128; }
    else { Q = A.dq + h * 128; K = A.dk + h * 128; ldq = 640; VT = A.vtin + (size_t)(768 + h * 128) * M; ocol = 1408 + h * 128; }
#pragma unroll
    for (int q = 0; q < ANQ; ++q)
#pragma unroll
        for (int d = lane; d < DQ; d += 64) Qs[q * 192 + d] = bf2f(Q[(size_t)(qrow0 + q) * ldq + d]);
    LDS_WAIT(); __builtin_amdgcn_wave_barrier(); asm volatile("" ::: "memory");
    const int t_in = qrow0 & (SEQ - 1), gr = t_in >> 6, qc0 = t_in & 63;
    int r0 = gr - 4; r0 = r0 < 0 ? 0 : (r0 > 56 ? 56 : r0);
    const int nlat = is_ctx ? 0 : (TYPE == 0 ? 8 : 64), ntiles = 4 + nlat;
    float mrun[NS][ANQ], lrun[NS][ANQ], o[NS][ANQ][2];
#pragma unroll
    for (int s = 0; s < NS; ++s)
#pragma unroll
        for (int q = 0; q < ANQ; ++q) { mrun[s][q] = -1e30f; lrun[s][q] = 0.f; o[s][q][0] = 0.f; o[s][q][1] = 0.f; }
    for (int ti = 0; ti < ntiles; ++ti) {
        int tok0, kr = 0; bool local = false;
        if (ti < 4) tok0 = ML + b * CTXL + 64 * ti;
        else if (TYPE == 0) { kr = r0 + (ti - 4); tok0 = b * SEQ + 64 * kr; local = true; }
        else tok0 = b * SEQ + 64 * (ti - 4);
        float s[NS][ANQ];
#pragma unroll
        for (int ss = 0; ss < NS; ++ss)
#pragma unroll
            for (int q = 0; q < ANQ; ++q) s[ss][q] = 0.f;
        const bf16_t* kp = K + (size_t)(tok0 + lane) * ldq;
#pragma unroll 1
        for (int c8 = 0; c8 < DQ / 8; ++c8) {
            const u32x4 kw = *(const u32x4*)(kp + 8 * c8);
            const float k0 = bflo(kw.x), k1 = bfhi(kw.x), k2 = bflo(kw.y), k3 = bfhi(kw.y), k4 = bflo(kw.z), k5 = bfhi(kw.z), k6 = bflo(kw.w), k7 = bfhi(kw.w);
            const int ss = (TYPE == 2 && c8 >= 8) ? 1 : 0;
#pragma unroll
            for (int q = 0; q < ANQ; ++q) { const f32x4 qa = *(const LAS f32x4*)(Qs + q * 192 + 8 * c8), qb = *(const LAS f32x4*)(Qs + q * 192 + 8 * c8 + 4);
                const float dsum = (qa[0] * k0 + qa[1] * k1) + (qa[2] * k2 + qa[3] * k3) + (qb[0] * k4 + qb[1] * k5) + (qb[2] * k6 + qb[3] * k7);
                if (NS == 2) { if (ss == 0) s[0][q] += dsum; else s[NS - 1][q] += dsum; } else s[0][q] += dsum; }
        }
        if (TYPE == 0 && local) {
#pragma unroll
            for (int q = 0; q < ANQ; ++q) { const int qc = qc0 + q; int c0 = qc - 8; c0 = c0 < 0 ? 0 : (c0 > 48 ? 48 : c0);
                const bool ok = lane >= c0 && lane < c0 + 16;
                int co = lane - qc; co = co < -15 ? -15 : (co > 15 ? 15 : co);
                const float bias = A.rpb[(h * 15 + (kr - gr + 7)) * 31 + co + 15] * LOG2E;
                s[0][q] = ok ? s[0][q] + bias : -1e30f; }
        }
#pragma unroll
        for (int ss = 0; ss < NS; ++ss)
#pragma unroll
            for (int q = 0; q < ANQ; ++q) {
                const float tm = wave_max(s[ss][q]); const float mn = fmaxf(mrun[ss][q], tm); const float alpha = fast_exp2(mrun[ss][q] - mn);
                const float p = fast_exp2(s[ss][q] - mn); lrun[ss][q] = lrun[ss][q] * alpha + wave_sum(p); mrun[ss][q] = mn;
                o[ss][q][0] *= alpha; o[ss][q][1] *= alpha;
                Ps[(ss * ANQ + q) * 64 + lane] = p; }
        LDS_WAIT(); __builtin_amdgcn_wave_barrier(); asm volatile("" ::: "memory");
        const bf16_t* v0p = VT + (size_t)(2 * lane) * M + tok0; const bf16_t* v1p = v0p + M;
#pragma unroll 1
        for (int jc = 0; jc < 8; ++jc) {
            const u32x4 a = *(const u32x4*)(v0p + 8 * jc), bq = *(const u32x4*)(v1p + 8 * jc);
            const float va[8] = {bflo(a.x), bfhi(a.x), bflo(a.y), bfhi(a.y), bflo(a.z), bfhi(a.z), bflo(a.w), bfhi(a.w)};
            const float vb[8] = {bflo(bq.x), bfhi(bq.x), bflo(bq.y), bfhi(bq.y), bflo(bq.z), bfhi(bq.z), bflo(bq.w), bfhi(bq.w)};
#pragma unroll
            for (int ss = 0; ss < NS; ++ss)
#pragma unroll
                for (int q = 0; q < ANQ; ++q) { const f32x4 pa = *(const LAS f32x4*)(Ps + (ss * ANQ + q) * 64 + 8 * jc), pb = *(const LAS f32x4*)(Ps + (ss * ANQ + q) * 64 + 8 * jc + 4);
                    o[ss][q][0] += (pa[0] * va[0] + pa[1] * va[1]) + (pa[2] * va[2] + pa[3] * va[3]) + (pb[0] * va[4] + pb[1] * va[5]) + (pb[2] * va[6] + pb[3] * va[7]);
                    o[ss][q][1] += (pa[0] * vb[0] + pa[1] * vb[1]) + (pa[2] * vb[2] + pa[3] * vb[3]) + (pb[0] * vb[4] + pb[1] * vb[5]) + (pb[2] * vb[6] + pb[3] * vb[7]); }
        }
        LDS_WAIT(); __builtin_amdgcn_wave_barrier(); asm volatile("" ::: "memory");
    }
#pragma unroll
    for (int q = 0; q < ANQ; ++q) {
        float r0v, r1v;
        if (NS == 1) { const float il = 1.0f / lrun[0][q]; r0v = o[0][q][0] * il; r1v = o[0][q][1] * il; }
        else { const float i1 = 1.0f / lrun[0][q], i2 = A.lam / lrun[NS - 1][q]; r0v = o[0][q][0] * i1 - o[NS - 1][q][0] * i2; r1v = o[0][q][1] * i1 - o[NS - 1][q][1] * i2;
            const float ssq = wave_sum(r0v * r0v + r1v * r1v); const float rr = (1.0f / sqrtf(ssq * (1.0f / 128.0f) + NORM_EPS)) * A.one_m_li;
            r0v *= rr * A.subln[2 * lane]; r1v *= rr * A.subln[2 * lane + 1]; }
        *(unsigned*)(A.omix + (size_t)(qrow0 + q) * D + ocol + 2 * lane) = pk2(r0v, r1v);
    }
}
__device__ __forceinline__ void attn_naive_phase(Frame& F, const AttnCtx& A, bool with_ctx) {
    const int gw = F.vcu * NWAVES + F.wave, NGW = F.G * NWAVES, lane = (tid_of(F.wave) & 63);
    LAS float* Qs = (LAS float*)(F.lds + RING_OFF + F.wave * 8192); LAS float* Ps = Qs + ANQ * 192;
    constexpr int GPB = SEQ / ANQ, CGPB = CTXL / ANQ;
    constexpr int T_MLA = NBATCH * H_MLA * GPB, T_DF = NBATCH * H_DF * GPB, T_NA = NBATCH * H_NA * GPB, T_LAT = T_MLA + T_DF + T_NA;
    constexpr int C_MLA = NBATCH * H_MLA * CGPB, C_DF = NBATCH * H_DF * CGPB, C_NA = NBATCH * H_NA * CGPB;
    const int total = T_LAT + (with_ctx ? C_MLA + C_DF + C_NA : 0);
    for (int t = gw; t < total; t += NGW) {
        int r = t, type, b, h, g; bool isc = false;
        if (r < T_MLA) { type = 1; b = r / (H_MLA * GPB); h = (r / GPB) % H_MLA; g = r % GPB; }
        else if ((r -= T_MLA) < T_DF) { type = 2; b = r / (H_DF * GPB); h = (r / GPB) % H_DF; g = r % GPB; }
        else if ((r -= T_DF) < T_NA) { type = 0; b = r / (H_NA * GPB); h = (r / GPB) % H_NA; g = r % GPB; }
        else if ((r -= T_NA) < C_MLA) { type = 1; isc = true; b = r / (H_MLA * CGPB); h = (r / CGPB) % H_MLA; g = r % CGPB; }
        else if ((r -= C_MLA) < C_DF) { type = 2; isc = true; b = r / (H_DF * CGPB); h = (r / CGPB) % H_DF; g = r % CGPB; }
        else { r -= C_DF; type = 0; isc = true; b = r / (H_NA * CGPB); h = (r / CGPB) % H_NA; g = r % CGPB; }
        const int qrow0 = isc ? ML + b * CTXL + ANQ * g : b * SEQ + ANQ * g;
        if (type == 1) attn_naive_task<1>(A, Qs, Ps, lane, b, h, qrow0, isc);
        else if (type == 2) attn_naive_task<2>(A, Qs, Ps, lane, b, h, qrow0, isc);
        else attn_naive_task<0>(A, Qs, Ps, lane, b, h, qrow0, isc);
    }
}
typedef float f32x16 __attribute__((ext_vector_type(16)));
typedef __bf16 bf16x2_t __attribute__((ext_vector_type(2)));
__device__ __forceinline__ unsigned cvtpk_c(float lo, float hi) { f32x2 v = {lo, hi}; return __builtin_bit_cast(unsigned, __builtin_convertvector(v, bf16x2_t)); }
template <int DQK> __device__ __forceinline__ int k_off(int r, int c) { return r * (DQK * 2) + 16 * (DQK == 128 ? (c ^ (r & 15)) : (c ^ ((r >> 1) & 7))); }
__device__ __forceinline__ int v_off(int r, int c) { return r * 128 + 16 * (c ^ ((r >> 1) & 7)); }
__device__ __forceinline__ int swap23(int k) { return (k & ~12) | ((k & 4) << 1) | ((k & 8) >> 1); }
constexpr int ATT_KB0 = 0, ATT_KB1 = 24576, ATT_VB0 = 49152, ATT_VB1 = 65536, ATT_RPB = 81920, ATT_LDS_END = 81920 + 2048;
constexpr size_t WS_DTMP = WS_U;
static_assert((size_t)2 * M * 640 * 4 <= (size_t)M * FF * 2, "DTMP fits in U");

struct AUnit { int type, b, h, pass, qrow0, isctx, g; };

template <int TYPE>
__device__ __forceinline__ void attn_mfma_unit(const AttnCtx& A, unsigned char* ws, LAS unsigned char* lds, int tid, const AUnit& u) {
    constexpr int DQK = TYPE == 1 ? 192 : (TYPE == 0 ? 128 : 64);
    constexpr int NKK = DQK / 16, NKC = DQK / 8, KPT = NKC / 8;
    const int w = __builtin_amdgcn_readfirstlane(tid >> 6), lane = tid & 63, q_ = lane & 31, h2_ = lane >> 5;
    const bf16_t* Qg; const bf16_t* Kg; const bf16_t* VTg; int ld;
    if (TYPE == 0) { Qg = A.naq + u.h * 128; Kg = A.nak + u.h * 128; ld = 768; VTg = A.vtin + (size_t)(u.h * 128) * M; }
    else if (TYPE == 1) { Qg = A.mq + u.h * 192; Kg = A.mk + u.h * 192; ld = 960; VTg = A.vtm + (size_t)(u.h * 128) * M; }
    else { Qg = A.dq + u.h * 128 + 64 * u.pass; Kg = A.dk + u.h * 128 + 64 * u.pass; ld = 640; VTg = A.vtin + (size_t)(768 + u.h * 128) * M; }
    const int qrow = u.qrow0 + 32 * w + q_;
    bf16x8 qf[NKK];
#pragma unroll
    for (int kk = 0; kk < NKK; ++kk) qf[kk] = *(const bf16x8*)(Qg + (size_t)qrow * ld + 16 * kk + 8 * h2_);
    int lo = 0, nlat = u.isctx ? 0 : 64, qr = 0, qc = 0, r0w = 0, c0 = 0;
    if (TYPE == 0 && !u.isctx) {
        int a = 4 * u.g - 4; lo = a < 0 ? 0 : (a > 56 ? 56 : a); int hb = 4 * u.g + 3 - 4; hb = hb < 0 ? 0 : (hb > 56 ? 56 : hb); nlat = hb + 8 - lo;
        qr = 4 * u.g + (w >> 1); qc = 32 * (w & 1) + q_; int t = qr - 4; r0w = t < 0 ? 0 : (t > 56 ? 56 : t); t = qc - 8; c0 = t < 0 ? 0 : (t > 48 ? 48 : t);
        LAS float* rp = (LAS float*)(lds + ATT_RPB);
        if (tid < 465) rp[tid] = A.rpb[u.h * 465 + tid] * LOG2E;
    }
    const int nt = 4 + nlat;
    int kgo[KPT], klo[KPT], vgo[2], vlo[2];
#pragma unroll
    for (int i = 0; i < KPT; ++i) { const int ci = tid + 512 * i, row = ci / NKC, c = ci % NKC; kgo[i] = row * ld + 8 * c; klo[i] = k_off<DQK>(swap23(row), c); }
#pragma unroll
    for (int i = 0; i < 2; ++i) { const int ci = tid + 512 * i, ch = ci >> 3, c = ci & 7; vgo[i] = ch * M + 8 * c; vlo[i] = v_off(ch, c); }
    u32x4 kst[KPT], vst[2];
#define ATT_TOK0(ti) ((ti) < 4 ? ML + u.b * CTXL + 64 * (ti) : (TYPE == 0 ? u.b * SEQ + 64 * (lo + (ti) - 4) : u.b * SEQ + 64 * ((ti) - 4)))
#define ATT_LOAD(ti) do { const int _t0 = ATT_TOK0(ti); const bf16_t* _kb = Kg + (size_t)_t0 * ld; const bf16_t* _vb = VTg + _t0; \
        _Pragma("unroll") for (int _i = 0; _i < KPT; ++_i) kst[_i] = *(const u32x4*)(_kb + kgo[_i]); \
        _Pragma("unroll") for (int _i = 0; _i < 2; ++_i) vst[_i] = *(const u32x4*)(_vb + vgo[_i]); } while (0)
#define ATT_WRITE(buf) do { LAS unsigned char* _k = lds + ((buf) ? ATT_KB1 : ATT_KB0); LAS unsigned char* _v = lds + ((buf) ? ATT_VB1 : ATT_VB0); \
        _Pragma("unroll") for (int _i = 0; _i < KPT; ++_i) *(LAS u32x4*)(_k + klo[_i]) = kst[_i]; \
        _Pragma("unroll") for (int _i = 0; _i < 2; ++_i) *(LAS u32x4*)(_v + vlo[_i]) = vst[_i]; } while (0)
    f32x16 o[4];
#pragma unroll
    for (int d0 = 0; d0 < 4; ++d0)
#pragma unroll
        for (int r = 0; r < 16; ++r) o[d0][r] = 0.f;
    float mrun = -1e30f, lrun = 0.f;
    ATT_LOAD(0); ATT_WRITE(0);
    __syncthreads();
    for (int ti = 0; ti < nt; ++ti) {
        const int buf = ti & 1;
        if (ti + 1 < nt) ATT_LOAD(ti + 1);
        bool active = true; int kr = 0;
        if (TYPE == 0 && ti >= 4) { kr = lo + ti - 4; active = (kr >= r0w) && (kr < r0w + 8); }
        if (active) {
            const int q = opaque_v(q_), h2 = opaque_v(h2_);
            const LAS unsigned char* kb = lds + (buf ? ATT_KB1 : ATT_KB0); const LAS unsigned char* vb = lds + (buf ? ATT_VB1 : ATT_VB0);
            f32x16 s0, s1;
#pragma unroll
            for (int r = 0; r < 16; ++r) { s0[r] = 0.f; s1[r] = 0.f; }
#pragma unroll
            for (int kk = 0; kk < NKK; ++kk) {
                const bf16x8 a0 = *(const LAS bf16x8*)(kb + k_off<DQK>(q, 2 * kk + h2));
                const bf16x8 a1 = *(const LAS bf16x8*)(kb + k_off<DQK>(32 + q, 2 * kk + h2));
                s0 = __builtin_amdgcn_mfma_f32_32x32x16_bf16(a0, qf[kk], s0, 0, 0, 0);
                s1 = __builtin_amdgcn_mfma_f32_32x32x16_bf16(a1, qf[kk], s1, 0, 0, 0);
            }
            if (TYPE == 0 && ti >= 4) {
                const LAS float* rp = (const LAS float*)(lds + ATT_RPB) + (kr - qr + 7) * 31 + 15;
#pragma unroll
                for (int r = 0; r < 16; ++r) {
                    const int k0c = 16 * (r >> 3) + 8 * h2 + 4 * ((r >> 2) & 1) + (r & 3), k1c = 32 + k0c;
                    const bool ok0 = (k0c >= c0) && (k0c < c0 + 16), ok1 = (k1c >= c0) && (k1c < c0 + 16);
                    int i0 = k0c - qc; i0 = i0 < -15 ? -15 : (i0 > 15 ? 15 : i0); int i1 = k1c - qc; i1 = i1 < -15 ? -15 : (i1 > 15 ? 15 : i1);
                    const float b0 = rp[i0], b1 = rp[i1];
                    s0[r] = ok0 ? s0[r] + b0 : -1e30f; s1[r] = ok1 ? s1[r] + b1 : -1e30f;
                }
            }
            float tm = s0[0];
#pragma unroll
            for (int r = 1; r < 16; ++r) tm = fmaxf(tm, s0[r]);
#pragma unroll
            for (int r = 0; r < 16; ++r) tm = fmaxf(tm, s1[r]);
            tm = half_max(tm);
            const float mn = fmaxf(mrun, tm), alpha = fast_exp2(mrun - mn);
            float ps = 0.f;
#pragma unroll
            for (int r = 0; r < 16; ++r) { s0[r] = fast_exp2(s0[r] - mn); s1[r] = fast_exp2(s1[r] - mn); ps += s0[r] + s1[r]; }
            ps = half_sum(ps);
            lrun = lrun * alpha + ps; mrun = mn;
#pragma unroll
            for (int d0 = 0; d0 < 4; ++d0)
#pragma unroll
                for (int r = 0; r < 16; ++r) o[d0][r] *= alpha;
            bf16x8 pf[4];
#pragma unroll
            for (int s = 0; s < 2; ++s) {
                u32x4 t0, t1;
                t0.x = cvtpk_c(s0[8 * s + 0], s0[8 * s + 1]); t0.y = cvtpk_c(s0[8 * s + 2], s0[8 * s + 3]); t0.z = cvtpk_c(s0[8 * s + 4], s0[8 * s + 5]); t0.w = cvtpk_c(s0[8 * s + 6], s0[8 * s + 7]);
                t1.x = cvtpk_c(s1[8 * s + 0], s1[8 * s + 1]); t1.y = cvtpk_c(s1[8 * s + 2], s1[8 * s + 3]); t1.z = cvtpk_c(s1[8 * s + 4], s1[8 * s + 5]); t1.w = cvtpk_c(s1[8 * s + 6], s1[8 * s + 7]);
                pf[s] = __builtin_bit_cast(bf16x8, t0); pf[2 + s] = __builtin_bit_cast(bf16x8, t1);
            }
#pragma unroll
            for (int d0 = 0; d0 < 4; ++d0)
#pragma unroll
                for (int ks = 0; ks < 4; ++ks) {
                    const bf16x8 av = *(const LAS bf16x8*)(vb + v_off(32 * d0 + q, 2 * ks + h2));
                    o[d0] = __builtin_amdgcn_mfma_f32_32x32x16_bf16(av, pf[ks], o[d0], 0, 0, 0);
                }
        }
        if (ti + 1 < nt) ATT_WRITE(buf ^ 1);
        __syncthreads();
    }
#undef ATT_TOK0
#undef ATT_LOAD
#undef ATT_WRITE
    const int h2 = h2_;
    const float il = 1.0f / lrun;
    if (TYPE == 2) {
        float* dst = (float*)(ws + WS_DTMP) + ((size_t)u.pass * M + qrow) * 640 + u.h * 128 + 4 * h2;
#pragma unroll
        for (int d0 = 0; d0 < 4; ++d0)
#pragma unroll
            for (int i = 0; i < 4; ++i) { f32x4 v = {o[d0][4 * i] * il, o[d0][4 * i + 1] * il, o[d0][4 * i + 2] * il, o[d0][4 * i + 3] * il}; *(f32x4*)(dst + 32 * d0 + 8 * i) = v; }
    } else {
        bf16_t* dst = A.omix + (size_t)qrow * D + (TYPE == 0 ? 0 : 768) + u.h * 128 + 4 * h2;
#pragma unroll
        for (int d0 = 0; d0 < 4; ++d0)
#pragma unroll
            for (int i = 0; i < 4; ++i) { u32x2 v; v.x = cvtpk_c(o[d0][4 * i] * il, o[d0][4 * i + 1] * il); v.y = cvtpk_c(o[d0][4 * i + 2] * il, o[d0][4 * i + 3] * il); *(u32x2*)(dst + 32 * d0 + 8 * i) = v; }
    }
}

#ifndef ATTN_PRIO
#define ATTN_PRIO 1
#endif
#ifndef ATTN_ALLLATE
#define ATTN_ALLLATE 1
#endif
#ifndef ATTN_PIPE_MASK
#define ATTN_PIPE_MASK 0
#endif
constexpr float ATT_THR = 8.0f;
constexpr int A2_RPB = 122880;

template <int TYPE>
__device__ __forceinline__ void attn_mfma_unit2(const AttnCtx& A, unsigned char* ws, LAS unsigned char* lds, int tid, const AUnit& u) {
    constexpr int DQK = TYPE == 1 ? 192 : (TYPE == 0 ? 128 : 64);
    constexpr int NKK = DQK / 16, NKC = DQK / 8, PITCH = DQK * 2, KB = 64 * PITCH;
    constexpr int NIK = KB / 8192, NIW = NIK + 2;
    constexpr int NKB = DQK == 128 ? 8 : 4;
    constexpr int STG = KB + 16384;
    const int w = __builtin_amdgcn_readfirstlane(tid >> 6), lane = tid & 63, q = lane & 31, h2 = lane >> 5;
    const bf16_t* Qg; const bf16_t* Kg; const bf16_t* VTg; int ld;
    if (TYPE == 0) { Qg = A.naq + u.h * 128; Kg = A.nak + u.h * 128; ld = 768; VTg = A.vtin + (size_t)(u.h * 128) * M; }
    else if (TYPE == 1) { Qg = A.mq + u.h * 192; Kg = A.mk + u.h * 192; ld = 960; VTg = A.vtm + (size_t)(u.h * 128) * M; }
    else { Qg = A.dq + u.h * 128 + 64 * u.pass; Kg = A.dk + u.h * 128 + 64 * u.pass; ld = 640; VTg = A.vtin + (size_t)(768 + u.h * 128) * M; }
#if ATTN_PRIO
    if (w < 4) __builtin_amdgcn_s_setprio(2); else __builtin_amdgcn_s_setprio(0);
#endif
    const int qrow = u.qrow0 + 32 * w + q;
    bf16x8 qf[NKK];
#pragma unroll
    for (int kk = 0; kk < NKK; ++kk) qf[kk] = *(const bf16x8*)(Qg + (size_t)qrow * ld + 16 * kk + 8 * h2);
    int lo = 0, nlat = u.isctx ? 0 : 64, qr = 0, qc = 0, r0w = 0, c0 = 0;
    if (TYPE == 0 && !u.isctx) {
        int a = 4 * u.g - 4; lo = a < 0 ? 0 : (a > 56 ? 56 : a); int hb = 4 * u.g + 3 - 4; hb = hb < 0 ? 0 : (hb > 56 ? 56 : hb); nlat = hb + 8 - lo;
        qr = 4 * u.g + (w >> 1); qc = 32 * (w & 1) + q; int t = qr - 4; r0w = t < 0 ? 0 : (t > 56 ? 56 : t); t = qc - 8; c0 = t < 0 ? 0 : (t > 48 ? 48 : t);
        LAS float* rp = (LAS float*)(lds + A2_RPB);
        if (tid < 465) rp[tid] = A.rpb[u.h * 465 + tid] * LOG2E;
    }
    const int nt = 4 + nlat;
    unsigned goff[NIW];
#pragma unroll
    for (int m = 0; m < NIW; ++m) {
        if (m < NIK) { const int p = 64 * (w + 8 * m) + lane, row = p / NKC, slot = p % NKC; const int c = DQK == 128 ? (slot ^ (row & 15)) : (slot ^ ((row >> 1) & 7)); goff[m] = (unsigned)(swap23(row) * ld + 8 * c); }
        else { const int p = 64 * (w + 8 * (m - NIK)) + lane, ch = p >> 3, slot = p & 7; const int c = slot ^ ((ch >> 1) & 7); goff[m] = (unsigned)(ch * M + 8 * c); }
    }
    const unsigned ldsw = (unsigned)w * 1024u;
    unsigned kbase[NKB], vbase[4];
#pragma unroll
    for (int i = 0; i < NKB; ++i) kbase[i] = (unsigned)(q * PITCH + 16 * (DQK == 128 ? ((2 * i + h2) ^ (q & 15)) : ((2 * i + h2) ^ ((q >> 1) & 7))));
#pragma unroll
    for (int i = 0; i < 4; ++i) vbase[i] = (unsigned)(KB + q * 128 + 16 * ((2 * i + h2) ^ ((q >> 1) & 7)));
#define A2_TOK0(ti) ((ti) < 4 ? ML + u.b * CTXL + 64 * (ti) : (TYPE == 0 ? u.b * SEQ + 64 * (lo + (ti) - 4) : u.b * SEQ + 64 * ((ti) - 4)))
#define A2_DMA(ti, SOFF) do { const int _t0 = A2_TOK0(ti); const bf16_t* _kb = Kg + (size_t)_t0 * ld; const bf16_t* _vb = VTg + _t0; \
        _Pragma("unroll") for (int _m = 0; _m < NIK; ++_m) __builtin_amdgcn_global_load_lds((const unsigned*)(_kb + goff[_m]), (LAS unsigned*)(lds + (SOFF) + ldsw + _m * 8192), 16, 0, 0); \
        _Pragma("unroll") for (int _m = 0; _m < 2; ++_m) __builtin_amdgcn_global_load_lds((const unsigned*)(_vb + goff[NIK + _m]), (LAS unsigned*)(lds + (SOFF) + KB + ldsw + _m * 8192), 16, 0, 0); } while (0)
#define A2_WAITN(n) asm volatile("s_waitcnt vmcnt(%0)" :: "n"(n) : "memory")
#define A2_BAR() do { __builtin_amdgcn_s_barrier(); asm volatile("" ::: "memory"); } while (0)
#define A2_KRD(kk, blk, KBUF) (*(const LAS bf16x8*)(lds + (DQK == 128 ? kc[kk] : kc[(kk) & 3]) + ((blk) * 32 * PITCH + (DQK == 128 ? 0 : 128 * ((kk) >> 2)))))
#define A2_VRD(d0, ks, VBUF) (*(const LAS bf16x8*)(lds + vc[ks] + (4096 * (d0))))
    f32x16 o[4];
#pragma unroll
    for (int d0 = 0; d0 < 4; ++d0)
#pragma unroll
        for (int r = 0; r < 16; ++r) o[d0][r] = 0.f;
    float mref = 0.f, lrun = 0.f; bool first = true;
    constexpr bool PIPE = (ATTN_PIPE_MASK >> TYPE) & 1;
    f32x16 sA0, sA1, sB0, sB1; bool actA = true, actB = true; bf16x8 pf[4], fa[4], fb[4];
#define A2_ACTIVE(ti) (!(TYPE == 0 && (ti) >= 4) || ((lo + (ti) - 4 >= r0w) && (lo + (ti) - 4 < r0w + 8)))
#define A2_LDK4(dst, p, KBUF) do { dst[0] = A2_KRD(2 * (p), 0, KBUF); dst[1] = A2_KRD(2 * (p), 1, KBUF); dst[2] = A2_KRD(2 * (p) + 1, 0, KBUF); dst[3] = A2_KRD(2 * (p) + 1, 1, KBUF); } while (0)
#define A2_MMK4(src, p, S0, S1) do { S0 = __builtin_amdgcn_mfma_f32_32x32x16_bf16(src[0], qf[2 * (p)], S0, 0, 0, 0); S1 = __builtin_amdgcn_mfma_f32_32x32x16_bf16(src[1], qf[2 * (p)], S1, 0, 0, 0); \
        S0 = __builtin_amdgcn_mfma_f32_32x32x16_bf16(src[2], qf[2 * (p) + 1], S0, 0, 0, 0); S1 = __builtin_amdgcn_mfma_f32_32x32x16_bf16(src[3], qf[2 * (p) + 1], S1, 0, 0, 0); } while (0)
#define A2_SCHED() __builtin_amdgcn_sched_barrier(0)
#define A2_QK(S0, S1, ti, KBUF) do { \
        { const float _nm = -mref;        \
        _Pragma("unroll") for (int _r = 0; _r < 16; ++_r) { S0[_r] = _nm; S1[_r] = _nm; } } \
        if constexpr (TYPE == 0) {        \
            _Pragma("unroll") for (int _p = 0; _p < NKK / 2; ++_p) { A2_LDK4(fa, _p, KBUF); A2_MMK4(fa, _p, S0, S1); } \
        } else { \
        A2_LDK4(fa, 0, KBUF); \
        _Pragma("unroll") for (int _p = 0; _p < NKK / 2; _p += 2) { \
            A2_LDK4(fb, _p + 1, KBUF); A2_SCHED(); A2_MMK4(fa, _p, S0, S1); A2_SCHED(); \
            if (_p + 2 < NKK / 2) A2_LDK4(fa, _p + 2, KBUF); A2_SCHED(); A2_MMK4(fb, _p + 1, S0, S1); A2_SCHED(); } } \
        if (TYPE == 0 && (ti) >= 4) { const int _kr = lo + (ti) - 4; \
            const int _lb = opaque_v(c0 - 8 * h2);                        \
            const LAS float* _rp = (const LAS float*)(lds + A2_RPB) + ((_kr - qr + 7) * 31 + 15) + opaque_v(8 * h2 - qc); \
            _Pragma("unroll") for (int _r = 0; _r < 16; ++_r) { const int _k0 = 16 * (_r >> 3) + 4 * ((_r >> 2) & 1) + (_r & 3), _k1 = 32 + _k0; \
                const bool _ok0 = (unsigned)(_k0 - _lb) < 16u, _ok1 = (unsigned)(_k1 - _lb) < 16u; \
                S0[_r] = _ok0 ? S0[_r] + _rp[_k0] : -1e30f; S1[_r] = _ok1 ? S1[_r] + _rp[_k1] : -1e30f; } } } while (0)
#define A2_PSM(S0, S1) do { \
        float _tm = S0[0]; \
        _Pragma("unroll") for (int _r = 1; _r < 16; ++_r) _tm = fmaxf(_tm, S0[_r]); \
        _Pragma("unroll") for (int _r = 0; _r < 16; ++_r) _tm = fmaxf(_tm, S1[_r]); \
        _tm = half_max(_tm); \
        if (first || !__all(_tm <= ATT_THR)) { \
            const float _sh = first ? _tm : fmaxf(_tm, 0.f), _al = first ? 0.f : fast_exp2(-_sh); \
            mref += _sh; lrun *= _al; first = false; \
            _Pragma("unroll") for (int _d = 0; _d < 4; ++_d) _Pragma("unroll") for (int _r = 0; _r < 16; ++_r) o[_d][_r] *= _al; \
            _Pragma("unroll") for (int _r = 0; _r < 16; ++_r) { S0[_r] -= _sh; S1[_r] -= _sh; } } } while (0)
#define A2_LDV4(dst, d0, VBUF) do { dst[0] = A2_VRD(d0, 0, VBUF); dst[1] = A2_VRD(d0, 1, VBUF); dst[2] = A2_VRD(d0, 2, VBUF); dst[3] = A2_VRD(d0, 3, VBUF); } while (0)
#define A2_MMV4(src, d0) do { _Pragma("unroll") for (int _ks = 0; _ks < 4; ++_ks) o[d0] = __builtin_amdgcn_mfma_f32_32x32x16_bf16(src[_ks], pf[_ks], o[d0], 0, 0, 0); } while (0)
#define A2_LDVK(dst, ks) do { dst[0] = A2_VRD(0, ks, 0); dst[1] = A2_VRD(1, ks, 0); dst[2] = A2_VRD(2, ks, 0); dst[3] = A2_VRD(3, ks, 0); } while (0)
#define A2_MMVK(src, ks) do { _Pragma("unroll") for (int _d = 0; _d < 4; ++_d) o[_d] = __builtin_amdgcn_mfma_f32_32x32x16_bf16(src[_d], pf[ks], o[_d], 0, 0, 0); } while (0)
#define A2_EXP8(S, off, ks) do { \
        _Pragma("unroll") for (int _r = 0; _r < 8; ++_r) { S[(off) + _r] = fast_exp2(S[(off) + _r]); } \
        _ps += ((S[(off) + 0] + S[(off) + 1]) + (S[(off) + 2] + S[(off) + 3])) + ((S[(off) + 4] + S[(off) + 5]) + (S[(off) + 6] + S[(off) + 7])); \
        u32x4 _t; _t.x = cvtpk_c(S[(off) + 0], S[(off) + 1]); _t.y = cvtpk_c(S[(off) + 2], S[(off) + 3]); _t.z = cvtpk_c(S[(off) + 4], S[(off) + 5]); _t.w = cvtpk_c(S[(off) + 6], S[(off) + 7]); \
        pf[ks] = __builtin_bit_cast(bf16x8, _t); } while (0)
#define A2_FSM_PV(S0, S1, VBUF) do { float _ps = 0.f; \
        A2_LDVK(fa, 0); A2_SCHED(); \
        A2_EXP8(S0, 0, 0); A2_LDVK(fb, 1); A2_SCHED(); A2_MMVK(fa, 0); A2_SCHED(); \
        A2_EXP8(S0, 8, 1); A2_LDVK(fa, 2); A2_SCHED(); A2_MMVK(fb, 1); A2_SCHED(); \
        A2_EXP8(S1, 0, 2); A2_LDVK(fb, 3); A2_SCHED(); A2_MMVK(fa, 2); A2_SCHED(); \
        A2_EXP8(S1, 8, 3); A2_SCHED(); A2_MMVK(fb, 3); A2_SCHED(); \
        lrun += half_sum(_ps); } while (0)

    (void)PIPE; (void)actA; (void)actB; (void)sB0; (void)sB1;
    A2_DMA(0, 0);
    asm volatile("s_waitcnt lgkmcnt(0)" ::: "memory");
    A2_WAITN(0); A2_BAR();
#define A2_SETKC(SOFF) _Pragma("unroll") for (int _i = 0; _i < NKB; ++_i) kc[_i] = kbase[_i] + (unsigned)(SOFF)
#define A2_SETVC(SOFF) _Pragma("unroll") for (int _i = 0; _i < 4; ++_i) vc[_i] = vbase[_i] + (unsigned)(SOFF)
    unsigned kc[NKB], vc[4];
    int scur = 0, snxt = STG, sprv = 0;
    if (w < 4 && !ATTN_ALLLATE) {
        for (int ti = 0; ti < nt; ++ti) {
            if (ti + 1 < nt) A2_DMA(ti + 1, snxt);
            if (A2_ACTIVE(ti)) { A2_SETKC(scur); A2_SETVC(scur); A2_QK(sA0, sA1, ti, 0); A2_PSM(sA0, sA1); A2_FSM_PV(sA0, sA1, 0); }
            A2_WAITN(0); A2_BAR();
            sprv = scur; scur = snxt; snxt = snxt == 2 * STG ? 0 : snxt + STG;
        }
    } else {
        bool actP = false;
        for (int ti = 0; ti < nt; ++ti) {
            if (ti + 1 < nt) A2_DMA(ti + 1, snxt);
            if (actP) { A2_SETVC(sprv); A2_FSM_PV(sA0, sA1, 0); }
            actP = A2_ACTIVE(ti);
            if (actP) { A2_SETKC(scur); A2_QK(sA0, sA1, ti, 0); A2_PSM(sA0, sA1); }
            A2_WAITN(0); A2_BAR();
            sprv = scur; scur = snxt; snxt = snxt == 2 * STG ? 0 : snxt + STG;
        }
        if (actP) { A2_SETVC(sprv); A2_FSM_PV(sA0, sA1, 0); }
    }
#undef A2_SETKC
#undef A2_SETVC
    asm volatile("" ::: "memory"); __builtin_amdgcn_s_barrier(); asm volatile("" ::: "memory");
#undef A2_TOK0
#undef A2_DMA
#undef A2_WAITN
#undef A2_BAR
#undef A2_KRD
#undef A2_VRD
#undef A2_ACTIVE
#undef A2_QK
#undef A2_LDK4
#undef A2_MMK4
#undef A2_LDV4
#undef A2_MMV4
#undef A2_SCHED
#undef A2_PSM
#undef A2_FSM_PV
#undef A2_LDVK
#undef A2_MMVK
#undef A2_EXP8
#if ATTN_PRIO
    __builtin_amdgcn_s_setprio(0);
#endif
    const float il = 1.0f / lrun;
    const int lane_e = lane_id(), q_e = lane_e & 31, h2_e = lane_e >> 5, qrow_e = u.qrow0 + 32 * w + q_e;
    if (TYPE == 2) {
        float* dst = (float*)(ws + WS_DTMP) + ((size_t)u.pass * M + qrow_e) * 640 + u.h * 128 + 4 * h2_e;
#pragma unroll
        for (int d0 = 0; d0 < 4; ++d0)
#pragma unroll
            for (int i = 0; i < 4; ++i) { f32x4 v = {o[d0][4 * i] * il, o[d0][4 * i + 1] * il, o[d0][4 * i + 2] * il, o[d0][4 * i + 3] * il}; *(f32x4*)(dst + 32 * d0 + 8 * i) = v; }
    } else {
        bf16_t* dst = A.omix + (size_t)qrow_e * D + (TYPE == 0 ? 0 : 768) + u.h * 128 + 4 * h2_e;
#pragma unroll
        for (int d0 = 0; d0 < 4; ++d0)
#pragma unroll
            for (int i = 0; i < 4; ++i) { u32x2 v; v.x = cvtpk_c(o[d0][4 * i] * il, o[d0][4 * i + 1] * il); v.y = cvtpk_c(o[d0][4 * i + 2] * il, o[d0][4 * i + 3] * il); *(u32x2*)(dst + 32 * d0 + 8 * i) = v; }
    }
}
#ifndef ATTN_V2
#define ATTN_V2 1
#endif
__device__ __forceinline__ bool attn_unit_decode(int x, int i, bool with_ctx, AUnit& u) {
    u.pass = 0; u.isctx = 0; u.g = 0;
    if (i < 20) { const int item = 5 * x + (i >> 2), pair = item >> 2, qb = 4 * (item & 3) + (i & 3); u.type = 1; u.b = pair / 5; u.h = pair % 5; u.qrow0 = u.b * SEQ + 256 * qb; return true; } i -= 20;
    if (i < 40) { const int item = 5 * x + (i >> 3), pair = item >> 2, qb = 4 * (item & 3) + ((i & 7) >> 1); u.type = 2; u.b = pair / 5; u.h = pair % 5; u.pass = i & 1; u.qrow0 = u.b * SEQ + 256 * qb; return true; } i -= 40;
    if (i < 24) { const int item = 6 * x + (i >> 2), pair = item >> 2, g = 4 * (item & 3) + (i & 3); u.type = 0; u.b = pair / 6; u.h = pair % 6; u.g = g; u.qrow0 = u.b * SEQ + 256 * g; return true; } i -= 24;
    if (!with_ctx) return false;
    int c = x + 8 * i; u.isctx = 1;
    if (c < 10) { u.type = 1; u.b = c / 5; u.h = c % 5; u.qrow0 = ML + u.b * CTXL; return true; } c -= 10;
    if (c < 20) { u.type = 2; u.b = c / 10; u.h = (c >> 1) % 5; u.pass = c & 1; u.qrow0 = ML + u.b * CTXL; return true; } c -= 20;
    if (c < 12) { u.type = 0; u.b = c / 6; u.h = c % 6; u.qrow0 = ML + u.b * CTXL; return true; }
    return false;
}
__device__ __forceinline__ void attn_mfma_phase(Frame& F, const AttnCtx& A, bool with_ctx, gu32* qheads, int type_mask = 7) {
    volatile LAS unsigned* slot = F.MISC;
    const int x0 = (int)(xb_xcc_id() & 7u);
    for (int k = 0; k < 8; ++k) {
        const int x = (x0 + k) & 7;
        if (k == 1) {
            const int t = tid_of(F.wave);
            if (t < 8) { const unsigned hv = __hip_atomic_load(qheads + 64 * t, RLX_AGENT); slot[32 + t] = ((int)hv < 84 + (with_ctx ? (t < 2 ? 6 : 5) : 0)) ? 1u : 0u; }
            __syncthreads();
        }
        if (k >= 1 && slot[32 + x] == 0u) continue;
        for (;;) {
            if (tid_of(F.wave) == 0) slot[0] = __hip_atomic_fetch_add(qheads + 64 * x, 1u, RLX_AGENT);
            __syncthreads();
            const int ui = (int)slot[0];
            AUnit u;
            const bool ok = attn_unit_decode(x, ui, with_ctx, u);
            if (ok && ((type_mask >> u.type) & 1)) {
#if ATTN_V2
                if (u.type == 1) attn_mfma_unit2<1>(A, F.ws, F.lds + RING_OFF, tid_of(F.wave), u);
                else if (u.type == 2) attn_mfma_unit2<2>(A, F.ws, F.lds + RING_OFF, tid_of(F.wave), u);
                else attn_mfma_unit2<0>(A, F.ws, F.lds + RING_OFF, tid_of(F.wave), u);
#else
                if (u.type == 1) attn_mfma_unit<1>(A, F.ws, F.lds + RING_OFF, tid_of(F.wave), u);
                else if (u.type == 2) attn_mfma_unit<2>(A, F.ws, F.lds + RING_OFF, tid_of(F.wave), u);
                else attn_mfma_unit<0>(A, F.ws, F.lds + RING_OFF, tid_of(F.wave), u);
#endif
            }
            __syncthreads();
            if (!ok) break;
        }
    }
}
__device__ __forceinline__ void diff_combine_phase(Frame& F, const AttnCtx& A, int nrows, bool zero_ctx_y) {
    const int gw = F.vcu * NWAVES + F.wave, NGW = F.G * NWAVES, lane = (tid_of(F.wave) & 63);
    const float* t1 = (const float*)(F.ws + WS_DTMP); const float* t2 = t1 + (size_t)M * 640;
    const float g0 = A.subln[2 * lane], g1 = A.subln[2 * lane + 1];
    if (zero_ctx_y) {
        unsigned long long* yz = (unsigned long long*)(F.ws + WS_Y + (size_t)ML * D * 2);
        const unsigned long long z = (unsigned long long)(unsigned)opaque_v(0);
        for (int i = gw * 64 + lane; i < MC * D * 2 / 8; i += NGW * 64) __hip_atomic_store(yz + i, z, __ATOMIC_RELAXED, __HIP_MEMORY_SCOPE_AGENT);
    }
    for (int row = gw; row < nrows; row += NGW) {
        const size_t off = (size_t)row * 640 + 2 * lane;
        f32x2 a[H_DF], b[H_DF];
#pragma unroll
        for (int h = 0; h < H_DF; ++h) { a[h] = *(const f32x2*)(t1 + off + h * 128); b[h] = *(const f32x2*)(t2 + off + h * 128); }
#pragma unroll
        for (int h = 0; h < H_DF; ++h) {
            const float r0 = a[h][0] - A.lam * b[h][0], r1 = a[h][1] - A.lam * b[h][1];
            const float ssq = wave_sum(r0 * r0 + r1 * r1); const float rr = (1.0f / sqrtf(ssq * (1.0f / 128.0f) + NORM_EPS)) * A.one_m_li;
            *(unsigned*)(A.omix + (size_t)row * D + 1408 + h * 128 + 2 * lane) = pk2(r0 * rr * g0, r1 * rr * g1);
        }
    }
}
#ifndef PROBE_PRO
#define PROBE_PRO 0
#endif
#ifndef PROBE_FFNIN
#define PROBE_FFNIN 0
#endif
#ifndef PROBE_ATTN
#define PROBE_ATTN 0
#endif
#ifndef PROBE_NULLEPI
#define PROBE_NULLEPI 0
#endif
#ifndef PROBE_FFNOUT
#define PROBE_FFNOUT 0
#endif
#ifndef PROBE_NORM
#define PROBE_NORM 0
#endif
#ifndef PROBE_INPROJ
#define PROBE_INPROJ 0
#endif
#ifndef PROBE_MLAUP
#define PROBE_MLAUP 0
#endif
#ifndef PROBE_MERGE
#define PROBE_MERGE 0
#endif
#ifndef PROBE_BAR
#define PROBE_BAR 0
#endif
#ifndef ATTN_NAIVE
#define ATTN_NAIVE 0
#endif
#ifndef WCV_RES
#define WCV_RES 5632
#endif
#ifndef WCV_CONV
#define WCV_CONV 8
#endif
#ifndef MK_SPLIT
#define MK_SPLIT 0
#endif
__global__ void __launch_bounds__(NTHREADS, 2) dit_fwd(Args args) {
    extern __shared__ __attribute__((aligned(16))) unsigned char lds[];
    Frame F;
    F.lds = (LAS unsigned char*)lds;
    F.MISC = (volatile LAS unsigned*)(F.lds + MISC_OFF);
    F.wave = __builtin_amdgcn_readfirstlane((int)threadIdx.x >> 6);
    F.G = gridDim.x; { const int bx = blockIdx.x; F.vcu = (F.G % 8 == 0) ? (bx % 8) * (F.G / 8) + bx / 8 : bx; }
    F.ws = args.ws; F.ctl = (gu32*)(args.ws + WS_CTL);
    for (int u = (int)threadIdx.x; u < (LDS_BYTES - LDSCTL_OFF) / 4; u += NTHREADS) ((LAS unsigned*)(F.lds + LDSCTL_OFF))[u] = 0u;
    __syncthreads();
    { LAS float* rc = (LAS float*)(F.lds + ROPE_LDS);
      for (int i = (int)threadIdx.x; i < 1024; i += NTHREADS) { const int pos = i >> 4, fi = i & 15; const float fr = powf(10000.0f, -(float)fi / 16.0f); const float ang = (float)pos * fr; rc[i] = cosf(ang); rc[1024 + i] = sinf(ang); } }
    XcdBarrier bar; bar.bar = (unsigned*)(F.ctl + CW_BAR); bar.x = 0; bar.st = nullptr; bar.wave = F.wave;
    if (!MK_SPLIT) bar = xcd_barrier_post((unsigned*)(F.ctl + CW_BAR), F.MISC + 8, F.wave);
    const int lo = args.ph_lo, hi = args.ph_hi; int ph = 0;
#define PH_BEGIN if (lo <= ph && ph < hi) {
#define PH_END   if (!MK_SPLIT) xcd_barrier(bar); } ++ph;

    float* mod = wsp<float>(F, WS_MOD);
    const int G = F.G, cid = (int)blockIdx.x;
    LAS unsigned char* ring = F.lds + RING_OFF;

    PH_BEGIN p0_prologue(F, args, true); PH_END
#if PROBE_PRO
    PH_BEGIN p0_prologue(F, args, false); PH_END
#endif

    for (int s = 0; s < 2 * DEPTH; ++s) {
        const int l = s >> 1, j = s & 1, li = s;
        const bool last = (l == DEPTH - 1);
        const float* modl = mod + (size_t)l * 3 * MODLD;
        const int nM_f = (j == 1 && last) ? 32 : 34;
        if (s == 0) { PH_BEGIN norm_mod_phase(F, args.in[I_NORMW] + (size_t)(l * 3) * D, modl, modl + D, 0, M, 0, args.in[I_X], args.in[I_CTX]); PH_END }
        else if (nM_f == 34) { PH_BEGIN { if (j == 0) ctx_norm_phase<11>(F, args.in[I_NORMW] + (size_t)(l * 3) * D, modl, modl + D); else ctx_norm_phase<8>(F, args.in[I_NORMW] + (size_t)(l * 3 + 2) * D, modl + 6 * D, modl + 7 * D); } PH_END }
        PH_BEGIN {
            pg8::Gemm g{wsp<bf16_t>(F, WS_H), wsp<bf16_t>(F, WS_WFI + (size_t)li * WFI_SZ)};
            pg8::SegSched S; S.init(0, nM_f, FF / 128, G, cid, 0, D / 64);
            pg8::EpiSwiGLU E{wsp<bf16_t>(F, WS_U)};
            { const int rem = (nM_f * (FF / 128)) % G; int cL = 0, cH = 0, cslot = 0, clo = 0, chi = 0;
              if (s == 0) { cslot = 2048; clo = wcv::I_FI; chi = wcv::I_FI + wcv::I_FO; }
              else if (s == 1) { cL = 1; cslot = 3584; clo = wcv::NH0 - WCV_RES; chi = wcv::NH0; }
              else if (s == 2) { cL = 1; cH = 1; cslot = 4096; clo = wcv::NH1 - wcv::I_FO - WCV_RES; chi = wcv::NH1 - wcv::I_FO; }
              if (chi > clo && (rem == 0 || cid >= rem)) { convert_fill(F, args, cL, cH, F.ctl + CW_WCV + cslot, clo, chi); __syncthreads(); } }
            pg8::gemm_phase<pg8::EpiSwiGLU, pg8::SegSched, LDH, D>(ring, g, S, E, F.wave);
            if (s == 2 * DEPTH - 1) convert_fill(F, args, DEPTH - 1, 1, F.ctl + CW_WCV + 1024, wcv::NH1 - wcv::I_FO, wcv::NH1);
        } PH_END
#if PROBE_FFNIN
        PH_BEGIN {
            pg8::Gemm g{wsp<bf16_t>(F, WS_H), wsp<bf16_t>(F, WS_WFI + (size_t)li * WFI_SZ)};
            pg8::SegSched S; S.init(0, nM_f, FF / 128, G, cid, 0, PROBE_FFNIN);
#if PROBE_NULLEPI
            pg8::EpiNull E{wsp<float>(F, WS_YF)};
            pg8::gemm_phase<pg8::EpiNull, pg8::SegSched, LDH, D>(ring, g, S, E, F.wave);
#else
            pg8::EpiSwiGLU E{wsp<bf16_t>(F, WS_YF)};
            pg8::gemm_phase<pg8::EpiSwiGLU, pg8::SegSched, LDH, D>(ring, g, S, E, F.wave);
#endif
        } PH_END
#endif
        PH_BEGIN {
            pg8::Gemm g{wsp<bf16_t>(F, WS_U), wsp<bf16_t>(F, WS_WFO + (size_t)li * WFO_SZ)};
            pg8::ResidSched<11, 512> S; S.init(D / 256, G, cid, FF / 64, nM_f == 34);
            const bool fin = (j == 1 && last);
            const float* ng = fin ? args.in[I_FNORM] : (j == 0 ? args.in[I_NORMW] + (size_t)(l * 3 + 1) * D : args.in[I_NORMW] + (size_t)((l + 1) * 3) * D);
            const float* nsh = j == 0 ? modl + 3 * D : (fin ? modl : mod + (size_t)(l + 1) * 3 * MODLD);
            pg8::EpiResidNorm E{F.ws, modl + (j ? 8 : 2) * D, ng, nsh, fin ? args.out : nullptr, s == 0 ? args.in[I_X] : nullptr, 0.5f, 3 * l + (j ? 2 : 0)};
            pg8::gemm_phase<pg8::EpiResidNorm, pg8::ResidSched<11, 512>, FF, FF>(ring, g, S, E, F.wave);
        } PH_END
        if (j == 0) {
            const int nM_o = last ? 32 : 34;
            pg8::ProjCtx pc{F.ws, l, 0, F.lds};
            PH_BEGIN ctx_norm_phase<11>(F, args.in[I_NORMW] + (size_t)(l * 3 + 1) * D, modl + 3 * D, modl + 4 * D); PH_END
            int nmove; { const int tot = (last ? 32 : 34) * 41 + (last ? 18 : 0) + 204, ex = tot % G; nmove = (tot > G && ex > 0 && ex <= 204 && 3 * ex <= G) ? ex : 0; }
            PH_BEGIN {
                pg8::InProjSched S1; S1.init(last, G, cid); const int U1 = S1.total();
                { pg8::Gemm g{wsp<bf16_t>(F, WS_H), wsp<bf16_t>(F, WS_WIN + (size_t)l * WIN_SZ)};
                  pg8::EpiProj<0> E{pc};
                  pg8::gemm_phase<pg8::EpiProj<0>, pg8::InProjSched, LDH, D>(ring, g, S1, E, F.wave); }
                { pg8::Gemm g{wsp<bf16_t>(F, WS_WVT + (size_t)l * WVT_SZ), wsp<bf16_t>(F, WS_H)};
                  pg8::SegSched S; S.init(U1, 6, 34, G, cid, 0, D / 64); S.lim = 204 - nmove;
                  pg8::EpiVT<0> E{wsp<bf16_t>(F, WS_VTIN), nullptr};
                  pg8::gemm_phase<pg8::EpiVT<0>, pg8::SegSched, D, LDH>(ring, g, S, E, F.wave); }
            } PH_END
#if PROBE_INPROJ
            PH_BEGIN {
                pg8::InProjSched S1; S1.init(last, G, cid); const int U1 = S1.total();
                { pg8::Gemm g{wsp<bf16_t>(F, WS_H), wsp<bf16_t>(F, WS_WIN + (size_t)l * WIN_SZ)};
                  pg8::ProjCtx pcp{F.ws, l, 1, F.lds}; pg8::EpiProj<0> E{pcp};
                  pg8::gemm_phase<pg8::EpiProj<0>, pg8::InProjSched, LDH, D>(ring, g, S1, E, F.wave); }
                { pg8::Gemm g{wsp<bf16_t>(F, WS_WVT + (size_t)l * WVT_SZ), wsp<bf16_t>(F, WS_H)};
                  pg8::SegSched S; S.init(U1, 6, 34, G, cid, 0, D / 64);
                  pg8::EpiVT<0> E{wsp<bf16_t>(F, WS_VTIN), nullptr};
                  pg8::gemm_phase<pg8::EpiVT<0>, pg8::SegSched, D, LDH>(ring, g, S, E, F.wave); }
            } PH_END
#endif
            PH_BEGIN {
                constexpr int U1 = 34 * 4, U2 = U1 + 34 * 3;
                const int GS = G - nmove; const bool small = cid < GS;
                { pg8::Gemm g{wsp<bf16_t>(F, WS_WVT + (size_t)l * WVT_SZ), wsp<bf16_t>(F, WS_H)};
                  pg8::SegSched S; S.init(cid - (204 - nmove + cid - GS), 6, 34, G, cid, 0, D / 64); if (small) S.lim = 0;
                  pg8::EpiVT<0> E{wsp<bf16_t>(F, WS_VTIN), nullptr};
                  pg8::gemm_phase<pg8::EpiVT<0>, pg8::SegSched, D, LDH>(ring, g, S, E, F.wave); }
                { pg8::Gemm g{wsp<bf16_t>(F, WS_CQ), wsp<bf16_t>(F, WS_WUQ + (size_t)l * WUQ_SZ)};
                  pg8::SegSched S; S.init(0, 34, 4, GS, cid, 0, 12); if (!small) S.lim = 0;
                  pg8::EpiProj<1> E{pc};
                  pg8::gemm_phase<pg8::EpiProj<1>, pg8::SegSched, 768, 768>(ring, g, S, E, F.wave); }
                { pg8::Gemm g{wsp<bf16_t>(F, WS_CKV), wsp<bf16_t>(F, WS_WUK + (size_t)l * WUK_SZ)};
                  pg8::SegSched S; S.init(U1, 34, 3, GS, cid, 0, 8); if (!small) S.lim = 0;
                  pg8::EpiProj<2> E{pc};
                  pg8::gemm_phase<pg8::EpiProj<2>, pg8::SegSched, 512, 512>(ring, g, S, E, F.wave); }
                { pg8::Gemm g{wsp<bf16_t>(F, WS_WUV + (size_t)l * WUK_SZ), wsp<bf16_t>(F, WS_CKV)};
                  pg8::SegSched S; S.init(nmove == 0 ? U1 : U2, 3, 34, GS, cid, 0, 8); if (!small) S.lim = 0;
                  pg8::EpiVT<1> E{wsp<bf16_t>(F, WS_VTM), wsp<float>(F, WS_SSQ) + (size_t)(2 * l + 1) * M};
                  pg8::gemm_phase<pg8::EpiVT<1>, pg8::SegSched, 512, 512>(ring, g, S, E, F.wave); }
            } PH_END
#if PROBE_MLAUP
            PH_BEGIN {
                constexpr int U1 = 34 * 4, U2 = U1 + 34 * 3;
                { pg8::Gemm g{wsp<bf16_t>(F, WS_CQ), wsp<bf16_t>(F, WS_WUQ + (size_t)l * WUQ_SZ)};
                  pg8::SegSched S; S.init(0, 34, 4, G, cid, 0, 12);
                  pg8::EpiProj<1> E{pc};
                  pg8::gemm_phase<pg8::EpiProj<1>, pg8::SegSched, 768, 768>(ring, g, S, E, F.wave); }
                { pg8::Gemm g{wsp<bf16_t>(F, WS_CKV), wsp<bf16_t>(F, WS_WUK + (size_t)l * WUK_SZ)};
                  pg8::SegSched S; S.init(U1, 34, 3, G, cid, 0, 8);
                  pg8::EpiProj<2> E{pc};
                  pg8::gemm_phase<pg8::EpiProj<2>, pg8::SegSched, 512, 512>(ring, g, S, E, F.wave); }
                { pg8::Gemm g{wsp<bf16_t>(F, WS_WUV + (size_t)l * WUK_SZ), wsp<bf16_t>(F, WS_CKV)};
                  pg8::SegSched S; S.init(U2, 3, 34, G, cid, 0, 8);
                  pg8::EpiVT<1> E{wsp<bf16_t>(F, WS_VTM), wsp<float>(F, WS_SSQ) + (size_t)(2 * l + 1) * M};
                  pg8::gemm_phase<pg8::EpiVT<1>, pg8::SegSched, 512, 512>(ring, g, S, E, F.wave); }
            } PH_END
#endif
#define MAKE_ACTX() \
                const float lambda_init = (l == 0) ? 0.2f : 0.35550907f;        \
                const float* dl = args.in[I_DLAM] + (size_t)l * 256; \
                const int ln = (tid_of(F.wave) & 63); \
                const float s01 = wave_sum(dl[ln] * dl[64 + ln]), s23 = wave_sum(dl[128 + ln] * dl[192 + ln]); \
                AttnCtx A{wsp<bf16_t>(F, WS_NAQ), wsp<bf16_t>(F, WS_NAK), wsp<bf16_t>(F, WS_DQ), wsp<bf16_t>(F, WS_DK), wsp<bf16_t>(F, WS_MQ), wsp<bf16_t>(F, WS_MK), \
                          wsp<bf16_t>(F, WS_VTIN), wsp<bf16_t>(F, WS_VTM), wsp<bf16_t>(F, WS_OMIX), args.in[I_RPB] + (size_t)l * 6 * 15 * 31, args.in[I_SUBLN] + (size_t)l * 128, \
                          expf(s01) - expf(s23) + lambda_init, 1.0f - lambda_init};
#if ATTN_NAIVE
            PH_BEGIN { MAKE_ACTX() attn_naive_phase(F, A, !last); } PH_END
#else
            PH_BEGIN { MAKE_ACTX()
                       for (int it = ((cid >> 3) < WCV_CONV) ? 0 : 1; it < 2; ++it) {
                           if (it == 1) attn_mfma_phase(F, A, !last, F.ctl + CW_AQ + 512 * l);
                           for (int q = (l == 0 ? 0 : 1); q < 2; ++q)
                               convert_fill(F, args, q, q == 0 ? 1 : l, F.ctl + CW_WCV + (q == 0 ? 1536 : 512 * l), 0, q == 0 ? wcv::NH1 : (l == 0 ? wcv::NH0 : wcv::NH1 - wcv::I_FO) - WCV_RES); } } PH_END
#if PROBE_ATTN
            PH_BEGIN { MAKE_ACTX() attn_mfma_phase(F, A, !last, F.ctl + CW_AQ + 512 * (l + 2), PROBE_ATTN); } PH_END
#endif
            PH_BEGIN { MAKE_ACTX() diff_combine_phase(F, A, last ? ML : M, !last); } PH_END
#endif
#undef MAKE_ACTX
            PH_BEGIN {
                pg8::Gemm g{wsp<bf16_t>(F, WS_OMIX), wsp<bf16_t>(F, WS_WBR + (size_t)l * WSQ_SZ)};
                pg8::MergeSched S; S.init(G, cid, nM_o == 34);
                pg8::EpiMerge E{F.ws};
                pg8::gemm_phase<pg8::EpiMerge, pg8::MergeSched, D, D>(ring, g, S, E, F.wave);
            } PH_END
            PH_BEGIN {
                pg8::Gemm g{wsp<bf16_t>(F, WS_Y), wsp<bf16_t>(F, WS_WO + (size_t)l * WSQ_SZ)};
                pg8::ResidSched<8, 256> S; S.init(D / 256, G, cid, D / 64, nM_o == 34);
                pg8::EpiResidNorm E{F.ws, modl + 5 * D, args.in[I_NORMW] + (size_t)(l * 3 + 2) * D, modl + 6 * D, nullptr, nullptr, 1.0f, 3 * l + 1};
                pg8::gemm_phase<pg8::EpiResidNorm, pg8::ResidSched<8, 256>, D, D>(ring, g, S, E, F.wave);
            } PH_END
        }
    }
#if PROBE_BAR
    for (int pb = 0; pb < 32; ++pb) { PH_BEGIN PH_END }
#endif
#undef PH_BEGIN
#undef PH_END
}
constexpr int N_PHASES = 1 + 2 * DEPTH * 3 + DEPTH * (ATTN_NAIVE ? 6 : 7) + 1;

extern "C" void kernel_launch(void* const* d_in, const int* in_sizes, int n_in, void* d_out, int out_size, void* d_ws, size_t ws_size, hipStream_t stream) {
    static int grid = 0;
    if (grid == 0) {
        if (n_in != 20 || in_sizes[0] != ML * D || out_size != ML * D || ws_size < WS_END) { fprintf(stderr, "kernel_launch: unexpected shapes (n_in %d, in0 %d, out %d, ws %zu < %zu); nothing launched\n", n_in, n_in > 0 ? in_sizes[0] : -1, out_size, ws_size, (size_t)WS_END); grid = -1; return; }
        int dev = 0, cus = 0, per_cu = 0;
        if (hipGetDevice(&dev) != hipSuccess || hipDeviceGetAttribute(&cus, hipDeviceAttributeMultiprocessorCount, dev) != hipSuccess) { grid = -1; return; }
        if (hipFuncSetAttribute((const void*)dit_fwd, hipFuncAttributeMaxDynamicSharedMemorySize, LDS_BYTES) != hipSuccess) { fprintf(stderr, "kernel_launch: hipFuncSetAttribute failed\n"); grid = -1; return; }
        if (hipOccupancyMaxActiveBlocksPerMultiprocessor(&per_cu, (const void*)dit_fwd, NTHREADS, LDS_BYTES) != hipSuccess || per_cu < 1)
            fprintf(stderr, "kernel_launch: note: occupancy query reports %d workgroups per CU\n", per_cu);
        (void)hipGetLastError();
        grid = cus;
    }
    if (grid < 0) return;
    if (hipMemsetAsync((char*)d_ws + WS_CTL, 0, CTL_ZERO_BYTES, stream) != hipSuccess) { fprintf(stderr, "kernel_launch: hipMemsetAsync failed\n"); return; }
    Args a{};
    for (int i = 0; i < 20; ++i) a.in[i] = (const float*)d_in[i];
    a.out = (float*)d_out; a.ws = (unsigned char*)d_ws;
#if MK_SPLIT
    for (int p = 0; p < N_PHASES; ++p) { a.ph_lo = p; a.ph_hi = p + 1; hipLaunchKernelGGL(dit_fwd, dim3(grid), dim3(NTHREADS), LDS_BYTES, stream, a); }
#else
    a.ph_lo = 0; a.ph_hi = 1 << 20;
    hipLaunchKernelGGL(dit_fwd, dim3(grid), dim3(NTHREADS), LDS_BYTES, stream, a);
    const hipError_t le = hipPeekAtLastError();
    if (le != hipSuccess) fprintf(stderr, "kernel_launch: launch failed: %s\n", hipGetErrorName(le));
#endif
}
```

```cpp
#include <hip/hip_runtime.h>
#include <cstdio>
#include <cstdint>

#define GAS __attribute__((address_space(1)))
#define LAS __attribute__((address_space(3)))
typedef unsigned short bf16_t;
typedef short bf16x8 __attribute__((ext_vector_type(8)));
typedef float f32x4 __attribute__((ext_vector_type(4)));
typedef float f32x2 __attribute__((ext_vector_type(2)));
typedef unsigned u32x4 __attribute__((ext_vector_type(4)));
typedef unsigned u32x2 __attribute__((ext_vector_type(2)));

constexpr int D = 2048, NBATCH = 2, SEQ = 4096, DEPTH = 2, CTXL = 256, FF = 5632, NMOD = 9, GRIDW = 64;
constexpr int ML = NBATCH * SEQ;
constexpr int MC = NBATCH * CTXL;
constexpr int M = ML + MC;
constexpr int INW = 11712, MODLD = NMOD * D;
constexpr int NA_W = 768, MLA_W = 640, DF_W = 640, QRANK = 768, KVRANK = 512;
constexpr int H_NA = 6, H_MLA = 5, H_DF = 5;
constexpr float NORM_EPS = 1e-6f, LOG2E = 1.4426950408889634f;
constexpr float NA_SCALE = 0.08838834764831845f, MLA_SCALE = 0.07216878364870322f, DF_SCALE = 0.125f;
constexpr int NWAVES = 8, NTHREADS = 512;
constexpr int LDH = D + 64;
constexpr int LDX = D + 32;

constexpr size_t al256(size_t x) { return (x + 255) & ~(size_t)255; }
constexpr size_t WS_CTL = 0, CTL_ZERO_BYTES = 1u << 20;
constexpr int CW_TMO = 0, CW_AQ = 1024, CW_BAR = 4096, CW_WCV = 8192;
constexpr size_t WS_MOD = 65536;
constexpr size_t WS_SSQ = 524288;
constexpr int NFUSE = 3 * DEPTH;
constexpr size_t WS_SSQX = WS_SSQ + (size_t)DEPTH * 2 * M * 4;
constexpr size_t WS_PCNT = WS_SSQX + (size_t)NFUSE * ML * 4;
static_assert(WS_MOD + (size_t)DEPTH * 3 * MODLD * 4 <= WS_SSQ && WS_SSQX % 256 == 0 && WS_PCNT % 256 == 0 && WS_PCNT + (size_t)NFUSE * 32 * 256 <= CTL_ZERO_BYTES, "ctl map");
constexpr size_t WS_ROPE = CTL_ZERO_BYTES;
constexpr size_t WS_XS   = WS_ROPE + 8192;
constexpr size_t WS_H    = WS_XS   + al256((size_t)M * LDX * 4);
constexpr size_t WS_U    = WS_H    + al256((size_t)M * LDH * 2);
constexpr size_t WS_NAQ  = WS_U    + al256((size_t)M * FF * 2);
constexpr size_t WS_NAK  = WS_NAQ  + al256((size_t)M * 768 * 2);
constexpr size_t WS_CQ   = WS_NAK  + al256((size_t)M * 768 * 2);
constexpr size_t WS_CKV  = WS_CQ   + al256((size_t)M * 768 * 2);
constexpr size_t WS_DQ   = WS_CKV  + al256((size_t)M * 512 * 2);
constexpr size_t WS_DK   = WS_DQ   + al256((size_t)M * 640 * 2);
constexpr size_t WS_G    = WS_DK   + al256((size_t)M * 640 * 2);
constexpr size_t WS_VTIN = WS_G    + al256((size_t)M * 6144 * 2);
constexpr size_t WS_MQ   = WS_VTIN + al256((size_t)1536 * M * 2);
constexpr size_t WS_MK   = WS_MQ   + al256((size_t)M * 1024 * 2);
constexpr size_t WS_VTM  = WS_MK   + al256((size_t)M * 960 * 2);
constexpr size_t WS_OMIX = WS_VTM  + al256((size_t)768 * M * 2);
constexpr size_t WS_YF   = WS_OMIX + al256((size_t)M * D * 2);
constexpr size_t WS_Y    = WS_YF   + al256((size_t)M * LDX * 4);
constexpr size_t WS_WFI  = WS_Y    + al256((size_t)M * D * 2);
constexpr size_t WFI_SZ = (size_t)2 * FF * D * 2, WFO_SZ = (size_t)D * FF * 2, WIN_ROWS = 10496, WIN_SZ = WIN_ROWS * D * 2, WVT_SZ = (size_t)1536 * D * 2;
constexpr size_t WUQ_SZ = (size_t)1024 * 768 * 2, WUK_SZ = (size_t)768 * 512 * 2, WSQ_SZ = (size_t)D * D * 2;
constexpr size_t WS_WFO  = WS_WFI + 4 * WFI_SZ;
constexpr size_t WS_WIN  = WS_WFO + 4 * WFO_SZ;
constexpr size_t WS_WVT  = WS_WIN + 2 * WIN_SZ;
constexpr size_t WS_WUQ  = WS_WVT + 2 * WVT_SZ;
constexpr size_t WS_WUK  = WS_WUQ + 2 * WUQ_SZ;
constexpr size_t WS_WUV  = WS_WUK + 2 * WUK_SZ;
constexpr size_t WS_WBR  = WS_WUV + 2 * WUK_SZ;
constexpr size_t WS_WO   = WS_WBR + 2 * WSQ_SZ;
constexpr size_t WS_PART = WS_WO  + 2 * WSQ_SZ;
constexpr int LDXH = D + 64, LDXL = D + 128;
constexpr size_t WS_XH   = WS_PART + (size_t)11 * MC * LDX * 4;
constexpr size_t WS_XL   = WS_XH + (size_t)ML * LDXH * 2;
constexpr size_t WS_END  = WS_XL + (size_t)ML * LDXL;

constexpr int RING_OFF = 0, RING_BYTES = 131072;
constexpr int LDSCTL_OFF = RING_BYTES, MISC_OFF = LDSCTL_OFF + 320;
constexpr int ROPE_LDS = LDSCTL_OFF + 1024;
constexpr int LDS_BYTES = 147456;

typedef GAS unsigned gu32;
#define RLX_AGENT __ATOMIC_RELAXED, __HIP_MEMORY_SCOPE_AGENT
#define LDS_WAIT() asm volatile("s_waitcnt lgkmcnt(0)" ::: "memory")
#define VM_WAIT() asm volatile("s_waitcnt vmcnt(0)" ::: "memory")
__device__ __forceinline__ unsigned f2bf(float f) { unsigned u = __builtin_bit_cast(unsigned, f); return (u + 0x7fffu + ((u >> 16) & 1u)) >> 16; }
__device__ __forceinline__ unsigned pk2(float lo, float hi) { return f2bf(lo) | (f2bf(hi) << 16); }
__device__ __forceinline__ float bf2f(unsigned short b) { return __builtin_bit_cast(float, ((unsigned)b) << 16); }
__device__ __forceinline__ float bflo(unsigned w) { return __builtin_bit_cast(float, w << 16); }
__device__ __forceinline__ float bfhi(unsigned w) { return __builtin_bit_cast(float, w & 0xffff0000u); }
__device__ __forceinline__ unsigned cvt_pk_bf16(float lo, float hi) { unsigned r; asm volatile("v_cvt_pk_bf16_f32 %0, %1, %2" : "=v"(r) : "v"(lo), "v"(hi)); return r; }
template <int X> __device__ __forceinline__ float xor_lane(float v) {
    static_assert(X == 1 || X == 2 || X == 4 || X == 8 || X == 16, "xor_lane: within a 32-lane half (ds_swizzle bit mode)");
    return __builtin_bit_cast(float, __builtin_amdgcn_ds_swizzle(__builtin_bit_cast(int, v), (X << 10) | 0x1F));
}
__device__ __forceinline__ float half_sum(float v) { const unsigned u = __builtin_bit_cast(unsigned, v); auto rr = __builtin_amdgcn_permlane32_swap(u, u, false, false); return __builtin_bit_cast(float, (unsigned)rr[0]) + __builtin_bit_cast(float, (unsigned)rr[1]); }
__device__ __forceinline__ float half_max(float v) { const unsigned u = __builtin_bit_cast(unsigned, v); auto rr = __builtin_amdgcn_permlane32_swap(u, u, false, false); return fmaxf(__builtin_bit_cast(float, (unsigned)rr[0]), __builtin_bit_cast(float, (unsigned)rr[1])); }
__device__ __forceinline__ float wave_sum(float v) {
    v += xor_lane<1>(v); v += xor_lane<2>(v); v += xor_lane<4>(v); v += xor_lane<8>(v); v += xor_lane<16>(v); return half_sum(v);
}
__device__ __forceinline__ float wave_max(float v) {
    v = fmaxf(v, xor_lane<1>(v)); v = fmaxf(v, xor_lane<2>(v)); v = fmaxf(v, xor_lane<4>(v)); v = fmaxf(v, xor_lane<8>(v)); v = fmaxf(v, xor_lane<16>(v)); return half_max(v);
}
__device__ __forceinline__ float fast_exp2(float x) { return __builtin_amdgcn_exp2f(x); }
__device__ __forceinline__ float fast_rcp(float x) { return __builtin_amdgcn_rcpf(x); }
__device__ __forceinline__ float silu_f(float a) { return a * fast_rcp(1.0f + fast_exp2(-a * LOG2E)); }
__device__ __forceinline__ float sigmoid_f(float a) { return fast_rcp(1.0f + fast_exp2(-a * LOG2E)); }
__device__ __forceinline__ void atomic_add_f32(float* p, float v) { unsafeAtomicAdd(p, v); }
__device__ __forceinline__ int opaque_v(int x) { asm volatile("" : "+v"(x)); return x; }
__device__ __forceinline__ int opaque_s(int x) { asm volatile("" : "+s"(x)); return x; }
__device__ __forceinline__ int lane_id() { int r; asm volatile("v_mbcnt_lo_u32_b32 %0, -1, 0\n\tv_mbcnt_hi_u32_b32 %0, -1, %0" : "=v"(r)); return r; }
__device__ __forceinline__ int tid_of(int wave) { return wave * 64 + lane_id(); }
#define XB_TMO      128
#define XB_XCNT(j)  (256  + 64 * (j))
#define XB_XSUB(j)  (1280 + 64 * (j))
#define XB_XGEN(j)  (2304 + 64 * (j))
#define XB_TOP      3328
#define XB_TOPGEN   3392
#define XCD_BAR_WORDS 3456
#define XB_SPIN_CAP (1u << 23)

__device__ __forceinline__ unsigned xb_ld(unsigned* p)              { return __hip_atomic_load(p, __ATOMIC_RELAXED, __HIP_MEMORY_SCOPE_AGENT); }
__device__ __forceinline__ unsigned xb_add(unsigned* p, unsigned v) { return __hip_atomic_fetch_add(p, v, __ATOMIC_RELAXED, __HIP_MEMORY_SCOPE_AGENT); }
__device__ __forceinline__ unsigned xb_xcc_id() { return (unsigned)__builtin_amdgcn_s_getreg((3 << 11) | 20) & 0xFu; }
#define XB_SPIN(cond, bar) do { unsigned _sp = 0; while (cond) { __builtin_amdgcn_s_sleep(1); \
    if ((++_sp & 255u) == 0u) { if (xb_ld(&(bar)[XB_TMO])) break; if (_sp > XB_SPIN_CAP) { atomicAdd(&(bar)[XB_TMO], 1u); break; } } } } while (0)

struct XcdBarrier {
    unsigned* bar; unsigned x; int wave;
    volatile LAS unsigned* st;
};

__device__ __forceinline__ XcdBarrier xcd_barrier_post(unsigned* bar, volatile LAS unsigned* st, int wave) {
    XcdBarrier b; b.bar = bar; b.x = xb_xcc_id(); b.st = st; b.wave = wave;
    if (threadIdx.x == 0) (void)xb_add(&bar[XB_XCNT(b.x)], 1u);
    return b;
}
__device__ __forceinline__ void xcd_barrier_complete(unsigned* bar, unsigned x, unsigned& nloc, unsigned& nx) {
    const unsigned G = gridDim.x * gridDim.y * gridDim.z;
    unsigned sum, cnt, mine, sp = 0u;
    for (;;) {
        sum = 0u; cnt = 0u; mine = 0u;
#pragma unroll
        for (unsigned j = 0; j < 16; ++j) { const unsigned c = xb_ld(&bar[XB_XCNT(j)]); sum += c; cnt += (c > 0u) ? 1u : 0u; mine = (j == x) ? c : mine; }
        if (sum == G) break;
        __builtin_amdgcn_s_sleep(1);
        if ((++sp & 255u) == 0u) { if (xb_ld(&bar[XB_TMO])) break; if (sp > XB_SPIN_CAP) { atomicAdd(&bar[XB_TMO], 1u); break; } }
    }
    nloc = mine > 0u ? mine : 1u; nx = cnt > 0u ? cnt : 1u;
}

__device__ __forceinline__ void xcd_barrier(const XcdBarrier& b) {
    asm volatile("s_waitcnt vmcnt(0)" ::: "memory");
    __syncthreads();
    if (b.wave == 0 && lane_id() == 0) {
        unsigned* bar = b.bar;
        __builtin_amdgcn_s_waitcnt(0);
        unsigned nloc = b.st[0], nx = b.st[1];
        if (nloc == 0u) { xcd_barrier_complete(bar, b.x, nloc, nx); b.st[0] = nloc; b.st[1] = nx; }
        const unsigned old = xb_add(&bar[XB_XSUB(b.x)], 1u);
        const unsigned gen = old / nloc;
        if (old + 1u == (gen + 1u) * nloc) {
            __builtin_amdgcn_fence(__ATOMIC_RELEASE, "agent");
            asm volatile("s_waitcnt vmcnt(0)" ::: "memory");
            const unsigned og = xb_add(&bar[XB_TOP], 1u);
            const unsigned tg = og / nx;
            if (og + 1u == (tg + 1u) * nx) xb_add(&bar[XB_TOPGEN], 1u);
            else XB_SPIN(xb_ld(&bar[XB_TOPGEN]) == tg, bar);
            __builtin_amdgcn_fence(__ATOMIC_ACQUIRE, "agent");
            xb_add(&bar[XB_XGEN(b.x)], 1u);
            asm volatile("s_waitcnt vmcnt(0)" ::: "memory");
        } else {
            XB_SPIN(xb_ld(&bar[XB_XGEN(b.x)]) == gen, bar);
            __builtin_amdgcn_fence(__ATOMIC_ACQUIRE, "agent");
            asm volatile("s_waitcnt vmcnt(0)" ::: "memory");
        }
    }
    __syncthreads();
}

#ifndef MERGE_CTX_ATOMIC
#define MERGE_CTX_ATOMIC 1
#endif
namespace pg8 {
constexpr int BM = 256, BK = 64, HALF = 128, HTB = HALF * BK * 2, STAGE_BYTES = 8 * HTB, NXCD = 8, WGM = 8;
__host__ __device__ __forceinline__ int lds_byte(int r, int c) { const int st = (r >> 4) * 2 + (c >> 5), rr = r & 15, cc = c & 31, ob = rr * 64 + cc * 2; return st * 1024 + (ob ^ (((ob >> 9) & 1) << 5)); }
__host__ __device__ __forceinline__ void stage_rc(int b, int& R, int& C) { const int st = b / 1024, sb = b % 1024, swz = sb ^ (((sb >> 9) & 1) << 5); R = (st >> 1) * 16 + swz / 64; C = (st & 1) * 32 + (swz % 64) / 2; }
__host__ __device__ __forceinline__ int perm32(int rho) { const int n = rho >> 4, i = rho & 15; return 8 * (i >> 2) + 4 * n + (i & 3); }

struct Unit { int pm, pn, kofs, nkt, aux; };
struct Gemm { const bf16_t* A; const bf16_t* Bt; };

struct SegSched {
    int n, nM, nN, G, first, kofs, nkt, lim;
    __device__ __forceinline__ void init(int lo, int nM_, int nN_, int G_, int c, int kofs_, int nkt_) {
        nM = nM_; nN = nN_; n = nM * nN; G = G_; kofs = kofs_; nkt = nkt_; lim = n;
        int f = (c - lo) % G; if (f < 0) f += G; first = f;
    }
    __device__ __forceinline__ bool next(int i, Unit& u) const {
        const long L = (long)first + (long)i * G; if (L >= lim) return false;
        int wgid = (int)L; { const int q = n / NXCD, r = n % NXCD, xcd = wgid % NXCD, off = wgid / NXCD; wgid = (xcd < r ? xcd * (q + 1) : r * (q + 1) + (xcd - r) * q) + off; }
        const int nig = WGM * nN, gid = wgid / nig, fm = gid * WGM, gsz = (nM - fm) < WGM ? (nM - fm) : WGM;
        u.pm = fm + ((wgid % nig) % gsz); u.pn = (wgid % nig) / gsz; u.kofs = kofs; u.nkt = nkt; u.aux = 0; return true;
    }
};
template <int NSPLIT, int KCHUNK> struct ResidSched {
    SegSched lat; int G, c, nctx;
    __device__ __forceinline__ void init(int nN, int G_, int c_, int nkt_full, bool with_ctx) { lat.init(0, 32, nN, G_, c_, 0, nkt_full); G = G_; c = c_; nctx = with_ctx ? 2 * nN * NSPLIT : 0; }
    __device__ __forceinline__ bool next(int i, Unit& u) const {
        const long L = (long)c + (long)i * G;
        if (L < lat.n) return lat.next(i, u);
        const int x = (int)(L - lat.n); if (x >= nctx) return false;
        const int t = x / NSPLIT, ks = x - t * NSPLIT;
        u.pm = 32 + (t >> 3); u.pn = t & 7; u.kofs = ks * KCHUNK;        u.nkt = KCHUNK / BK; u.aux = 1 + ks; return true;
    }
};
struct InProjSched {
    SegSched a; int G, c, nctx;
    __device__ __forceinline__ void init(bool last, int G_, int c_) { a.init(0, last ? 32 : 34, 41, G_, c_, 0, 32); G = G_; c = c_; nctx = last ? 18 : 0; }
    __device__ __forceinline__ int total() const { return a.n + nctx; }
    __device__ __forceinline__ bool next(int i, Unit& u) const {
        const long L = (long)c + (long)i * G;
        if (L < a.n) return a.next(i, u);
        const int x = (int)(L - a.n); if (x >= nctx) return false;
        const int p = x / 9, j = x - 9 * p;
        u.pm = 32 + p; u.pn = j < 3 ? 3 + j : (j < 5 ? 6 + j : 8 + j); u.kofs = 0; u.nkt = 32; u.aux = 0; return true;
    }
};
struct MergeSched {
    SegSched s; int G, c, ntl, nctx;
    __device__ __forceinline__ void init(int G_, int c_, bool with_ctx) {
#if MERGE_CTX_ATOMIC
        s.init(0, 32, 8, G_, c_, 0, 0); G = G_; c = c_; ntl = c_ < 256 ? (256 - c_ + G_ - 1) / G_ : 0; nctx = with_ctx ? 48 : 0;
#else
        const int nt_ = with_ctx ? 272 : 256; s.init(0, with_ctx ? 34 : 32, 8, G_, c_, 0, 0); G = G_; c = c_; ntl = c_ < nt_ ? (nt_ - c_ + G_ - 1) / G_ : 0; nctx = 0;
#endif
    }
    __device__ __forceinline__ bool next(int i, Unit& u) const {
        int br;
        if (i < 3 * ntl) { const int t = i / 3; br = i - 3 * t; if (!s.next(t, u)) return false; u.aux = br; }
        else { const int x = c + (i - 3 * ntl) * G; if (x >= nctx) return false; const int t = x / 3; br = x - 3 * t; u.pm = 32 + (t >> 3); u.pn = t & 7; u.aux = 4 + br; }
        u.kofs = br == 0 ? 0 : (br == 1 ? 768 : 1408); u.nkt = br == 0 ? 12 : 10; return true;
    }
};

template <class Epi, class Sched, int LDA, int LDB, bool ALIGN_EPI = true>
__device__ __forceinline__ void gemm_phase(LAS unsigned char* lds, const Gemm g, const Sched& S, const Epi& E, int wave) {
    const int tid = tid_of(wave), wid = wave, lane = tid & 63, wr = wid >> 2, wc = wid & 3, fr = lane & 15, fq = lane >> 4;
    unsigned voffA[2], voffB[2];
#pragma unroll
    for (int i = 0; i < 2; ++i) { int R, C; stage_rc(tid * 16 + i * 8192, R, C); const int Rb = Epi::PERM ? ((R & ~31) + perm32(R & 31)) : R;
        voffA[i] = (unsigned)(R * LDA + C) * 2u; voffB[i] = (unsigned)(Rb * LDB + C) * 2u; }
    constexpr size_t kstep = (size_t)(BK * 2);
    constexpr size_t hstepA = (size_t)HALF * LDA * 2, hstepB = (size_t)HALF * LDB * 2;
    constexpr size_t tstepA = 2 * hstepA, tstepB = 2 * hstepB;
    const unsigned ldsw = (unsigned)wid * 1024u;
    const int aoff = lds_byte(wr * 64 + fr, fq * 8), boff = lds_byte(wc * 32 + fr, fq * 8);
#define PG8_SA(b, h) (((b) * 2 + (h)) * HTB)
#define PG8_SB(b, h) ((4 + (b) * 2 + (h)) * HTB)
#define PG8_STAGE(bufoff, gbase, voff) do { _Pragma("unroll") for (int _i = 0; _i < 2; ++_i) \
        __builtin_amdgcn_global_load_lds((const unsigned*)((const char*)(gbase) + (voff)[_i]), (LAS unsigned*)(lds + (bufoff) + ldsw + _i * 8192), 16, 0, 0); } while (0)
#define PG8_LDA(dst, b, h) do { _Pragma("unroll") for (int m = 0; m < 4; ++m) _Pragma("unroll") for (int k = 0; k < 2; ++k) dst[m][k] = *(const LAS bf16x8*)(lds + PG8_SA(b, h) + aoff + m * 2048 + k * 1024); } while (0)
#define PG8_LDB(dst, b, h) do { _Pragma("unroll") for (int n = 0; n < 2; ++n) _Pragma("unroll") for (int k = 0; k < 2; ++k) dst[n][k] = *(const LAS bf16x8*)(lds + PG8_SB(b, h) + boff + n * 2048 + k * 1024); } while (0)
#define PG8_MMA(ai, bj, At, Bt) do { __builtin_amdgcn_s_setprio(1); _Pragma("unroll") for (int m = 0; m < 4; ++m) _Pragma("unroll") for (int n = 0; n < 2; ++n) _Pragma("unroll") for (int k = 0; k < 2; ++k) \
        acc[ai][bj][m][n] = __builtin_amdgcn_mfma_f32_16x16x32_bf16(Bt[n][k], At[m][k], acc[ai][bj][m][n], 0, 0, 0); __builtin_amdgcn_s_setprio(0); } while (0)
#define PG8_WAIT_V(n) asm volatile("s_waitcnt vmcnt(" #n ")" ::: "memory")
#define PG8_WAIT_L(n) asm volatile("s_waitcnt lgkmcnt(" #n ")" ::: "memory")
#define PG8_BAR __builtin_amdgcn_s_barrier()
#define PG8_SCHED __builtin_amdgcn_sched_barrier(0)
    Unit cur, nxt; int ui = 0;
    if (!S.next(0, cur)) return;
    f32x4 acc[2][2][4][2];
#pragma unroll
    for (int a = 0; a < 2; ++a)
#pragma unroll
        for (int b = 0; b < 2; ++b)
#pragma unroll
            for (int m = 0; m < 4; ++m)
#pragma unroll
                for (int n = 0; n < 2; ++n) acc[a][b][m][n] = (f32x4){0.f, 0.f, 0.f, 0.f};
    bf16x8 At[4][2], B0[2][2], B1[2][2];
    const char* cA = (const char*)g.A + (size_t)cur.pm * tstepA + (size_t)cur.kofs * 2; const char* cB = (const char*)g.Bt + (size_t)cur.pn * tstepB + (size_t)cur.kofs * 2;
    PG8_STAGE(PG8_SB(0, 0), cB, voffB); PG8_STAGE(PG8_SB(0, 1), cB + hstepB, voffB); PG8_STAGE(PG8_SA(0, 0), cA, voffA); PG8_STAGE(PG8_SA(0, 1), cA + hstepA, voffA);
    if (wr == 1) PG8_BAR;
    PG8_WAIT_V(2); PG8_BAR;
    PG8_STAGE(PG8_SB(1, 0), cB + kstep, voffB); PG8_STAGE(PG8_SA(1, 0), cA + kstep, voffA); PG8_STAGE(PG8_SB(1, 1), cB + hstepB + kstep, voffB);
    PG8_WAIT_V(6); PG8_BAR;
    for (;;) {
        const bool has_next = S.next(ui + 1, nxt);
        const char* nA = has_next ? (const char*)g.A + (size_t)nxt.pm * tstepA + (size_t)nxt.kofs * 2 : cA; const char* nB = has_next ? (const char*)g.Bt + (size_t)nxt.pn * tstepB + (size_t)nxt.kofs * 2 : cB;
        const int nt = cur.nkt;
        for (int t = 0; t < nt; t += 2) {
            const bool last = (t == nt - 2);
            const char* a1 = cA + (size_t)(t + 1) * kstep;
            const char* a2 = last ? nA : cA + (size_t)(t + 2) * kstep; const char* b2 = last ? nB : cB + (size_t)(t + 2) * kstep;
            const char* a3 = a2 + kstep; const char* b3 = b2 + kstep;
            PG8_LDB(B0, 0, 0); PG8_LDB(B1, 0, 1); PG8_SCHED; PG8_LDA(At, 0, 0); PG8_STAGE(PG8_SA(1, 1), a1 + hstepA, voffA);
            PG8_WAIT_V(8); PG8_WAIT_L(0); PG8_BAR; PG8_MMA(0, 0, At, B0); PG8_MMA(0, 1, At, B1); PG8_BAR; PG8_SCHED;
            PG8_LDA(At, 0, 1); PG8_STAGE(PG8_SB(0, 0), b2, voffB); PG8_STAGE(PG8_SB(0, 1), b2 + hstepB, voffB); PG8_STAGE(PG8_SA(0, 0), a2, voffA);
            PG8_WAIT_V(8); PG8_WAIT_L(0); PG8_BAR; PG8_MMA(1, 0, At, B0); PG8_MMA(1, 1, At, B1); PG8_BAR; PG8_SCHED;
            PG8_LDB(B0, 1, 0); PG8_LDB(B1, 1, 1); PG8_SCHED; PG8_LDA(At, 1, 0); PG8_STAGE(PG8_SA(0, 1), a2 + hstepA, voffA);
            PG8_WAIT_V(8); PG8_WAIT_L(0); PG8_BAR; PG8_MMA(0, 0, At, B0); PG8_MMA(0, 1, At, B1); PG8_BAR; PG8_SCHED;
            PG8_LDA(At, 1, 1); PG8_STAGE(PG8_SB(1, 0), b3, voffB); PG8_STAGE(PG8_SB(1, 1), b3 + hstepB, voffB); PG8_STAGE(PG8_SA(1, 0), a3, voffA);
            PG8_WAIT_V(8); PG8_WAIT_L(0); PG8_BAR; PG8_MMA(1, 0, At, B0); PG8_MMA(1, 1, At, B1); PG8_BAR; PG8_SCHED;
        }
        if constexpr (ALIGN_EPI) { if (wr == 0) PG8_BAR; }
        E(acc, cur, wr, wc, fr, fq);
        if (!has_next) break;
#pragma unroll
        for (int a = 0; a < 2; ++a)
#pragma unroll
            for (int b = 0; b < 2; ++b)
#pragma unroll
                for (int m = 0; m < 4; ++m)
#pragma unroll
                    for (int n = 0; n < 2; ++n) acc[a][b][m][n] = (f32x4){0.f, 0.f, 0.f, 0.f};
        cur = nxt; cA = nA; cB = nB; ++ui;
        if constexpr (ALIGN_EPI) { if (wr == 1) PG8_BAR; }
    }
    PG8_WAIT_V(0);
    if constexpr (!ALIGN_EPI) { if (wr == 0) PG8_BAR; }
    PG8_BAR;
#undef PG8_SA
#undef PG8_SB
#undef PG8_STAGE
#undef PG8_LDA
#undef PG8_LDB
#undef PG8_MMA
#undef PG8_WAIT_V
#undef PG8_WAIT_L
#undef PG8_BAR
#undef PG8_SCHED
}
}
namespace pg8 {
__device__ __forceinline__ int mod_row(int pm) { return pm < 16 ? 0 : (pm < 32 ? 1 : 2); }

struct EpiSwiGLU {
    static constexpr bool PERM = true;
    bf16_t* U;
    __device__ __forceinline__ void operator()(const f32x4 (&acc)[2][2][4][2], const Unit& u, int wr, int wc, int fr, int fq) const {
        const int row0 = u.pm * BM + wr * 64 + fr, col0 = u.pn * HALF + wc * 32 + 8 * fq;
#pragma unroll
        for (int ai = 0; ai < 2; ++ai)
#pragma unroll
            for (int m = 0; m < 4; ++m) { bf16_t* p = U + (size_t)(row0 + ai * HALF + m * 16) * FF + col0;
                const f32x4 a0 = acc[ai][0][m][0], a1 = acc[ai][0][m][1], b0 = acc[ai][1][m][0], b1 = acc[ai][1][m][1];
                float v[8];
#pragma unroll
                for (int e = 0; e < 4; ++e) { v[e] = silu_f(a0[e]) * b0[e]; v[4 + e] = silu_f(a1[e]) * b1[e]; }
                u32x4 w; w.x = cvt_pk_bf16(v[0], v[1]); w.y = cvt_pk_bf16(v[2], v[3]); w.z = cvt_pk_bf16(v[4], v[5]); w.w = cvt_pk_bf16(v[6], v[7]);
                *(u32x4*)p = w; }
    }
};

struct EpiNull {
    static constexpr bool PERM = true;
    float* dummy;
    __device__ __forceinline__ void operator()(const f32x4 (&acc)[2][2][4][2], const Unit& u, int wr, int wc, int fr, int fq) const {
        f32x4 s = {0.f, 0.f, 0.f, 0.f};
#pragma unroll
        for (int ai = 0; ai < 2; ++ai)
#pragma unroll
            for (int bj = 0; bj < 2; ++bj)
#pragma unroll
                for (int m = 0; m < 4; ++m)
#pragma unroll
                    for (int n = 0; n < 2; ++n) s = s + acc[ai][bj][m][n];
        dummy[(size_t)(u.pm * 64 + u.pn) * 512 + (wr * 4 + wc) * 64 + fq * 16 + fr] = (s[0] + s[1]) + (s[2] + s[3]);
    }
};

struct EpiResidNorm {
    static constexpr bool PERM = true;
    unsigned char* ws; const float* gate; const float* g; const float* shift; float* out; const float* xin; float gs; int fs;
    __device__ __forceinline__ void operator()(const f32x4 (&acc)[2][2][4][2], const Unit& u, int wr, int wc, int fr, int fq) const {
        const int row0 = u.pm * BM + wr * 64 + fr, col0 = u.pn * BM + wc * 32 + 8 * fq, mr = mod_row(u.pm);
        const float* gp = gate + (size_t)mr * MODLD + col0;
        f32x4 gv[2][2];
#pragma unroll
        for (int bj = 0; bj < 2; ++bj)
#pragma unroll
            for (int n = 0; n < 2; ++n) gv[bj][n] = *(const f32x4*)(gp + bj * HALF + n * 4) * gs;
        if (u.aux == 0) {
            bf16_t* XH = (bf16_t*)(ws + WS_XH); unsigned char* XL = ws + WS_XL; float* ssq = (float*)(ws + WS_SSQX) + (size_t)fs * ML; unsigned* cnt = (unsigned*)(ws + WS_PCNT) + (size_t)(fs * 32 + u.pm) * 64;
            const bool fin = out != nullptr;
            f32x4 xn[2][4][2][2];
#pragma unroll
            for (int ai = 0; ai < 2; ++ai)
#pragma unroll
                for (int m = 0; m < 4; ++m) { const int row = row0 + ai * HALF + m * 16; bf16_t* rowh = XH + (size_t)row * LDXH + col0; unsigned char* rowl = XL + (size_t)row * LDXL + col0; float ss = 0.f;
#pragma unroll
                    for (int bj = 0; bj < 2; ++bj) { f32x4 x0, x1;
                        if (xin) { const float* rin = xin + (size_t)row * D + col0 + bj * HALF; x0 = *(const f32x4*)rin; x1 = *(const f32x4*)(rin + 4); }
                        else { const u32x4 hw = *(const u32x4*)(rowh + bj * HALF); const u32x2 lw = *(const u32x2*)(rowl + bj * HALF);
#define XUNP(h, l, k) __builtin_bit_cast(float, __builtin_amdgcn_perm((h), (l), ((k) & 1) ? (0x07060000u | ((unsigned)((k) & 3) << 8) | 0x0cu) : (0x05040000u | ((unsigned)((k) & 3) << 8) | 0x0cu)))
                            x0 = (f32x4){XUNP(hw.x, lw.x, 0), XUNP(hw.x, lw.x, 1), XUNP(hw.y, lw.x, 2), XUNP(hw.y, lw.x, 3)};
                            x1 = (f32x4){XUNP(hw.z, lw.y, 4), XUNP(hw.z, lw.y, 5), XUNP(hw.w, lw.y, 6), XUNP(hw.w, lw.y, 7)};
#undef XUNP
                        }
                        const f32x4 t0 = x0 + gv[bj][0] * acc[ai][bj][m][0], t1 = x1 + gv[bj][1] * acc[ai][bj][m][1];
                        if (!fin) {
                            unsigned b[8];
#pragma unroll
                            for (int e = 0; e < 4; ++e) { const float f0 = t0[e], f1 = t1[e]; b[e] = __builtin_bit_cast(unsigned, f0); b[4 + e] = __builtin_bit_cast(unsigned, f1); }
                            u32x4 hw; hw.x = __builtin_amdgcn_perm(b[1], b[0], 0x07060302u); hw.y = __builtin_amdgcn_perm(b[3], b[2], 0x07060302u); hw.z = __builtin_amdgcn_perm(b[5], b[4], 0x07060302u); hw.w = __builtin_amdgcn_perm(b[7], b[6], 0x07060302u);
                            u32x2 lw; lw.x = __builtin_amdgcn_perm(__builtin_amdgcn_perm(b[3], b[2], 0x0c0c0501u), __builtin_amdgcn_perm(b[1], b[0], 0x0c0c0501u), 0x05040100u);
                            lw.y = __builtin_amdgcn_perm(__builtin_amdgcn_perm(b[7], b[6], 0x0c0c0501u), __builtin_amdgcn_perm(b[5], b[4], 0x0c0c0501u), 0x05040100u);
                            *(u32x4*)(rowh + bj * HALF) = hw; *(u32x2*)(rowl + bj * HALF) = lw; }
                        xn[ai][m][bj][0] = t0; xn[ai][m][bj][1] = t1;
                        ss += ((t0[0] * t0[0] + t0[1] * t0[1]) + (t0[2] * t0[2] + t0[3] * t0[3])) + ((t1[0] * t1[0] + t1[1] * t1[1]) + (t1[2] * t1[2] + t1[3] * t1[3])); }
                    ss += xor_lane<16>(ss); ss = half_sum(ss);
                    if (fq == 0) atomic_add_f32(ssq + row, ss);
                    asm volatile("" ::: "memory"); }
            f32x4 gm[2][2], sh[2][2];
#pragma unroll
            for (int bj = 0; bj < 2; ++bj)
#pragma unroll
                for (int n = 0; n < 2; ++n) { const int c = col0 + bj * HALF + n * 4; const f32x4 gw = *(const f32x4*)(g + c);
                    if (fin) { gm[bj][n] = gw; sh[bj][n] = (f32x4){0.f, 0.f, 0.f, 0.f}; }
                    else { gm[bj][n] = gw * (*(const f32x4*)(shift + (size_t)mr * MODLD + D + c) + 1.0f); sh[bj][n] = *(const f32x4*)(shift + (size_t)mr * MODLD + c); } }
            asm volatile("s_waitcnt vmcnt(0)" ::: "memory");
            if (lane_id() == 0) (void)xb_add(cnt, 1u);
            { unsigned sp = 0; unsigned* tmo = (unsigned*)(ws + WS_CTL) + CW_BAR + XB_TMO;
              while ((unsigned)__builtin_amdgcn_readfirstlane((int)xb_ld(cnt)) < 64u) { __builtin_amdgcn_s_sleep(2);
                  if ((++sp & 255u) == 0u) { if (xb_ld(tmo)) break; if (sp > XB_SPIN_CAP) { atomicAdd(tmo, 1u); break; } } } }
            float rs[2][4];
#pragma unroll
            for (int ai = 0; ai < 2; ++ai)
#pragma unroll
                for (int m = 0; m < 4; ++m) rs[ai][m] = __hip_atomic_load(ssq + row0 + ai * HALF + m * 16, __ATOMIC_RELAXED, __HIP_MEMORY_SCOPE_AGENT);
#pragma unroll
            for (int ai = 0; ai < 2; ++ai)
#pragma unroll
                for (int m = 0; m < 4; ++m) { const int row = row0 + ai * HALF + m * 16; const float rstd = 1.0f / sqrtf(rs[ai][m] * (1.0f / D) + NORM_EPS);
#pragma unroll
                    for (int bj = 0; bj < 2; ++bj) { const f32x4 y0 = xn[ai][m][bj][0] * rstd * gm[bj][0] + sh[bj][0], y1 = xn[ai][m][bj][1] * rstd * gm[bj][1] + sh[bj][1];
                        if (fin) { float* o = out + (size_t)row * D + col0 + bj * HALF; *(f32x4*)o = y0; *(f32x4*)(o + 4) = y1; }
                        else { u32x4 w; w.x = cvt_pk_bf16(y0[0], y0[1]); w.y = cvt_pk_bf16(y0[2], y0[3]); w.z = cvt_pk_bf16(y1[0], y1[1]); w.w = cvt_pk_bf16(y1[2], y1[3]);
                            *(u32x4*)((bf16_t*)(ws + WS_H) + (size_t)row * LDH + col0 + bj * HALF) = w; } }
                    asm volatile("" ::: "memory"); }
        } else {
            float* pb = (float*)(ws + WS_PART) + (size_t)(u.aux - 1) * MC * LDX;
#pragma unroll
            for (int ai = 0; ai < 2; ++ai)
#pragma unroll
                for (int m = 0; m < 4; ++m) { float* rowp = pb + (size_t)(row0 + ai * HALF + m * 16 - ML) * LDX + col0;
#pragma unroll
                    for (int bj = 0; bj < 2; ++bj)
#pragma unroll
                        for (int n = 0; n < 2; ++n) *(f32x4*)(rowp + bj * HALF + n * 4) = gv[bj][n] * acc[ai][bj][m][n]; }
        }
    }
};

struct ProjCtx { unsigned char* ws; int l; int probe; LAS unsigned char* lds; };
template <class T> __device__ __forceinline__ T* pws(const ProjCtx& c, size_t off) { return (T*)(c.ws + off); }
template <int LD, bool SSQ, bool RS, bool ACT, bool ROPE, int NCOPY>
__device__ __forceinline__ void proj_group(const f32x4 (&acc)[2][2][4][2], const int bj, bf16_t* p0, const float cs, float* ssq_out, const float* ssq_in, const float inv_n,
                                           const int rk, const int row0, const int fq, const LAS unsigned char* ldsb) {
    float sqv[2][4];
    if constexpr (RS) {
#pragma unroll
        for (int ai = 0; ai < 2; ++ai)
#pragma unroll
            for (int m = 0; m < 4; ++m) sqv[ai][m] = ssq_in[ai * HALF + m * 16];
    }
#pragma unroll
    for (int ai = 0; ai < 2; ++ai)
#pragma unroll
        for (int m = 0; m < 4; ++m) {
            const int ro = ai * HALF + m * 16;
            f32x4 v0 = acc[ai][bj][m][0], v1 = acc[ai][bj][m][1];
            if constexpr (SSQ) {
                float ss = (v0[0] * v0[0] + v0[1] * v0[1]) + (v0[2] * v0[2] + v0[3] * v0[3]) + (v1[0] * v1[0] + v1[1] * v1[1]) + (v1[2] * v1[2] + v1[3] * v1[3]);
                ss += xor_lane<16>(ss); ss = half_sum(ss);
                if (fq == 0) atomic_add_f32(ssq_out + ro, ss);
            }
            if constexpr (RS) { const float rs = cs * (1.0f / sqrtf(sqv[ai][m] * inv_n + NORM_EPS)); v0 = v0 * rs; v1 = v1 * rs; }
            else if constexpr (!SSQ && !ACT) { v0 = v0 * cs; v1 = v1 * cs; }
            if constexpr (ACT) {
#pragma unroll
                for (int e = 0; e < 4; ++e) { v0[e] = sigmoid_f(v0[e]); v1[e] = sigmoid_f(v1[e]); }
            }
            if constexpr (ROPE) {
                if (rk != 0) {
                    const int t = (row0 + ro) & (SEQ - 1), pos = (rk == 1) ? (t >> 6) : (t & 63);
                    const LAS float* tb = (const LAS float*)(ldsb + ROPE_LDS) + pos * 16 + 8 * (fq & 1);
                    const f32x4 c0 = *(const LAS f32x4*)tb, c1 = *(const LAS f32x4*)(tb + 4), s0 = *(const LAS f32x4*)(tb + 1024), s1 = *(const LAS f32x4*)(tb + 1028);
                    const bool lowh = fq < 2;
#pragma unroll
                    for (int e = 0; e < 4; ++e) {
                        { const float f = v0[e]; const unsigned w = __builtin_bit_cast(unsigned, f); auto rr = __builtin_amdgcn_permlane32_swap(w, w, false, false);
                          const float x1 = __builtin_bit_cast(float, (unsigned)rr[0]), x2 = __builtin_bit_cast(float, (unsigned)rr[1]);
                          v0[e] = lowh ? x1 * c0[e] - x2 * s0[e] : x1 * s0[e] + x2 * c0[e]; }
                        { const float f = v1[e]; const unsigned w = __builtin_bit_cast(unsigned, f); auto rr = __builtin_amdgcn_permlane32_swap(w, w, false, false);
                          const float x1 = __builtin_bit_cast(float, (unsigned)rr[0]), x2 = __builtin_bit_cast(float, (unsigned)rr[1]);
                          v1[e] = lowh ? x1 * c1[e] - x2 * s1[e] : x1 * s1[e] + x2 * c1[e]; }
                    }
                }
            }
            if constexpr (ACT) {
                unsigned g0 = 0u, g1 = 0u;
                g0 = __builtin_amdgcn_cvt_pk_u8_f32(__builtin_rintf(v0[0] * 255.0f), 0, g0); g0 = __builtin_amdgcn_cvt_pk_u8_f32(__builtin_rintf(v0[1] * 255.0f), 1, g0); g0 = __builtin_amdgcn_cvt_pk_u8_f32(__builtin_rintf(v0[2] * 255.0f), 2, g0); g0 = __builtin_amdgcn_cvt_pk_u8_f32(__builtin_rintf(v0[3] * 255.0f), 3, g0);
                g1 = __builtin_amdgcn_cvt_pk_u8_f32(__builtin_rintf(v1[0] * 255.0f), 0, g1); g1 = __builtin_amdgcn_cvt_pk_u8_f32(__builtin_rintf(v1[1] * 255.0f), 1, g1); g1 = __builtin_amdgcn_cvt_pk_u8_f32(__builtin_rintf(v1[2] * 255.0f), 2, g1); g1 = __builtin_amdgcn_cvt_pk_u8_f32(__builtin_rintf(v1[3] * 255.0f), 3, g1);
                u32x2 w; w.x = g0; w.y = g1;
                *(u32x2*)((unsigned char*)p0 + (size_t)ro * LD) = w;
            } else {
            u32x4 w; w.x = cvt_pk_bf16(v0[0], v0[1]); w.y = cvt_pk_bf16(v0[2], v0[3]); w.z = cvt_pk_bf16(v1[0], v1[1]); w.w = cvt_pk_bf16(v1[2], v1[3]);
            bf16_t* p = p0 + (size_t)ro * LD;
#pragma unroll
            for (int cp = 0; cp < NCOPY; ++cp) *(u32x4*)(p + cp * 192) = w;
            }
        }
}
template <int KIND> struct EpiProj {
    static constexpr bool PERM = true;
    ProjCtx c;
    __device__ __forceinline__ void operator()(const f32x4 (&acc)[2][2][4][2], const Unit& u, int wr, int wc, int fr, int fq) const {
        const int row0 = u.pm * BM + wr * 64 + fr, lc = wc * 32 + 8 * fq;
        const LAS unsigned char* tab = c.lds;
        if constexpr (KIND == 0) {
            if (u.pn >= 17) {
#pragma unroll
                for (int bj = 0; bj < 2; ++bj) proj_group<256, false, false, true, false, 1>(acc, bj, (bf16_t*)(pws<unsigned char>(c, WS_G) + ((size_t)(u.pm * 24 + u.pn - 17) << 16) + (row0 & 255) * 256 + bj * 128 + lc), 1.f, nullptr, nullptr, 0.f, 0, row0, fq, tab);
            } else if (u.pn < 6) {
                bf16_t* base = pws<bf16_t>(c, u.pn < 3 ? WS_NAQ : WS_NAK) + (size_t)row0 * 768 + (u.pn < 3 ? u.pn : u.pn - 3) * 256 + lc;
                const float cs = u.pn < 3 ? NA_SCALE * LOG2E : 1.f;
#pragma unroll
                for (int bj = 0; bj < 2; ++bj) proj_group<768, false, false, false, false, 1>(acc, bj, base + bj * 128, cs, nullptr, nullptr, 0.f, 0, row0, fq, tab);
            } else if (u.pn < 9) {
                bf16_t* base = pws<bf16_t>(c, WS_CQ) + (size_t)row0 * 768 + (u.pn - 6) * 256 + lc; float* sq = (c.probe ? pws<float>(c, WS_PART) : pws<float>(c, WS_SSQ) + (size_t)(2 * c.l) * M) + row0;
#pragma unroll
                for (int bj = 0; bj < 2; ++bj) proj_group<768, true, false, false, false, 1>(acc, bj, base + bj * 128, 1.f, sq, nullptr, 0.f, 0, row0, fq, tab);
            } else if (u.pn < 11) {
                bf16_t* base = pws<bf16_t>(c, WS_CKV) + (size_t)row0 * 512 + (u.pn - 9) * 256 + lc; float* sq = (c.probe ? pws<float>(c, WS_PART) : pws<float>(c, WS_SSQ) + (size_t)(2 * c.l + 1) * M) + row0;
#pragma unroll
                for (int bj = 0; bj < 2; ++bj) proj_group<512, true, false, false, false, 1>(acc, bj, base + bj * 128, 1.f, sq, nullptr, 0.f, 0, row0, fq, tab);
            } else if (u.pn < 16) {
                const int rk = row0 < ML ? 1 + (wc & 1) : 0;
#pragma unroll
                for (int bj = 0; bj < 2; ++bj) { const int g = 2 * u.pn + bj; const bool q = g < 27;
                    bf16_t* p0 = pws<bf16_t>(c, q ? WS_DQ : WS_DK) + (size_t)row0 * 640 + (q ? g - 22 : g - 27) * 128 + lc;
                    proj_group<640, false, false, false, true, 1>(acc, bj, p0, q ? DF_SCALE * LOG2E : 1.f, nullptr, nullptr, 0.f, rk, row0, fq, tab); }
            } else {
                if (wc < 2) proj_group<960, false, false, false, true, 5>(acc, 0, pws<bf16_t>(c, WS_MK) + (size_t)row0 * 960 + 128 + lc, 1.f, nullptr, nullptr, 0.f, row0 < ML ? 1 + (wc & 1) : 0, row0, fq, tab);
            }
        } else if constexpr (KIND == 1) {
            const float* sq = pws<float>(c, WS_SSQ) + (size_t)(2 * c.l) * M + row0;
#pragma unroll
            for (int bj = 0; bj < 2; ++bj) { const int g = 2 * u.pn + bj, b32 = 4 * g + wc, bb = b32 % 6;
                if (b32 >= 30) continue;
                bf16_t* p0 = pws<bf16_t>(c, WS_MQ) + (size_t)row0 * 960 + g * 128 + lc;
                if (bb >= 4) proj_group<960, false, true, false, true, 1>(acc, bj, p0, MLA_SCALE * LOG2E, nullptr, sq, 1.0f / 768.0f, row0 < ML ? bb - 3 : 0, row0, fq, tab);
                else proj_group<960, false, true, false, false, 1>(acc, bj, p0, MLA_SCALE * LOG2E, nullptr, sq, 1.0f / 768.0f, 0, row0, fq, tab); }
        } else {
            const float* sq = pws<float>(c, WS_SSQ) + (size_t)(2 * c.l + 1) * M + row0;
#pragma unroll
            for (int bj = 0; bj < 2; ++bj) { const int g = 2 * u.pn + bj; if (g >= 5) continue;
                proj_group<960, false, true, false, false, 1>(acc, bj, pws<bf16_t>(c, WS_MK) + (size_t)row0 * 960 + g * 192 + lc, 1.f, nullptr, sq, 1.0f / 512.0f, 0, row0, fq, tab); }
        }
    }
};

template <int KIND> struct EpiVT {
    static constexpr bool PERM = true;
    bf16_t* VT; const float* ssq;
    __device__ __forceinline__ void operator()(const f32x4 (&acc)[2][2][4][2], const Unit& u, int wr, int wc, int fr, int fq) const {
        const int ch0 = u.pm * BM + wr * 64 + fr, tok0 = u.pn * BM + wc * 32 + 8 * fq;
        constexpr int NCH = KIND == 0 ? 1408 : 640;
        f32x4 sc[2][2];
#pragma unroll
        for (int bj = 0; bj < 2; ++bj)
#pragma unroll
            for (int n = 0; n < 2; ++n) {
                if constexpr (KIND == 1) { const f32x4 s = *(const f32x4*)(ssq + tok0 + bj * HALF + 4 * n);
#pragma unroll
                    for (int e = 0; e < 4; ++e) sc[bj][n][e] = 1.0f / sqrtf(s[e] * (1.0f / 512.0f) + NORM_EPS); }
                else sc[bj][n] = (f32x4){1.f, 1.f, 1.f, 1.f};
            }
#pragma unroll
        for (int ai = 0; ai < 2; ++ai)
#pragma unroll
            for (int m = 0; m < 4; ++m) { const int ch = ch0 + ai * HALF + m * 16; if (ch >= NCH) continue;
                bf16_t* rowp = VT + (size_t)ch * M + tok0;
#pragma unroll
                for (int bj = 0; bj < 2; ++bj) { const f32x4 v0 = acc[ai][bj][m][0] * sc[bj][0], v1 = acc[ai][bj][m][1] * sc[bj][1];
                    u32x4 w; w.x = cvt_pk_bf16(v0[0], v0[1]); w.y = cvt_pk_bf16(v0[2], v0[3]); w.z = cvt_pk_bf16(v1[0], v1[1]); w.w = cvt_pk_bf16(v1[2], v1[3]);
                    *(u32x4*)(rowp + bj * HALF) = w; } }
    }
};

struct EpiMerge {
    static constexpr bool PERM = true;
    unsigned char* ws;
    __device__ __forceinline__ void operator()(const f32x4 (&acc)[2][2][4][2], const Unit& u, int wr, int wc, int fr, int fq) const {
        const int row0 = u.pm * BM + wr * 64 + fr, col0 = u.pn * BM + wc * 32 + 8 * fq, br = u.aux & 3; const bool atom = u.aux >= 4;
        const bf16_t* G = (const bf16_t*)(ws + WS_G); bf16_t* Y = (bf16_t*)(ws + WS_Y);
#pragma unroll
        for (int ai = 0; ai < 2; ++ai)
#pragma unroll
            for (int m = 0; m < 4; ++m) { const int row = row0 + ai * HALF + m * 16;
#pragma unroll
                for (int bj = 0; bj < 2; ++bj) { const int col = col0 + bj * HALF;
                    const u32x2 gw = *(const u32x2*)((const unsigned char*)G + ((size_t)(u.pm * 24 + br * 8 + u.pn) << 16) + (row & 255) * 256 + (col & 255));
                    f32x4 v0 = acc[ai][bj][m][0] * (1.0f / 255.0f), v1 = acc[ai][bj][m][1] * (1.0f / 255.0f);
                    v0[0] *= (float)(gw.x & 0xffu); v0[1] *= (float)((gw.x >> 8) & 0xffu); v0[2] *= (float)((gw.x >> 16) & 0xffu); v0[3] *= (float)(gw.x >> 24);
                    v1[0] *= (float)(gw.y & 0xffu); v1[1] *= (float)((gw.y >> 8) & 0xffu); v1[2] *= (float)((gw.y >> 16) & 0xffu); v1[3] *= (float)(gw.y >> 24);
                    bf16_t* yp = Y + (size_t)row * D + col;
                    if (!atom && br != 0) { const u32x4 yw = *(const u32x4*)yp;
                        v0[0] += bflo(yw.x); v0[1] += bfhi(yw.x); v0[2] += bflo(yw.y); v0[3] += bfhi(yw.y);
                        v1[0] += bflo(yw.z); v1[1] += bfhi(yw.z); v1[2] += bflo(yw.w); v1[3] += bfhi(yw.w); }
                    const unsigned a0 = cvt_pk_bf16(v0[0], v0[1]), a1 = cvt_pk_bf16(v0[2], v0[3]), a2 = cvt_pk_bf16(v1[0], v1[1]), a3 = cvt_pk_bf16(v1[2], v1[3]);
                    if (!atom) { u32x4 w; w.x = a0; w.y = a1; w.z = a2; w.w = a3; *(u32x4*)yp = w; }
                    else { typedef short s16x2 __attribute__((ext_vector_type(2))); GAS s16x2* ap = (GAS s16x2*)yp;
                        s16x2 b0 = __builtin_bit_cast(s16x2, a0), b1 = __builtin_bit_cast(s16x2, a1), b2 = __builtin_bit_cast(s16x2, a2), b3 = __builtin_bit_cast(s16x2, a3);
                        __builtin_amdgcn_global_atomic_fadd_v2bf16(ap, b0); __builtin_amdgcn_global_atomic_fadd_v2bf16(ap + 1, b1);
                        __builtin_amdgcn_global_atomic_fadd_v2bf16(ap + 2, b2); __builtin_amdgcn_global_atomic_fadd_v2bf16(ap + 3, b3); } }
                asm volatile("" ::: "memory"); }
    }
};
}
struct Frame {
    LAS unsigned char* lds;
    volatile LAS unsigned* MISC;
    gu32* ctl;
    unsigned char* ws;
    int wave, vcu, G;
};
struct Args { const float* in[20]; float* out; unsigned char* ws; int ph_lo, ph_hi; };
enum { I_X = 0, I_C, I_CTX, I_CCTX, I_WADA, I_BADA, I_NORMW, I_FFNIN, I_FFNOUT, I_WIN, I_RPB, I_QNORM, I_KVNORM, I_WUQ, I_WUKV, I_DLAM, I_SUBLN, I_WBR, I_WOUT, I_FNORM };
template <class T> __device__ __forceinline__ T* wsp(const Frame& F, size_t off) { return (T*)(F.ws + off); }

__device__ __forceinline__ bf16_t* dest_row(const Frame& F, int mat, int li, int n) {
    switch (mat) {
    case 0: { const int half = n >= FF ? 1 : 0, jj = n - half * FF; return wsp<bf16_t>(F, WS_WFI + (size_t)li * WFI_SZ) + (size_t)(256 * (jj >> 7) + 128 * half + (jj & 127)) * D; }
    case 1: return wsp<bf16_t>(F, WS_WFO + (size_t)li * WFO_SZ) + (size_t)n * FF;
    case 2: { bf16_t* win = wsp<bf16_t>(F, WS_WIN + (size_t)li * WIN_SZ); bf16_t* wvt = wsp<bf16_t>(F, WS_WVT + (size_t)li * WVT_SZ);
        if (n < 1536) return win + (size_t)n * D;
        if (n < 2304) return wvt + (size_t)(n - 1536) * D;
        if (n < 3584) return win + (size_t)(n - 2304 + 1536) * D;
        if (n < 3648) return win + (size_t)(n - 3584 + 4096) * D;
        if (n < 4928) return win + (size_t)(n - 3648 + 2816) * D;
        if (n < 5568) return wvt + (size_t)(n - 4928 + 768) * D;
        return win + (size_t)(n - 5568 + 4352) * D; }
    case 3: return wsp<bf16_t>(F, WS_WUQ + (size_t)li * WUQ_SZ) + (size_t)n * 768;
    case 4: { const int h = n >> 8, r = n & 255; return r < 128 ? wsp<bf16_t>(F, WS_WUK + (size_t)li * WUK_SZ) + (size_t)(h * 128 + r) * 512 : wsp<bf16_t>(F, WS_WUV + (size_t)li * WUK_SZ) + (size_t)(h * 128 + r - 128) * 512; }
    case 5: return wsp<bf16_t>(F, WS_WBR + (size_t)li * WSQ_SZ) + (size_t)n * D;
    default: return wsp<bf16_t>(F, WS_WO + (size_t)li * WSQ_SZ) + (size_t)n * D;
    }
}
__device__ __forceinline__ void transpose_item(const Frame& F, const float* W, int N, const float* gk, int mat, int li, LAS float* scr, int kb, int nb, int lane) {
    const int k0 = 64 * kb, n0 = 32 * nb, kr = lane >> 3, c4 = 4 * (lane & 7);
    f32x4 v[8];
#pragma unroll
    for (int i = 0; i < 8; ++i) v[i] = *(const f32x4*)(W + (size_t)(k0 + 8 * i + kr) * N + n0 + c4);
#pragma unroll
    for (int i = 0; i < 8; ++i) { const int kk = 8 * i + kr; f32x4 x = v[i]; if (gk) x = x * gk[k0 + kk];
        LAS float* d = scr + kk * 33 + c4; d[0] = x[0]; d[1] = x[1]; d[2] = x[2]; d[3] = x[3]; }
    LDS_WAIT(); asm volatile("" ::: "memory");
    const int c = lane & 7;
#pragma unroll
    for (int j = 0; j < 4; ++j) { const int n = (lane >> 3) + 8 * j; const LAS float* s = scr + (8 * c) * 33 + n;
        u32x4 o; o.x = pk2(s[0 * 33], s[1 * 33]); o.y = pk2(s[2 * 33], s[3 * 33]); o.z = pk2(s[4 * 33], s[5 * 33]); o.w = pk2(s[6 * 33], s[7 * 33]);
        bf16_t* dr = dest_row(F, mat, li, n0 + n);
        *(GAS u32x4*)(dr + k0 + 8 * c) = o; }
    LDS_WAIT(); asm volatile("" ::: "memory");
}
__device__ __forceinline__ void zero_rows(bf16_t* p, size_t nelem, int gtid, int gthreads) {
    const u32x4 z = {0u, 0u, 0u, 0u};
    for (size_t i = (size_t)gtid; i < nelem / 8; i += gthreads) ((u32x4*)p)[i] = z;
}
#ifndef WCV_RES
#define WCV_RES 3840
#endif
namespace wcv {
constexpr int I_FI = (D / 64) * (2 * FF / 32), I_FO = (FF / 64) * (D / 32), I_IN = (D / 64) * (INW / 32), I_UQ = (768 / 64) * (960 / 32), I_UKV = (512 / 64) * (1280 / 32), I_SQ = (D / 64) * (D / 32);
constexpr int NH0 = I_FI + I_FO + I_IN + I_UQ + I_UKV, NH1 = I_FI + I_FO + 2 * I_SQ;
__host__ __device__ constexpr int nitems(int half) { return half == 0 ? NH0 : NH1; }
}
__device__ __forceinline__ void convert_item(const Frame& F, const Args& args, int L, int half, int j, LAS float* scr, int lane) {
    using namespace wcv;
    int r = j, mat, li = L, N, nbs; const float* W; const float* gk = nullptr;
    if (r < I_FI) { li = 2 * L + half; mat = 0; W = args.in[I_FFNIN] + (size_t)li * D * 2 * FF; N = 2 * FF; nbs = 2 * FF / 32; }
    else if (half == 0) {
        if ((r -= I_FI) < I_FO) { li = 2 * L; mat = 1; W = args.in[I_FFNOUT] + (size_t)li * FF * D; N = D; nbs = D / 32; }
        else if ((r -= I_FO) < I_IN) { mat = 2; W = args.in[I_WIN] + (size_t)L * D * INW; N = INW; nbs = INW / 32; }
        else if ((r -= I_IN) < I_UQ) { mat = 3; W = args.in[I_WUQ] + (size_t)L * 768 * 960; N = 960; nbs = 30; gk = args.in[I_QNORM] + L * 768; }
        else { r -= I_UQ; mat = 4; W = args.in[I_WUKV] + (size_t)L * 512 * 1280; N = 1280; nbs = 40; gk = args.in[I_KVNORM] + L * 512; }
    } else {
        if ((r -= I_FI) < I_SQ) { mat = 5; W = args.in[I_WBR] + (size_t)L * D * D; N = D; nbs = 64; }
        else if ((r -= I_SQ) < I_SQ) { mat = 6; W = args.in[I_WOUT] + (size_t)L * D * D; N = D; nbs = 64; }
        else { r -= I_SQ; li = 2 * L + 1; mat = 1; W = args.in[I_FFNOUT] + (size_t)li * FF * D; N = D; nbs = D / 32; }
    }
    transpose_item(F, W, N, gk, mat, li, scr, r / nbs, r % nbs, lane);
}
struct CvItem { const float* W; const float* gk; int N, mat, li, kb, nb; };
__device__ __forceinline__ CvItem convert_decode(const Args& args, int L, int half, int j) {
    using namespace wcv;
    int r = j, mat, li = L, N, nbs; const float* W; const float* gk = nullptr;
    if (r < I_FI) { li = 2 * L + half; mat = 0; W = args.in[I_FFNIN] + (size_t)li * D * 2 * FF; N = 2 * FF; nbs = 2 * FF / 32; }
    else if (half == 0) {
        if ((r -= I_FI) < I_FO) { li = 2 * L; mat = 1; W = args.in[I_FFNOUT] + (size_t)li * FF * D; N = D; nbs = D / 32; }
        else if ((r -= I_FO) < I_IN) { mat = 2; W = args.in[I_WIN] + (size_t)L * D * INW; N = INW; nbs = INW / 32; }
        else if ((r -= I_IN) < I_UQ) { mat = 3; W = args.in[I_WUQ] + (size_t)L * 768 * 960; N = 960; nbs = 30; gk = args.in[I_QNORM] + L * 768; }
        else { r -= I_UQ; mat = 4; W = args.in[I_WUKV] + (size_t)L * 512 * 1280; N = 1280; nbs = 40; gk = args.in[I_KVNORM] + L * 512; }
    } else {
        if ((r -= I_FI) < I_SQ) { mat = 5; W = args.in[I_WBR] + (size_t)L * D * D; N = D; nbs = 64; }
        else if ((r -= I_SQ) < I_SQ) { mat = 6; W = args.in[I_WOUT] + (size_t)L * D * D; N = D; nbs = 64; }
        else { r -= I_SQ; li = 2 * L + 1; mat = 1; W = args.in[I_FFNOUT] + (size_t)li * FF * D; N = D; nbs = D / 32; }
    }
    CvItem c; c.W = W; c.gk = gk; c.N = N; c.mat = mat; c.li = li; c.kb = r / nbs; c.nb = r % nbs; return c;
}
__device__ __forceinline__ void cv_load(const CvItem& c, int lane, f32x4 (&v)[8]) {
    const int k0 = 64 * c.kb, n0 = 32 * c.nb, kr = lane >> 3, c4 = 4 * (lane & 7);
#pragma unroll
    for (int i = 0; i < 8; ++i) v[i] = __builtin_nontemporal_load((const f32x4*)(c.W + (size_t)(k0 + 8 * i + kr) * c.N + n0 + c4));
}
__device__ __forceinline__ void cv_finish(const Frame& F, const CvItem& c, LAS float* scr, int lane, const f32x4 (&v)[8]) {
    const int k0 = 64 * c.kb, n0 = 32 * c.nb, kr = lane >> 3, c4 = 4 * (lane & 7);
#pragma unroll
    for (int i = 0; i < 8; ++i) { const int kk = 8 * i + kr; f32x4 x = v[i]; if (c.gk) x = x * c.gk[k0 + kk];
        LAS float* d = scr + kk * 33 + c4; d[0] = x[0]; d[1] = x[1]; d[2] = x[2]; d[3] = x[3]; }
    LDS_WAIT(); asm volatile("" ::: "memory");
    const int cc = lane & 7;
#pragma unroll
    for (int j = 0; j < 4; ++j) { const int n = (lane >> 3) + 8 * j; const LAS float* sp = scr + (8 * cc) * 33 + n;
        u32x4 o; o.x = pk2(sp[0 * 33], sp[1 * 33]); o.y = pk2(sp[2 * 33], sp[3 * 33]); o.z = pk2(sp[4 * 33], sp[5 * 33]); o.w = pk2(sp[6 * 33], sp[7 * 33]);
        bf16_t* dr = dest_row(F, c.mat, c.li, n0 + n);
        __builtin_nontemporal_store(o, (u32x4*)(dr + k0 + 8 * cc)); }
    LDS_WAIT(); asm volatile("" ::: "memory");
}
template <int WCV_TAKE = 12>
__device__ __forceinline__ void convert_fill(const Frame& F, const Args& args, int L, int half, gu32* ctr, int jlo, int jhi) {
    LAS float* scr = (LAS float*)(F.lds + RING_OFF + F.wave * 16384);
    const int lane = (tid_of(F.wave) & 63), x0 = (int)(xb_xcc_id() & 7u);
    const int NI = jhi - jlo, NLC = (NI + 7) / 8;
    unsigned long long live;
    { const int xl = lane & 7, lol = xl * NLC, nl = (lol + NLC <= NI) ? NLC : (NI - lol);
      const unsigned cv = __hip_atomic_load(ctr + 64 * xl, RLX_AGENT);
      live = __builtin_amdgcn_ballot_w64((int)cv < nl); }
    for (int k = 0; k < 8; ++k) {
        const int x = (x0 + k) & 7, lo = x * NLC, n = (lo + NLC <= NI) ? NLC : (NI - lo);
        if (!((live >> x) & 1ull)) continue;
        for (;;) {
            unsigned b = 0u;
            if (lane == 0) b = __hip_atomic_fetch_add(ctr + 64 * x, (unsigned)WCV_TAKE, RLX_AGENT);
            b = (unsigned)__builtin_amdgcn_readfirstlane((int)b);
            if ((int)b >= n) break;
            const int cnt = (n - (int)b < WCV_TAKE) ? n - (int)b : WCV_TAKE, j0 = jlo + lo + (int)b;
            f32x4 va[8], vb[8], vc[8];
            if (cnt == WCV_TAKE) {
                CvItem ca = convert_decode(args, L, half, j0), cb = convert_decode(args, L, half, j0 + 1), cc = ca;
                cv_load(ca, lane, va); cv_load(cb, lane, vb);
                int i = 0;
                for (; i + 5 < WCV_TAKE; i += 3) {
                    cc = convert_decode(args, L, half, j0 + i + 2); cv_load(cc, lane, vc); cv_finish(F, ca, scr, lane, va);
                    ca = convert_decode(args, L, half, j0 + i + 3); cv_load(ca, lane, va); cv_finish(F, cb, scr, lane, vb);
                    cb = convert_decode(args, L, half, j0 + i + 4); cv_load(cb, lane, vb); cv_finish(F, cc, scr, lane, vc);
                }
                cc = convert_decode(args, L, half, j0 + WCV_TAKE - 1); cv_load(cc, lane, vc);
                cv_finish(F, ca, scr, lane, va); cv_finish(F, cb, scr, lane, vb); cv_finish(F, cc, scr, lane, vc);
            } else {
                for (int i = 0; i < cnt; ++i) { const CvItem ca = convert_decode(args, L, half, j0 + i); cv_load(ca, lane, va); cv_finish(F, ca, scr, lane, va); }
            }
        }
    }
}
__device__ __forceinline__ void p0_prologue(Frame& F, const Args& args, bool with_mod) {
    LAS float* scr = (LAS float*)(F.lds + RING_OFF + F.wave * 16384);
    const int gw = F.vcu * NWAVES + F.wave, NGW = F.G * NWAVES, lane = (tid_of(F.wave) & 63);
    if (with_mod)
    {
        float* mod = wsp<float>(F, WS_MOD);
        constexpr int NCH = MODLD / 256, NKS = D / 32, NIT = DEPTH * NKS * NCH;
        for (int it = gw; it < NIT; it += NGW) {
            const int l = it / (NKS * NCH), r = it % (NKS * NCH), ks = r / NCH, cc = r % NCH, n = cc * 256 + 4 * lane;
            f32x4 a0 = {0.f, 0.f, 0.f, 0.f}, a1 = a0, a2 = a0;
            const float* wp = args.in[I_WADA] + ((size_t)l * D + (size_t)ks * 32) * MODLD + n;
#pragma unroll 16
            for (int kk = 0; kk < 32; ++kk) { const int k = ks * 32 + kk; const f32x4 w = *(const f32x4*)(wp + (size_t)kk * MODLD);
                const float s0 = silu_f(args.in[I_C][k]), s1 = silu_f(args.in[I_C][D + k]), s2 = silu_f(args.in[I_CCTX][k]);
                a0 = a0 + w * s0; a1 = a1 + w * s1; a2 = a2 + w * s2; }
            if (ks == 0) { const f32x4 b = *(const f32x4*)(args.in[I_BADA] + (size_t)l * MODLD + n); a0 = a0 + b; a1 = a1 + b; a2 = a2 + b; }
            float* mp = mod + (size_t)l * 3 * MODLD + n;
#pragma unroll
            for (int e = 0; e < 4; ++e) { atomic_add_f32(mp + e, a0[e]); atomic_add_f32(mp + MODLD + e, a1[e]); atomic_add_f32(mp + 2 * MODLD + e, a2[e]); }
        }
    }
    for (int j = gw; j < wcv::NH0 - WCV_RES; j += NGW) convert_item(F, args, 0, 0, j < wcv::I_FI ? j : j + WCV_RES, scr, lane);
    {
        const int gtid = (F.vcu * NWAVES + F.wave) * 64 + lane, gth = F.G * NTHREADS;
        for (int l = 0; l < DEPTH; ++l) {
            zero_rows(wsp<bf16_t>(F, WS_WIN + (size_t)l * WIN_SZ) + (size_t)4160 * D, (size_t)192 * D, gtid, gth);
            zero_rows(wsp<bf16_t>(F, WS_WVT + (size_t)l * WVT_SZ) + (size_t)1408 * D, (size_t)128 * D, gtid, gth);
            zero_rows(wsp<bf16_t>(F, WS_WUQ + (size_t)l * WUQ_SZ) + (size_t)960 * 768, (size_t)64 * 768, gtid, gth);
            zero_rows(wsp<bf16_t>(F, WS_WUK + (size_t)l * WUK_SZ) + (size_t)640 * 512, (size_t)128 * 512, gtid, gth);
            zero_rows(wsp<bf16_t>(F, WS_WUV + (size_t)l * WUK_SZ) + (size_t)640 * 512, (size_t)128 * 512, gtid, gth);
        }
    }
}

__device__ __forceinline__ void norm_mod_phase(Frame& F, const float* g, const float* shift0, const float* scale0, int row_lo, int nrows, int nsplit, const float* xin_lat = nullptr, const float* xin_ctx = nullptr) {
    const int gw = F.vcu * NWAVES + F.wave, NGW = F.G * NWAVES, lane = (tid_of(F.wave) & 63);
    float* xs = wsp<float>(F, WS_XS); bf16_t* H = wsp<bf16_t>(F, WS_H);
    for (int m = row_lo + gw; m < nrows; m += NGW) {
        const int mr = m < SEQ ? 0 : (m < ML ? 1 : 2);
        const f32x4* xr = (const f32x4*)(xin_lat ? (m < ML ? xin_lat + (size_t)m * D : xin_ctx + (size_t)(m - ML) * D) : xs + (size_t)m * LDX) + lane;
        const f32x4* g4 = (const f32x4*)g + lane; const f32x4* sh4 = (const f32x4*)(shift0 + (size_t)mr * MODLD) + lane; const f32x4* sc4 = (const f32x4*)(scale0 + (size_t)mr * MODLD) + lane;
        f32x4 v[8], gv[8], shv[8], scv[8]; float s = 0.f;
#pragma unroll
        for (int j = 0; j < 8; ++j) v[j] = xr[64 * j];
#pragma unroll
        for (int j = 0; j < 8; ++j) { gv[j] = g4[64 * j]; shv[j] = sh4[64 * j]; scv[j] = sc4[64 * j]; }
        if (m >= ML && (nsplit > 0 || xin_lat)) {
            const f32x4* pr = (const f32x4*)(wsp<float>(F, WS_PART) + (size_t)(m - ML) * LDX) + lane;
            for (int sp = 0; sp < nsplit; ++sp) {
#pragma unroll
                for (int j = 0; j < 8; ++j) v[j] = v[j] + pr[(size_t)sp * (MC * LDX / 4) + 64 * j]; }
            f32x4* xw = (f32x4*)(xs + (size_t)m * LDX) + lane;
#pragma unroll
            for (int j = 0; j < 8; ++j) xw[64 * j] = v[j];
        }
#pragma unroll
        for (int j = 0; j < 8; ++j) s += (v[j][0] * v[j][0] + v[j][1] * v[j][1]) + (v[j][2] * v[j][2] + v[j][3] * v[j][3]);
        const float rstd = 1.0f / sqrtf(wave_sum(s) * (1.0f / D) + NORM_EPS);
        u32x2* o8 = (u32x2*)(H + (size_t)m * LDH) + lane;
#pragma unroll
        for (int j = 0; j < 8; ++j) { const f32x4 gg = gv[j], sh = shv[j], sc = scv[j];
            const f32x4 y = v[j] * rstd * gg * (sc + 1.0f) + sh;
            u32x2 w; w.x = pk2(y[0], y[1]); w.y = pk2(y[2], y[3]); o8[64 * j] = w; }
    }
}
template <int NSPLIT>
__device__ __forceinline__ void ctx_norm_phase(Frame& F, const float* g, const float* shift0, const float* scale0) {
    const int lane = (tid_of(F.wave) & 63), q = F.wave & 3, col = 512 * q + 4 * lane;
    LAS float* red = (LAS float*)(F.lds + RING_OFF);
    float* xs = wsp<float>(F, WS_XS); bf16_t* H = wsp<bf16_t>(F, WS_H);
    for (int r0 = 2 * F.vcu; r0 < MC; r0 += 2 * F.G) {
        const int rc = r0 + (F.wave >> 2), m = ML + rc;
        float* xr = xs + (size_t)m * LDX + col; const float* pr = wsp<float>(F, WS_PART) + (size_t)rc * LDX + col;
        f32x4 v0 = *(const f32x4*)xr, v1 = *(const f32x4*)(xr + 256), p0[NSPLIT], p1[NSPLIT];
#pragma unroll
        for (int sp = 0; sp < NSPLIT; ++sp) { p0[sp] = *(const f32x4*)(pr + (size_t)sp * MC * LDX); p1[sp] = *(const f32x4*)(pr + (size_t)sp * MC * LDX + 256); }
        const f32x4 g0 = *(const f32x4*)(g + col), g1 = *(const f32x4*)(g + col + 256);
        const f32x4 sh0 = *(const f32x4*)(shift0 + (size_t)2 * MODLD + col), sh1 = *(const f32x4*)(shift0 + (size_t)2 * MODLD + col + 256);
        const f32x4 sc0 = *(const f32x4*)(scale0 + (size_t)2 * MODLD + col), sc1 = *(const f32x4*)(scale0 + (size_t)2 * MODLD + col + 256);
#pragma unroll
        for (int sp = 0; sp < NSPLIT; ++sp) { v0 = v0 + p0[sp]; v1 = v1 + p1[sp]; }
        *(f32x4*)xr = v0; *(f32x4*)(xr + 256) = v1;
        const float ssum = wave_sum(((v0[0] * v0[0] + v0[1] * v0[1]) + (v0[2] * v0[2] + v0[3] * v0[3])) + ((v1[0] * v1[0] + v1[1] * v1[1]) + (v1[2] * v1[2] + v1[3] * v1[3])));
        if (lane == 0) red[F.wave] = ssum;
        __syncthreads();
        const int wb = F.wave & 4;
        const float rstd = 1.0f / sqrtf(((red[wb] + red[wb + 1]) + (red[wb + 2] + red[wb + 3])) * (1.0f / D) + NORM_EPS);
        const f32x4 y0 = v0 * rstd * g0 * (sc0 + 1.0f) + sh0, y1 = v1 * rstd * g1 * (sc1 + 1.0f) + sh1;
        u32x2 w0, w1; w0.x = pk2(y0[0], y0[1]); w0.y = pk2(y0[2], y0[3]); w1.x = pk2(y1[0], y1[1]); w1.y = pk2(y1[2], y1[3]);
        *(u32x2*)(H + (size_t)m * LDH + col) = w0; *(u32x2*)(H + (size_t)m * LDH + col + 256) = w1;
        __syncthreads();
    }
}
struct AttnCtx {
    const bf16_t *naq, *nak, *dq, *dk, *mq, *mk, *vtin, *vtm; bf16_t* omix;
    const float* rpb;
    const float* subln;
    float lam, one_m_li;
};
constexpr int ANQ = 4;
template <int TYPE>
__device__ __forceinline__ void attn_naive_task(const AttnCtx& A, LAS float* Qs, LAS float* Ps, int lane, int b, int h, int qrow0  , bool is_ctx) {
    constexpr int DQ = TYPE == 1 ? 192 : 128;
    constexpr int NS = TYPE == 2 ? 2 : 1;
    const bf16_t* Q; const bf16_t* K; const bf16_t* VT; int ldq, ocol;
    if (TYPE == 0) { Q = A.naq + h * 128; K = A.nak + h * 128; ldq = 768; VT = A.vtin + (size_t)(h * 128) * M; ocol = h * 128; }
    else if (TYPE == 1) { Q = A.mq + h * 192; K = A.mk + h * 192; ldq = 960; VT = A.vtm + (size_t)(h * 128) * M; ocol = 768 + h * 128; }
    else { Q = A.dq + h * 128; K = A.dk + h * 128; ldq = 640; VT = A.vtin + (size_t)(768 + h * 128) * M; ocol = 1408 + h * 128; }
#pragma unroll
    for (int q = 0; q < ANQ; ++q)
#pragma unroll
        for (int d = lane; d < DQ; d += 64) Qs[q * 192 + d] = bf2f(Q[(size_t)(qrow0 + q) * ldq + d]);
    LDS_WAIT(); __builtin_amdgcn_wave_barrier(); asm volatile("" ::: "memory");
    const int t_in = qrow0 & (SEQ - 1), gr = t_in >> 6, qc0 = t_in & 63;
    int r0 = gr - 4; r0 = r0 < 0 ? 0 : (r0 > 56 ? 56 : r0);
    const int nlat = is_ctx ? 0 : (TYPE == 0 ? 8 : 64), ntiles = 4 + nlat;
    float mrun[NS][ANQ], lrun[NS][ANQ], o[NS][ANQ][2];
#pragma unroll
    for (int s = 0; s < NS; ++s)
#pragma unroll
        for (int q = 0; q < ANQ; ++q) { mrun[s][q] = -1e30f; lrun[s][q] = 0.f; o[s][q][0] = 0.f; o[s][q][1] = 0.f; }
    for (int ti = 0; ti < ntiles; ++ti) {
        int tok0, kr = 0; bool local = false;
        if (ti < 4) tok0 = ML + b * CTXL + 64 * ti;
        else if (TYPE == 0) { kr = r0 + (ti - 4); tok0 = b * SEQ + 64 * kr; local = true; }
        else tok0 = b * SEQ + 64 * (ti - 4);
        float s[NS][ANQ];
#pragma unroll
        for (int ss = 0; ss < NS; ++ss)
#pragma unroll
            for (int q = 0; q < ANQ; ++q) s[ss][q] = 0.f;
        const bf16_t* kp = K + (size_t)(tok0 + lane) * ldq;
#pragma unroll 1
        for (int c8 = 0; c8 < DQ / 8; ++c8) {
            const u32x4 kw = *(const u32x4*)(kp + 8 * c8);
            const float k0 = bflo(kw.x), k1 = bfhi(kw.x), k2 = bflo(kw.y), k3 = bfhi(kw.y), k4 = bflo(kw.z), k5 = bfhi(kw.z), k6 = bflo(kw.w), k7 = bfhi(kw.w);
            const int ss = (TYPE == 2 && c8 >= 8) ? 1 : 0;
#pragma unroll
            for (int q = 0; q < ANQ; ++q) { const f32x4 qa = *(const LAS f32x4*)(Qs + q * 192 + 8 * c8), qb = *(const LAS f32x4*)(Qs + q * 192 + 8 * c8 + 4);
                const float dsum = (qa[0] * k0 + qa[1] * k1) + (qa[2] * k2 + qa[3] * k3) + (qb[0] * k4 + qb[1] * k5) + (qb[2] * k6 + qb[3] * k7);
                if (NS == 2) { if (ss == 0) s[0][q] += dsum; else s[NS - 1][q] += dsum; } else s[0][q] += dsum; }
        }
        if (TYPE == 0 && local) {
#pragma unroll
            for (int q = 0; q < ANQ; ++q) { const int qc = qc0 + q; int c0 = qc - 8; c0 = c0 < 0 ? 0 : (c0 > 48 ? 48 : c0);
                const bool ok = lane >= c0 && lane < c0 + 16;
                int co = lane - qc; co = co < -15 ? -15 : (co > 15 ? 15 : co);
                const float bias = A.rpb[(h * 15 + (kr - gr + 7)) * 31 + co + 15] * LOG2E;
                s[0][q] = ok ? s[0][q] + bias : -1e30f; }
        }
#pragma unroll
        for (int ss = 0; ss < NS; ++ss)
#pragma unroll
            for (int q = 0; q < ANQ; ++q) {
                const float tm = wave_max(s[ss][q]); const float mn = fmaxf(mrun[ss][q], tm); const float alpha = fast_exp2(mrun[ss][q] - mn);
                const float p = fast_exp2(s[ss][q] - mn); lrun[ss][q] = lrun[ss][q] * alpha + wave_sum(p); mrun[ss][q] = mn;
                o[ss][q][0] *= alpha; o[ss][q][1] *= alpha;
                Ps[(ss * ANQ + q) * 64 + lane] = p; }
        LDS_WAIT(); __builtin_amdgcn_wave_barrier(); asm volatile("" ::: "memory");
        const bf16_t* v0p = VT + (size_t)(2 * lane) * M + tok0; const bf16_t* v1p = v0p + M;
#pragma unroll 1
        for (int jc = 0; jc < 8; ++jc) {
            const u32x4 a = *(const u32x4*)(v0p + 8 * jc), bq = *(const u32x4*)(v1p + 8 * jc);
            const float va[8] = {bflo(a.x), bfhi(a.x), bflo(a.y), bfhi(a.y), bflo(a.z), bfhi(a.z), bflo(a.w), bfhi(a.w)};
            const float vb[8] = {bflo(bq.x), bfhi(bq.x), bflo(bq.y), bfhi(bq.y), bflo(bq.z), bfhi(bq.z), bflo(bq.w), bfhi(bq.w)};
#pragma unroll
            for (int ss = 0; ss < NS; ++ss)
#pragma unroll
                for (int q = 0; q < ANQ; ++q) { const f32x4 pa = *(const LAS f32x4*)(Ps + (ss * ANQ + q) * 64 + 8 * jc), pb = *(const LAS f32x4*)(Ps + (ss * ANQ + q) * 64 + 8 * jc + 4);
                    o[ss][q][0] += (pa[0] * va[0] + pa[1] * va[1]) + (pa[2] * va[2] + pa[3] * va[3]) + (pb[0] * va[4] + pb[1] * va[5]) + (pb[2] * va[6] + pb[3] * va[7]);
                    o[ss][q][1] += (pa[0] * vb[0] + pa[1] * vb[1]) + (pa[2] * vb[2] + pa[3] * vb[3]) + (pb[0] * vb[4] + pb[1] * vb[5]) + (pb[2] * vb[6] + pb[3] * vb[7]); }
        }
        LDS_WAIT(); __builtin_amdgcn_wave_barrier(); asm volatile("" ::: "memory");
    }
#pragma unroll
    for (int q = 0; q < ANQ; ++q) {
        float r0v, r1v;
        if (NS == 1) { const float il = 1.0f / lrun[0][q]; r0v = o[0][q][0] * il; r1v = o[0][q][1] * il; }
        else { const float i1 = 1.0f / lrun[0][q], i2 = A.lam / lrun[NS - 1][q]; r0v = o[0][q][0] * i1 - o[NS - 1][q][0] * i2; r1v = o[0][q][1] * i1 - o[NS - 1][q][1] * i2;
            const float ssq = wave_sum(r0v * r0v + r1v * r1v); const float rr = (1.0f / sqrtf(ssq * (1.0f / 128.0f) + NORM_EPS)) * A.one_m_li;
            r0v *= rr * A.subln[2 * lane]; r1v *= rr * A.subln[2 * lane + 1]; }
        *(unsigned*)(A.omix + (size_t)(qrow0 + q) * D + ocol + 2 * lane) = pk2(r0v, r1v);
    }
}
__device__ __forceinline__ void attn_naive_phase(Frame& F, const AttnCtx& A, bool with_ctx) {
    const int gw = F.vcu * NWAVES + F.wave, NGW = F.G * NWAVES, lane = (tid_of(F.wave) & 63);
    LAS float* Qs = (LAS float*)(F.lds + RING_OFF + F.wave * 8192); LAS float* Ps = Qs + ANQ * 192;
    constexpr int GPB = SEQ / ANQ, CGPB = CTXL / ANQ;
    constexpr int T_MLA = NBATCH * H_MLA * GPB, T_DF = NBATCH * H_DF * GPB, T_NA = NBATCH * H_NA * GPB, T_LAT = T_MLA + T_DF + T_NA;
    constexpr int C_MLA = NBATCH * H_MLA * CGPB, C_DF = NBATCH * H_DF * CGPB, C_NA = NBATCH * H_NA * CGPB;
    const int total = T_LAT + (with_ctx ? C_MLA + C_DF + C_NA : 0);
    for (int t = gw; t < total; t += NGW) {
        int r = t, type, b, h, g; bool isc = false;
        if (r < T_MLA) { type = 1; b = r / (H_MLA * GPB); h = (r / GPB) % H_MLA; g = r % GPB; }
        else if ((r -= T_MLA) < T_DF) { type = 2; b = r / (H_DF * GPB); h = (r / GPB) % H_DF; g = r % GPB; }
        else if ((r -= T_DF) < T_NA) { type = 0; b = r / (H_NA * GPB); h = (r / GPB) % H_NA; g = r % GPB; }
        else if ((r -= T_NA) < C_MLA) { type = 1; isc = true; b = r / (H_MLA * CGPB); h = (r / CGPB) % H_MLA; g = r % CGPB; }
        else if ((r -= C_MLA) < C_DF) { type = 2; isc = true; b = r / (H_DF * CGPB); h = (r / CGPB) % H_DF; g = r % CGPB; }
        else { r -= C_DF; type = 0; isc = true; b = r / (H_NA * CGPB); h = (r / CGPB) % H_NA; g = r % CGPB; }
        const int qrow0 = isc ? ML + b * CTXL + ANQ * g : b * SEQ + ANQ * g;
        if (type == 1) attn_naive_task<1>(A, Qs, Ps, lane, b, h, qrow0, isc);
        else if (type == 2) attn_naive_task<2>(A, Qs, Ps, lane, b, h, qrow0, isc);
        else attn_naive_task<0>(A, Qs, Ps, lane, b, h, qrow0, isc);
    }
}
typedef float f32x16 __attribute__((ext_vector_type(16)));
typedef __bf16 bf16x2_t __attribute__((ext_vector_type(2)));
__device__ __forceinline__ unsigned cvtpk_c(float lo, float hi) { f32x2 v = {lo, hi}; return __builtin_bit_cast(unsigned, __builtin_convertvector(v, bf16x2_t)); }
template <int DQK> __device__ __forceinline__ int k_off(int r, int c) { return r * (DQK * 2) + 16 * (DQK == 128 ? (c ^ (r & 15)) : (c ^ ((r >> 1) & 7))); }
__device__ __forceinline__ int v_off(int r, int c) { return r * 128 + 16 * (c ^ ((r >> 1) & 7)); }
__device__ __forceinline__ int swap23(int k) { return (k & ~12) | ((k & 4) << 1) | ((k & 8) >> 1); }
constexpr int ATT_KB0 = 0, ATT_KB1 = 24576, ATT_VB0 = 49152, ATT_VB1 = 65536, ATT_RPB = 81920, ATT_LDS_END = 81920 + 2048;
constexpr size_t WS_DTMP = WS_U;
static_assert((size_t)2 * M * 640 * 4 <= (size_t)M * FF * 2, "DTMP fits in U");

struct AUnit { int type, b, h, pass, qrow0, isctx, g; };

template <int TYPE>
__device__ __forceinline__ void attn_mfma_unit(const AttnCtx& A, unsigned char* ws, LAS unsigned char* lds, int tid, const AUnit& u) {
    constexpr int DQK = TYPE == 1 ? 192 : (TYPE == 0 ? 128 : 64);
    constexpr int NKK = DQK / 16, NKC = DQK / 8, KPT = NKC / 8;
    const int w = __builtin_amdgcn_readfirstlane(tid >> 6), lane = tid & 63, q_ = lane & 31, h2_ = lane >> 5;
    const bf16_t* Qg; const bf16_t* Kg; const bf16_t* VTg; int ld;
    if (TYPE == 0) { Qg = A.naq + u.h * 128; Kg = A.nak + u.h * 128; ld = 768; VTg = A.vtin + (size_t)(u.h * 128) * M; }
    else if (TYPE == 1) { Qg = A.mq + u.h * 192; Kg = A.mk + u.h * 192; ld = 960; VTg = A.vtm + (size_t)(u.h * 128) * M; }
    else { Qg = A.dq + u.h * 128 + 64 * u.pass; Kg = A.dk + u.h * 128 + 64 * u.pass; ld = 640; VTg = A.vtin + (size_t)(768 + u.h * 128) * M; }
    const int qrow = u.qrow0 + 32 * w + q_;
    bf16x8 qf[NKK];
#pragma unroll
    for (int kk = 0; kk < NKK; ++kk) qf[kk] = *(const bf16x8*)(Qg + (size_t)qrow * ld + 16 * kk + 8 * h2_);
    int lo = 0, nlat = u.isctx ? 0 : 64, qr = 0, qc = 0, r0w = 0, c0 = 0;
    if (TYPE == 0 && !u.isctx) {
        int a = 4 * u.g - 4; lo = a < 0 ? 0 : (a > 56 ? 56 : a); int hb = 4 * u.g + 3 - 4; hb = hb < 0 ? 0 : (hb > 56 ? 56 : hb); nlat = hb + 8 - lo;
        qr = 4 * u.g + (w >> 1); qc = 32 * (w & 1) + q_; int t = qr - 4; r0w = t < 0 ? 0 : (t > 56 ? 56 : t); t = qc - 8; c0 = t < 0 ? 0 : (t > 48 ? 48 : t);
        LAS float* rp = (LAS float*)(lds + ATT_RPB);
        if (tid < 465) rp[tid] = A.rpb[u.h * 465 + tid] * LOG2E;
    }
    const int nt = 4 + nlat;
    int kgo[KPT], klo[KPT], vgo[2], vlo[2];
#pragma unroll
    for (int i = 0; i < KPT; ++i) { const int ci = tid + 512 * i, row = ci / NKC, c = ci % NKC; kgo[i] = row * ld + 8 * c; klo[i] = k_off<DQK>(swap23(row), c); }
#pragma unroll
    for (int i = 0; i < 2; ++i) { const int ci = tid + 512 * i, ch = ci >> 3, c = ci & 7; vgo[i] = ch * M + 8 * c; vlo[i] = v_off(ch, c); }
    u32x4 kst[KPT], vst[2];
#define ATT_TOK0(ti) ((ti) < 4 ? ML + u.b * CTXL + 64 * (ti) : (TYPE == 0 ? u.b * SEQ + 64 * (lo + (ti) - 4) : u.b * SEQ + 64 * ((ti) - 4)))
#define ATT_LOAD(ti) do { const int _t0 = ATT_TOK0(ti); const bf16_t* _kb = Kg + (size_t)_t0 * ld; const bf16_t* _vb = VTg + _t0; \
        _Pragma("unroll") for (int _i = 0; _i < KPT; ++_i) kst[_i] = *(const u32x4*)(_kb + kgo[_i]); \
        _Pragma("unroll") for (int _i = 0; _i < 2; ++_i) vst[_i] = *(const u32x4*)(_vb + vgo[_i]); } while (0)
#define ATT_WRITE(buf) do { LAS unsigned char* _k = lds + ((buf) ? ATT_KB1 : ATT_KB0); LAS unsigned char* _v = lds + ((buf) ? ATT_VB1 : ATT_VB0); \
        _Pragma("unroll") for (int _i = 0; _i < KPT; ++_i) *(LAS u32x4*)(_k + klo[_i]) = kst[_i]; \
        _Pragma("unroll") for (int _i = 0; _i < 2; ++_i) *(LAS u32x4*)(_v + vlo[_i]) = vst[_i]; } while (0)
    f32x16 o[4];
#pragma unroll
    for (int d0 = 0; d0 < 4; ++d0)
#pragma unroll
        for (int r = 0; r < 16; ++r) o[d0][r] = 0.f;
    float mrun = -1e30f, lrun = 0.f;
    ATT_LOAD(0); ATT_WRITE(0);
    __syncthreads();
    for (int ti = 0; ti < nt; ++ti) {
        const int buf = ti & 1;
        if (ti + 1 < nt) ATT_LOAD(ti + 1);
        bool active = true; int kr = 0;
        if (TYPE == 0 && ti >= 4) { kr = lo + ti - 4; active = (kr >= r0w) && (kr < r0w + 8); }
        if (active) {
            const int q = opaque_v(q_), h2 = opaque_v(h2_);
            const LAS unsigned char* kb = lds + (buf ? ATT_KB1 : ATT_KB0); const LAS unsigned char* vb = lds + (buf ? ATT_VB1 : ATT_VB0);
            f32x16 s0, s1;
#pragma unroll
            for (int r = 0; r < 16; ++r) { s0[r] = 0.f; s1[r] = 0.f; }
#pragma unroll
            for (int kk = 0; kk < NKK; ++kk) {
                const bf16x8 a0 = *(const LAS bf16x8*)(kb + k_off<DQK>(q, 2 * kk + h2));
                const bf16x8 a1 = *(const LAS bf16x8*)(kb + k_off<DQK>(32 + q, 2 * kk + h2));
                s0 = __builtin_amdgcn_mfma_f32_32x32x16_bf16(a0, qf[kk], s0, 0, 0, 0);
                s1 = __builtin_amdgcn_mfma_f32_32x32x16_bf16(a1, qf[kk], s1, 0, 0, 0);
            }
            if (TYPE == 0 && ti >= 4) {
                const LAS float* rp = (const LAS float*)(lds + ATT_RPB) + (kr - qr + 7) * 31 + 15;
#pragma unroll
                for (int r = 0; r < 16; ++r) {
                    const int k0c = 16 * (r >> 3) + 8 * h2 + 4 * ((r >> 2) & 1) + (r & 3), k1c = 32 + k0c;
                    const bool ok0 = (k0c >= c0) && (k0c < c0 + 16), ok1 = (k1c >= c0) && (k1c < c0 + 16);
                    int i0 = k0c - qc; i0 = i0 < -15 ? -15 : (i0 > 15 ? 15 : i0); int i1 = k1c - qc; i1 = i1 < -15 ? -15 : (i1 > 15 ? 15 : i1);
                    const float b0 = rp[i0], b1 = rp[i1];
                    s0[r] = ok0 ? s0[r] + b0 : -1e30f; s1[r] = ok1 ? s1[r] + b1 : -1e30f;
                }
            }
            float tm = s0[0];
#pragma unroll
            for (int r = 1; r < 16; ++r) tm = fmaxf(tm, s0[r]);
#pragma unroll
            for (int r = 0; r < 16; ++r) tm = fmaxf(tm, s1[r]);
            tm = half_max(tm);
            const float mn = fmaxf(mrun, tm), alpha = fast_exp2(mrun - mn);
            float ps = 0.f;
#pragma unroll
            for (int r = 0; r < 16; ++r) { s0[r] = fast_exp2(s0[r] - mn); s1[r] = fast_exp2(s1[r] - mn); ps += s0[r] + s1[r]; }
            ps = half_sum(ps);
            lrun = lrun * alpha + ps; mrun = mn;
#pragma unroll
            for (int d0 = 0; d0 < 4; ++d0)
#pragma unroll
                for (int r = 0; r < 16; ++r) o[d0][r] *= alpha;
            bf16x8 pf[4];
#pragma unroll
            for (int s = 0; s < 2; ++s) {
                u32x4 t0, t1;
                t0.x = cvtpk_c(s0[8 * s + 0], s0[8 * s + 1]); t0.y = cvtpk_c(s0[8 * s + 2], s0[8 * s + 3]); t0.z = cvtpk_c(s0[8 * s + 4], s0[8 * s + 5]); t0.w = cvtpk_c(s0[8 * s + 6], s0[8 * s + 7]);
                t1.x = cvtpk_c(s1[8 * s + 0], s1[8 * s + 1]); t1.y = cvtpk_c(s1[8 * s + 2], s1[8 * s + 3]); t1.z = cvtpk_c(s1[8 * s + 4], s1[8 * s + 5]); t1.w = cvtpk_c(s1[8 * s + 6], s1[8 * s + 7]);
                pf[s] = __builtin_bit_cast(bf16x8, t0); pf[2 + s] = __builtin_bit_cast(bf16x8, t1);
            }
#pragma unroll
            for (int d0 = 0; d0 < 4; ++d0)
#pragma unroll
                for (int ks = 0; ks < 4; ++ks) {
                    const bf16x8 av = *(const LAS bf16x8*)(vb + v_off(32 * d0 + q, 2 * ks + h2));
                    o[d0] = __builtin_amdgcn_mfma_f32_32x32x16_bf16(av, pf[ks], o[d0], 0, 0, 0);
                }
        }
        if (ti + 1 < nt) ATT_WRITE(buf ^ 1);
        __syncthreads();
    }
#undef ATT_TOK0
#undef ATT_LOAD
#undef ATT_WRITE
    const int h2 = h2_;
    const float il = 1.0f / lrun;
    if (TYPE == 2) {
        float* dst = (float*)(ws + WS_DTMP) + ((size_t)u.pass * M + qrow) * 640 + u.h * 128 + 4 * h2;
#pragma unroll
        for (int d0 = 0; d0 < 4; ++d0)
#pragma unroll
            for (int i = 0; i < 4; ++i) { f32x4 v = {o[d0][4 * i] * il, o[d0][4 * i + 1] * il, o[d0][4 * i + 2] * il, o[d0][4 * i + 3] * il}; *(f32x4*)(dst + 32 * d0 + 8 * i) = v; }
    } else {
        bf16_t* dst = A.omix + (size_t)qrow * D + (TYPE == 0 ? 0 : 768) + u.h * 128 + 4 * h2;
#pragma unroll
        for (int d0 = 0; d0 < 4; ++d0)
#pragma unroll
            for (int i = 0; i < 4; ++i) { u32x2 v; v.x = cvtpk_c(o[d0][4 * i] * il, o[d0][4 * i + 1] * il); v.y = cvtpk_c(o[d0][4 * i + 2] * il, o[d0][4 * i + 3] * il); *(u32x2*)(dst + 32 * d0 + 8 * i) = v; }
    }
}

#ifndef ATTN_PRIO
#define ATTN_PRIO 1
#endif
#ifndef ATTN_ALLLATE
#define ATTN_ALLLATE 1
#endif
#ifndef ATTN_PIPE_MASK
#define ATTN_PIPE_MASK 0
#endif
constexpr float ATT_THR = 8.0f;
constexpr int A2_RPB = 122880;

template <int TYPE>
__device__ __forceinline__ void attn_mfma_unit2(const AttnCtx& A, unsigned char* ws, LAS unsigned char* lds, int tid, const AUnit& u) {
    constexpr int DQK = TYPE == 1 ? 192 : (TYPE == 0 ? 128 : 64);
    constexpr int NKK = DQK / 16, NKC = DQK / 8, PITCH = DQK * 2, KB = 64 * PITCH;
    constexpr int NIK = KB / 8192, NIW = NIK + 2;
    constexpr int NKB = DQK == 128 ? 8 : 4;
    constexpr int STG = KB + 16384;
    const int w = __builtin_amdgcn_readfirstlane(tid >> 6), lane = tid & 63, q = lane & 31, h2 = lane >> 5;
    const bf16_t* Qg; const bf16_t* Kg; const bf16_t* VTg; int ld;
    if (TYPE == 0) { Qg = A.naq + u.h * 128; Kg = A.nak + u.h * 128; ld = 768; VTg = A.vtin + (size_t)(u.h * 128) * M; }
    else if (TYPE == 1) { Qg = A.mq + u.h * 192; Kg = A.mk + u.h * 192; ld = 960; VTg = A.vtm + (size_t)(u.h * 128) * M; }
    else { Qg = A.dq + u.h * 128 + 64 * u.pass; Kg = A.dk + u.h * 128 + 64 * u.pass; ld = 640; VTg = A.vtin + (size_t)(768 + u.h * 128) * M; }
#if ATTN_PRIO
    if (w < 4) __builtin_amdgcn_s_setprio(2); else __builtin_amdgcn_s_setprio(0);
#endif
    const int qrow = u.qrow0 + 32 * w + q;
    bf16x8 qf[NKK];
#pragma unroll
    for (int kk = 0; kk < NKK; ++kk) qf[kk] = *(const bf16x8*)(Qg + (size_t)qrow * ld + 16 * kk + 8 * h2);
    int lo = 0, nlat = u.isctx ? 0 : 64, qr = 0, qc = 0, r0w = 0, c0 = 0;
    if (TYPE == 0 && !u.isctx) {
        int a = 4 * u.g - 4; lo = a < 0 ? 0 : (a > 56 ? 56 : a); int hb = 4 * u.g + 3 - 4; hb = hb < 0 ? 0 : (hb > 56 ? 56 : hb); nlat = hb + 8 - lo;
        qr = 4 * u.g + (w >> 1); qc = 32 * (w & 1) + q; int t = qr - 4; r0w = t < 0 ? 0 : (t > 56 ? 56 : t); t = qc - 8; c0 = t < 0 ? 0 : (t > 48 ? 48 : t);
        LAS float* rp = (LAS float*)(lds + A2_RPB);
        if (tid < 465) rp[tid] = A.rpb[u.h * 465 + tid] * LOG2E;
    }
    const int nt = 4 + nlat;
    unsigned goff[NIW];
#pragma unroll
    for (int m = 0; m < NIW; ++m) {
        if (m < NIK) { const int p = 64 * (w + 8 * m) + lane, row = p / NKC, slot = p % NKC; const int c = DQK == 128 ? (slot ^ (row & 15)) : (slot ^ ((row >> 1) & 7)); goff[m] = (unsigned)(swap23(row) * ld + 8 * c); }
        else { const int p = 64 * (w + 8 * (m - NIK)) + lane, ch = p >> 3, slot = p & 7; const int c = slot ^ ((ch >> 1) & 7); goff[m] = (unsigned)(ch * M + 8 * c); }
    }
    const unsigned ldsw = (unsigned)w * 1024u;
    unsigned kbase[NKB], vbase[4];
#pragma unroll
    for (int i = 0; i < NKB; ++i) kbase[i] = (unsigned)(q * PITCH + 16 * (DQK == 128 ? ((2 * i + h2) ^ (q & 15)) : ((2 * i + h2) ^ ((q >> 1) & 7))));
#pragma unroll
    for (int i = 0; i < 4; ++i) vbase[i] = (unsigned)(KB + q * 128 + 16 * ((2 * i + h2) ^ ((q >> 1) & 7)));
#define A2_TOK0(ti) ((ti) < 4 ? ML + u.b * CTXL + 64 * (ti) : (TYPE == 0 ? u.b * SEQ + 64 * (lo + (ti) - 4) : u.b * SEQ + 64 * ((ti) - 4)))
#define A2_DMA(ti, SOFF) do { const int _t0 = A2_TOK0(ti); const bf16_t* _kb = Kg + (size_t)_t0 * ld; const bf16_t* _vb = VTg + _t0; \
        _Pragma("unroll") for (int _m = 0; _m < NIK; ++_m) __builtin_amdgcn_global_load_lds((const unsigned*)(_kb + goff[_m]), (LAS unsigned*)(lds + (SOFF) + ldsw + _m * 8192), 16, 0, 0); \
        _Pragma("unroll") for (int _m = 0; _m < 2; ++_m) __builtin_amdgcn_global_load_lds((const unsigned*)(_vb + goff[NIK + _m]), (LAS unsigned*)(lds + (SOFF) + KB + ldsw + _m * 8192), 16, 0, 0); } while (0)
#define A2_WAITN(n) asm volatile("s_waitcnt vmcnt(%0)" :: "n"(n) : "memory")
#define A2_BAR() do { __builtin_amdgcn_s_barrier(); asm volatile("" ::: "memory"); } while (0)
#define A2_KRD(kk, blk, KBUF) (*(const LAS bf16x8*)(lds + (DQK == 128 ? kc[kk] : kc[(kk) & 3]) + ((blk) * 32 * PITCH + (DQK == 128 ? 0 : 128 * ((kk) >> 2)))))
#define A2_VRD(d0, ks, VBUF) (*(const LAS bf16x8*)(lds + vc[ks] + (4096 * (d0))))
    f32x16 o[4];
#pragma unroll
    for (int d0 = 0; d0 < 4; ++d0)
#pragma unroll
        for (int r = 0; r < 16; ++r) o[d0][r] = 0.f;
    float mref = 0.f, lrun = 0.f; bool first = true;
    constexpr bool PIPE = (ATTN_PIPE_MASK >> TYPE) & 1;
    f32x16 sA0, sA1, sB0, sB1; bool actA = true, actB = true; bf16x8 pf[4], fa[4], fb[4];
#define A2_ACTIVE(ti) (!(TYPE == 0 && (ti) >= 4) || ((lo + (ti) - 4 >= r0w) && (lo + (ti) - 4 < r0w + 8)))
#define A2_LDK4(dst, p, KBUF) do { dst[0] = A2_KRD(2 * (p), 0, KBUF); dst[1] = A2_KRD(2 * (p), 1, KBUF); dst[2] = A2_KRD(2 * (p) + 1, 0, KBUF); dst[3] = A2_KRD(2 * (p) + 1, 1, KBUF); } while (0)
#define A2_MMK4(src, p, S0, S1) do { S0 = __builtin_amdgcn_mfma_f32_32x32x16_bf16(src[0], qf[2 * (p)], S0, 0, 0, 0); S1 = __builtin_amdgcn_mfma_f32_32x32x16_bf16(src[1], qf[2 * (p)], S1, 0, 0, 0); \
        S0 = __builtin_amdgcn_mfma_f32_32x32x16_bf16(src[2], qf[2 * (p) + 1], S0, 0, 0, 0); S1 = __builtin_amdgcn_mfma_f32_32x32x16_bf16(src[3], qf[2 * (p) + 1], S1, 0, 0, 0); } while (0)
#define A2_SCHED() __builtin_amdgcn_sched_barrier(0)
#define A2_QK(S0, S1, ti, KBUF) do { \
        { const float _nm = -mref;        \
        _Pragma("unroll") for (int _r = 0; _r < 16; ++_r) { S0[_r] = _nm; S1[_r] = _nm; } } \
        if constexpr (TYPE == 0) {        \
            _Pragma("unroll") for (int _p = 0; _p < NKK / 2; ++_p) { A2_LDK4(fa, _p, KBUF); A2_MMK4(fa, _p, S0, S1); } \
        } else { \
        A2_LDK4(fa, 0, KBUF); \
        _Pragma("unroll") for (int _p = 0; _p < NKK / 2; _p += 2) { \
            A2_LDK4(fb, _p + 1, KBUF); A2_SCHED(); A2_MMK4(fa, _p, S0, S1); A2_SCHED(); \
            if (_p + 2 < NKK / 2) A2_LDK4(fa, _p + 2, KBUF); A2_SCHED(); A2_MMK4(fb, _p + 1, S0, S1); A2_SCHED(); } } \
        if (TYPE == 0 && (ti) >= 4) { const int _kr = lo + (ti) - 4; \
            const int _lb = opaque_v(c0 - 8 * h2);                        \
            const LAS float* _rp = (const LAS float*)(lds + A2_RPB) + ((_kr - qr + 7) * 31 + 15) + opaque_v(8 * h2 - qc); \
            _Pragma("unroll") for (int _r = 0; _r < 16; ++_r) { const int _k0 = 16 * (_r >> 3) + 4 * ((_r >> 2) & 1) + (_r & 3), _k1 = 32 + _k0; \
                const bool _ok0 = (unsigned)(_k0 - _lb) < 16u, _ok1 = (unsigned)(_k1 - _lb) < 16u; \
                S0[_r] = _ok0 ? S0[_r] + _rp[_k0] : -1e30f; S1[_r] = _ok1 ? S1[_r] + _rp[_k1] : -1e30f; } } } while (0)
#define A2_PSM(S0, S1) do { \
        float _tm = S0[0]; \
        _Pragma("unroll") for (int _r = 1; _r < 16; ++_r) _tm = fmaxf(_tm, S0[_r]); \
        _Pragma("unroll") for (int _r = 0; _r < 16; ++_r) _tm = fmaxf(_tm, S1[_r]); \
        _tm = half_max(_tm); \
        if (first || !__all(_tm <= ATT_THR)) { \
            const float _sh = first ? _tm : fmaxf(_tm, 0.f), _al = first ? 0.f : fast_exp2(-_sh); \
            mref += _sh; lrun *= _al; first = false; \
            _Pragma("unroll") for (int _d = 0; _d < 4; ++_d) _Pragma("unroll") for (int _r = 0; _r < 16; ++_r) o[_d][_r] *= _al; \
            _Pragma("unroll") for (int _r = 0; _r < 16; ++_r) { S0[_r] -= _sh; S1[_r] -= _sh; } } } while (0)
#define A2_LDV4(dst, d0, VBUF) do { dst[0] = A2_VRD(d0, 0, VBUF); dst[1] = A2_VRD(d0, 1, VBUF); dst[2] = A2_VRD(d0, 2, VBUF); dst[3] = A2_VRD(d0, 3, VBUF); } while (0)
#define A2_MMV4(src, d0) do { _Pragma("unroll") for (int _ks = 0; _ks < 4; ++_ks) o[d0] = __builtin_amdgcn_mfma_f32_32x32x16_bf16(src[_ks], pf[_ks], o[d0], 0, 0, 0); } while (0)
#define A2_LDVK(dst, ks) do { dst[0] = A2_VRD(0, ks, 0); dst[1] = A2_VRD(1, ks, 0); dst[2] = A2_VRD(2, ks, 0); dst[3] = A2_VRD(3, ks, 0); } while (0)
#define A2_MMVK(src, ks) do { _Pragma("unroll") for (int _d = 0; _d < 4; ++_d) o[_d] = __builtin_amdgcn_mfma_f32_32x32x16_bf16(src[_d], pf[ks], o[_d], 0, 0, 0); } while (0)
#define A2_EXP8(S, off, ks) do { \
        _Pragma("unroll") for (int _r = 0; _r < 8; ++_r) { S[(off) + _r] = fast_exp2(S[(off) + _r]); } \
        _ps += ((S[(off) + 0] + S[(off) + 1]) + (S[(off) + 2] + S[(off) + 3])) + ((S[(off) + 4] + S[(off) + 5]) + (S[(off) + 6] + S[(off) + 7])); \
        u32x4 _t; _t.x = cvtpk_c(S[(off) + 0], S[(off) + 1]); _t.y = cvtpk_c(S[(off) + 2], S[(off) + 3]); _t.z = cvtpk_c(S[(off) + 4], S[(off) + 5]); _t.w = cvtpk_c(S[(off) + 6], S[(off) + 7]); \
        pf[ks] = __builtin_bit_cast(bf16x8, _t); } while (0)
#define A2_FSM_PV(S0, S1, VBUF) do { float _ps = 0.f; \
        A2_LDVK(fa, 0); A2_SCHED(); \
        A2_EXP8(S0, 0, 0); A2_LDVK(fb, 1); A2_SCHED(); A2_MMVK(fa, 0); A2_SCHED(); \
        A2_EXP8(S0, 8, 1); A2_LDVK(fa, 2); A2_SCHED(); A2_MMVK(fb, 1); A2_SCHED(); \
        A2_EXP8(S1, 0, 2); A2_LDVK(fb, 3); A2_SCHED(); A2_MMVK(fa, 2); A2_SCHED(); \
        A2_EXP8(S1, 8, 3); A2_SCHED(); A2_MMVK(fb, 3); A2_SCHED(); \
        lrun += half_sum(_ps); } while (0)

    (void)PIPE; (void)actA; (void)actB; (void)sB0; (void)sB1;
    A2_DMA(0, 0);
    asm volatile("s_waitcnt lgkmcnt(0)" ::: "memory");
    A2_WAITN(0); A2_BAR();
#define A2_SETKC(SOFF) _Pragma("unroll") for (int _i = 0; _i < NKB; ++_i) kc[_i] = kbase[_i] + (unsigned)(SOFF)
#define A2_SETVC(SOFF) _Pragma("unroll") for (int _i = 0; _i < 4; ++_i) vc[_i] = vbase[_i] + (unsigned)(SOFF)
    unsigned kc[NKB], vc[4];
    int scur = 0, snxt = STG, sprv = 0;
    if (w < 4 && !ATTN_ALLLATE) {
        for (int ti = 0; ti < nt; ++ti) {
            if (ti + 1 < nt) A2_DMA(ti + 1, snxt);
            if (A2_ACTIVE(ti)) { A2_SETKC(scur); A2_SETVC(scur); A2_QK(sA0, sA1, ti, 0); A2_PSM(sA0, sA1); A2_FSM_PV(sA0, sA1, 0); }
            A2_WAITN(0); A2_BAR();
            sprv = scur; scur = snxt; snxt = snxt == 2 * STG ? 0 : snxt + STG;
        }
    } else {
        bool actP = false;
        for (int ti = 0; ti < nt; ++ti) {
            if (ti + 1 < nt) A2_DMA(ti + 1, snxt);
            if (actP) { A2_SETVC(sprv); A2_FSM_PV(sA0, sA1, 0); }
            actP = A2_ACTIVE(ti);
            if (actP) { A2_SETKC(scur); A2_QK(sA0, sA1, ti, 0); A2_PSM(sA0, sA1); }
            A2_WAITN(0); A2_BAR();
            sprv = scur; scur = snxt; snxt = snxt == 2 * STG ? 0 : snxt + STG;
        }
        if (actP) { A2_SETVC(sprv); A2_FSM_PV(sA0, sA1, 0); }
    }
#undef A2_SETKC
#undef A2_SETVC
    asm volatile("" ::: "memory"); __builtin_amdgcn_s_barrier(); asm volatile("" ::: "memory");
#undef A2_TOK0
#undef A2_DMA
#undef A2_WAITN
#undef A2_BAR
#undef A2_KRD
#undef A2_VRD
#undef A2_ACTIVE
#undef A2_QK
#undef A2_LDK4
#undef A2_MMK4
#undef A2_LDV4
#undef A2_MMV4
#undef A2_SCHED
#undef A2_PSM
#undef A2_FSM_PV
#undef A2_LDVK
#undef A2_MMVK
#undef A2_EXP8
#if ATTN_PRIO
    __builtin_amdgcn_s_setprio(0);
#endif
    const float il = 1.0f / lrun;
    const int lane_e = lane_id(), q_e = lane_e & 31, h2_e = lane_e >> 5, qrow_e = u.qrow0 + 32 * w + q_e;
    if (TYPE == 2) {
        float* dst = (float*)(ws + WS_DTMP) + ((size_t)u.pass * M + qrow_e) * 640 + u.h * 128 + 4 * h2_e;
#pragma unroll
        for (int d0 = 0; d0 < 4; ++d0)
#pragma unroll
            for (int i = 0; i < 4; ++i) { f32x4 v = {o[d0][4 * i] * il, o[d0][4 * i + 1] * il, o[d0][4 * i + 2] * il, o[d0][4 * i + 3] * il}; *(f32x4*)(dst + 32 * d0 + 8 * i) = v; }
    } else {
        bf16_t* dst = A.omix + (size_t)qrow_e * D + (TYPE == 0 ? 0 : 768) + u.h * 128 + 4 * h2_e;
#pragma unroll
        for (int d0 = 0; d0 < 4; ++d0)
#pragma unroll
            for (int i = 0; i < 4; ++i) { u32x2 v; v.x = cvtpk_c(o[d0][4 * i] * il, o[d0][4 * i + 1] * il); v.y = cvtpk_c(o[d0][4 * i + 2] * il, o[d0][4 * i + 3] * il); *(u32x2*)(dst + 32 * d0 + 8 * i) = v; }
    }
}
#ifndef ATTN_V2
#define ATTN_V2 1
#endif
__device__ __forceinline__ bool attn_unit_decode(int x, int i, bool with_ctx, AUnit& u) {
    u.pass = 0; u.isctx = 0; u.g = 0;
    if (i < 20) { const int item = 5 * x + (i >> 2), pair = item >> 2, qb = 4 * (item & 3) + (i & 3); u.type = 1; u.b = pair / 5; u.h = pair % 5; u.qrow0 = u.b * SEQ + 256 * qb; return true; } i -= 20;
    if (i < 40) { const int item = 5 * x + (i >> 3), pair = item >> 2, qb = 4 * (item & 3) + ((i & 7) >> 1); u.type = 2; u.b = pair / 5; u.h = pair % 5; u.pass = i & 1; u.qrow0 = u.b * SEQ + 256 * qb; return true; } i -= 40;
    if (i < 24) { const int item = 6 * x + (i >> 2), pair = item >> 2, g = 4 * (item & 3) + (i & 3); u.type = 0; u.b = pair / 6; u.h = pair % 6; u.g = g; u.qrow0 = u.b * SEQ + 256 * g; return true; } i -= 24;
    if (!with_ctx) return false;
    int c = x + 8 * i; u.isctx = 1;
    if (c < 10) { u.type = 1; u.b = c / 5; u.h = c % 5; u.qrow0 = ML + u.b * CTXL; return true; } c -= 10;
    if (c < 20) { u.type = 2; u.b = c / 10; u.h = (c >> 1) % 5; u.pass = c & 1; u.qrow0 = ML + u.b * CTXL; return true; } c -= 20;
    if (c < 12) { u.type = 0; u.b = c / 6; u.h = c % 6; u.qrow0 = ML + u.b * CTXL; return true; }
    return false;
}
__device__ __forceinline__ void attn_mfma_phase(Frame& F, const AttnCtx& A, bool with_ctx, gu32* qheads, int type_mask = 7) {
    volatile LAS unsigned* slot = F.MISC;
    const int x0 = (int)(xb_xcc_id() & 7u);
    for (int k = 0; k < 8; ++k) {
        const int x = (x0 + k) & 7;
        if (k == 1) {
            const int t = tid_of(F.wave);
            if (t < 8) { const unsigned hv = __hip_atomic_load(qheads + 64 * t, RLX_AGENT); slot[32 + t] = ((int)hv < 84 + (with_ctx ? (t < 2 ? 6 : 5) : 0)) ? 1u : 0u; }
            __syncthreads();
        }
        if (k >= 1 && slot[32 + x] == 0u) continue;
        for (;;) {
            if (tid_of(F.wave) == 0) slot[0] = __hip_atomic_fetch_add(qheads + 64 * x, 1u, RLX_AGENT);
            __syncthreads();
            const int ui = (int)slot[0];
            AUnit u;
            const bool ok = attn_unit_decode(x, ui, with_ctx, u);
            if (ok && ((type_mask >> u.type) & 1)) {
#if ATTN_V2
                if (u.type == 1) attn_mfma_unit2<1>(A, F.ws, F.lds + RING_OFF, tid_of(F.wave), u);
                else if (u.type == 2) attn_mfma_unit2<2>(A, F.ws, F.lds + RING_OFF, tid_of(F.wave), u);
                else attn_mfma_unit2<0>(A, F.ws, F.lds + RING_OFF, tid_of(F.wave), u);
#else
                if (u.type == 1) attn_mfma_unit<1>(A, F.ws, F.lds + RING_OFF, tid_of(F.wave), u);
                else if (u.type == 2) attn_mfma_unit<2>(A, F.ws, F.lds + RING_OFF, tid_of(F.wave), u);
                else attn_mfma_unit<0>(A, F.ws, F.lds + RING_OFF, tid_of(F.wave), u);
#endif
            }
            __syncthreads();
            if (!ok) break;
        }
    }
}
__device__ __forceinline__ void diff_combine_phase(Frame& F, const AttnCtx& A, int nrows, bool zero_ctx_y) {
    const int gw = F.vcu * NWAVES + F.wave, NGW = F.G * NWAVES, lane = (tid_of(F.wave) & 63);
    const float* t1 = (const float*)(F.ws + WS_DTMP); const float* t2 = t1 + (size_t)M * 640;
    const float g0 = A.subln[2 * lane], g1 = A.subln[2 * lane + 1];
    if (zero_ctx_y) {
        unsigned long long* yz = (unsigned long long*)(F.ws + WS_Y + (size_t)ML * D * 2);
        const unsigned long long z = (unsigned long long)(unsigned)opaque_v(0);
        for (int i = gw * 64 + lane; i < MC * D * 2 / 8; i += NGW * 64) __hip_atomic_store(yz + i, z, __ATOMIC_RELAXED, __HIP_MEMORY_SCOPE_AGENT);
    }
    for (int row = gw; row < nrows; row += NGW) {
        const size_t off = (size_t)row * 640 + 2 * lane;
        f32x2 a[H_DF], b[H_DF];
#pragma unroll
        for (int h = 0; h < H_DF; ++h) { a[h] = *(const f32x2*)(t1 + off + h * 128); b[h] = *(const f32x2*)(t2 + off + h * 128); }
#pragma unroll
        for (int h = 0; h < H_DF; ++h) {
            const float r0 = a[h][0] - A.lam * b[h][0], r1 = a[h][1] - A.lam * b[h][1];
            const float ssq = wave_sum(r0 * r0 + r1 * r1); const float rr = (1.0f / sqrtf(ssq * (1.0f / 128.0f) + NORM_EPS)) * A.one_m_li;
            *(unsigned*)(A.omix + (size_t)row * D + 1408 + h * 128 + 2 * lane) = pk2(r0 * rr * g0, r1 * rr * g1);
        }
    }
}
#ifndef PROBE_PRO
#define PROBE_PRO 0
#endif
#ifndef PROBE_FFNIN
#define PROBE_FFNIN 0
#endif
#ifndef PROBE_ATTN
#define PROBE_ATTN 0
#endif
#ifndef PROBE_NULLEPI
#define PROBE_NULLEPI 0
#endif
#ifndef PROBE_FFNOUT
#define PROBE_FFNOUT 0
#endif
#ifndef PROBE_NORM
#define PROBE_NORM 0
#endif
#ifndef PROBE_INPROJ
#define PROBE_INPROJ 0
#endif
#ifndef PROBE_MLAUP
#define PROBE_MLAUP 0
#endif
#ifndef PROBE_MERGE
#define PROBE_MERGE 0
#endif
#ifndef PROBE_BAR
#define PROBE_BAR 0
#endif
#ifndef ATTN_NAIVE
#define ATTN_NAIVE 0
#endif
#ifndef WCV_CONV
#define WCV_CONV 8
#endif
#ifndef MK_SPLIT
#define MK_SPLIT 0
#endif
__global__ void __launch_bounds__(NTHREADS, 2) dit_fwd(Args args) {
    extern __shared__ __attribute__((aligned(16))) unsigned char lds[];
    Frame F;
    F.lds = (LAS unsigned char*)lds;
    F.MISC = (volatile LAS unsigned*)(F.lds + MISC_OFF);
    F.wave = __builtin_amdgcn_readfirstlane((int)threadIdx.x >> 6);
    F.G = gridDim.x; { const int bx = blockIdx.x; F.vcu = (F.G % 8 == 0) ? (bx % 8) * (F.G / 8) + bx / 8 : bx; }
    F.ws = args.ws; F.ctl = (gu32*)(args.ws + WS_CTL);
    for (int u = (int)threadIdx.x; u < (LDS_BYTES - LDSCTL_OFF) / 4; u += NTHREADS) ((LAS unsigned*)(F.lds + LDSCTL_OFF))[u] = 0u;
    __syncthreads();
    { LAS float* rc = (LAS float*)(F.lds + ROPE_LDS);
      for (int i = (int)threadIdx.x; i < 1024; i += NTHREADS) { const int pos = i >> 4, fi = i & 15; const float fr = powf(10000.0f, -(float)fi / 16.0f); const float ang = (float)pos * fr; rc[i] = cosf(ang); rc[1024 + i] = sinf(ang); } }
    XcdBarrier bar; bar.bar = (unsigned*)(F.ctl + CW_BAR); bar.x = 0; bar.st = nullptr; bar.wave = F.wave;
    if (!MK_SPLIT) bar = xcd_barrier_post((unsigned*)(F.ctl + CW_BAR), F.MISC + 8, F.wave);
    const int lo = args.ph_lo, hi = args.ph_hi; int ph = 0;
#define PH_BEGIN if (lo <= ph && ph < hi) {
#define PH_END   if (!MK_SPLIT) xcd_barrier(bar); } ++ph;

    float* mod = wsp<float>(F, WS_MOD);
    const int G = F.G, cid = (int)blockIdx.x;
    LAS unsigned char* ring = F.lds + RING_OFF;

    PH_BEGIN p0_prologue(F, args, true); PH_END
#if PROBE_PRO
    PH_BEGIN p0_prologue(F, args, false); PH_END
#endif

    for (int s = 0; s < 2 * DEPTH; ++s) {
        const int l = s >> 1, j = s & 1, li = s;
        const bool last = (l == DEPTH - 1);
        const float* modl = mod + (size_t)l * 3 * MODLD;
        const int nM_f = (j == 1 && last) ? 32 : 34;
        if (s == 0) { PH_BEGIN norm_mod_phase(F, args.in[I_NORMW] + (size_t)(l * 3) * D, modl, modl + D, 0, M, 0, args.in[I_X], args.in[I_CTX]); PH_END }
        else if (nM_f == 34) { PH_BEGIN { if (j == 0) ctx_norm_phase<11>(F, args.in[I_NORMW] + (size_t)(l * 3) * D, modl, modl + D); else ctx_norm_phase<8>(F, args.in[I_NORMW] + (size_t)(l * 3 + 2) * D, modl + 6 * D, modl + 7 * D); } PH_END }
        PH_BEGIN {
            pg8::Gemm g{wsp<bf16_t>(F, WS_H), wsp<bf16_t>(F, WS_WFI + (size_t)li * WFI_SZ)};
            pg8::SegSched S; S.init(0, nM_f, FF / 128, G, cid, 0, D / 64);
            pg8::EpiSwiGLU E{wsp<bf16_t>(F, WS_U)};
            { const int rem = (nM_f * (FF / 128)) % G; int cL = 0, cH = 0, cslot = 0, clo = 0, chi = 0;
              if (s == 0) { cslot = 2048; clo = wcv::I_FI; chi = wcv::I_FI + WCV_RES; }
              else if (s == 1) { cL = 1; cslot = 3584; clo = wcv::NH0 - WCV_RES; chi = wcv::NH0; }
              else if (s == 2) { cL = 1; cH = 1; cslot = 4096; clo = wcv::NH1 - wcv::I_FO - WCV_RES; chi = wcv::NH1 - wcv::I_FO; }
              if (chi > clo && (rem == 0 || cid >= rem)) { convert_fill<6>(F, args, cL, cH, F.ctl + CW_WCV + cslot, clo, chi); __syncthreads(); } }
            pg8::gemm_phase<pg8::EpiSwiGLU, pg8::SegSched, LDH, D>(ring, g, S, E, F.wave);
            if (s == 2 * DEPTH - 1) convert_fill(F, args, DEPTH - 1, 1, F.ctl + CW_WCV + 1024, wcv::NH1 - wcv::I_FO, wcv::NH1);
        } PH_END
#if PROBE_FFNIN
        PH_BEGIN {
            pg8::Gemm g{wsp<bf16_t>(F, WS_H), wsp<bf16_t>(F, WS_WFI + (size_t)li * WFI_SZ)};
            pg8::SegSched S; S.init(0, nM_f, FF / 128, G, cid, 0, PROBE_FFNIN);
#if PROBE_NULLEPI
            pg8::EpiNull E{wsp<float>(F, WS_YF)};
            pg8::gemm_phase<pg8::EpiNull, pg8::SegSched, LDH, D>(ring, g, S, E, F.wave);
#else
            pg8::EpiSwiGLU E{wsp<bf16_t>(F, WS_YF)};
            pg8::gemm_phase<pg8::EpiSwiGLU, pg8::SegSched, LDH, D>(ring, g, S, E, F.wave);
#endif
        } PH_END
#endif
        PH_BEGIN {
            pg8::Gemm g{wsp<bf16_t>(F, WS_U), wsp<bf16_t>(F, WS_WFO + (size_t)li * WFO_SZ)};
            pg8::ResidSched<11, 512> S; S.init(D / 256, G, cid, FF / 64, nM_f == 34);
            const bool fin = (j == 1 && last);
            const float* ng = fin ? args.in[I_FNORM] : (j == 0 ? args.in[I_NORMW] + (size_t)(l * 3 + 1) * D : args.in[I_NORMW] + (size_t)((l + 1) * 3) * D);
            const float* nsh = j == 0 ? modl + 3 * D : (fin ? modl : mod + (size_t)(l + 1) * 3 * MODLD);
            pg8::EpiResidNorm E{F.ws, modl + (j ? 8 : 2) * D, ng, nsh, fin ? args.out : nullptr, s == 0 ? args.in[I_X] : nullptr, 0.5f, 3 * l + (j ? 2 : 0)};
            pg8::gemm_phase<pg8::EpiResidNorm, pg8::ResidSched<11, 512>, FF, FF>(ring, g, S, E, F.wave);
        } PH_END
        if (j == 0) {
            const int nM_o = last ? 32 : 34;
            pg8::ProjCtx pc{F.ws, l, 0, F.lds};
            PH_BEGIN ctx_norm_phase<11>(F, args.in[I_NORMW] + (size_t)(l * 3 + 1) * D, modl + 3 * D, modl + 4 * D); PH_END
            int nmove; { const int tot = (last ? 32 : 34) * 41 + (last ? 18 : 0) + 204, ex = tot % G; nmove = (tot > G && ex > 0 && ex <= 204 && 3 * ex <= G) ? ex : 0; }
            PH_BEGIN {
                pg8::InProjSched S1; S1.init(last, G, cid); const int U1 = S1.total();
                { pg8::Gemm g{wsp<bf16_t>(F, WS_H), wsp<bf16_t>(F, WS_WIN + (size_t)l * WIN_SZ)};
                  pg8::EpiProj<0> E{pc};
                  pg8::gemm_phase<pg8::EpiProj<0>, pg8::InProjSched, LDH, D>(ring, g, S1, E, F.wave); }
                { pg8::Gemm g{wsp<bf16_t>(F, WS_WVT + (size_t)l * WVT_SZ), wsp<bf16_t>(F, WS_H)};
                  pg8::SegSched S; S.init(U1, 6, 34, G, cid, 0, D / 64); S.lim = 204 - nmove;
                  pg8::EpiVT<0> E{wsp<bf16_t>(F, WS_VTIN), nullptr};
                  pg8::gemm_phase<pg8::EpiVT<0>, pg8::SegSched, D, LDH>(ring, g, S, E, F.wave); }
            } PH_END
#if PROBE_INPROJ
            PH_BEGIN {
                pg8::InProjSched S1; S1.init(last, G, cid); const int U1 = S1.total();
                { pg8::Gemm g{wsp<bf16_t>(F, WS_H), wsp<bf16_t>(F, WS_WIN + (size_t)l * WIN_SZ)};
                  pg8::ProjCtx pcp{F.ws, l, 1, F.lds}; pg8::EpiProj<0> E{pcp};
                  pg8::gemm_phase<pg8::EpiProj<0>, pg8::InProjSched, LDH, D>(ring, g, S1, E, F.wave); }
                { pg8::Gemm g{wsp<bf16_t>(F, WS_WVT + (size_t)l * WVT_SZ), wsp<bf16_t>(F, WS_H)};
                  pg8::SegSched S; S.init(U1, 6, 34, G, cid, 0, D / 64);
                  pg8::EpiVT<0> E{wsp<bf16_t>(F, WS_VTIN), nullptr};
                  pg8::gemm_phase<pg8::EpiVT<0>, pg8::SegSched, D, LDH>(ring, g, S, E, F.wave); }
            } PH_END
#endif
            PH_BEGIN {
                constexpr int U1 = 34 * 4, U2 = U1 + 34 * 3;
                const int GS = G - nmove; const bool small = cid < GS;
                { pg8::Gemm g{wsp<bf16_t>(F, WS_WVT + (size_t)l * WVT_SZ), wsp<bf16_t>(F, WS_H)};
                  pg8::SegSched S; S.init(cid - (204 - nmove + cid - GS), 6, 34, G, cid, 0, D / 64); if (small) S.lim = 0;
                  pg8::EpiVT<0> E{wsp<bf16_t>(F, WS_VTIN), nullptr};
                  pg8::gemm_phase<pg8::EpiVT<0>, pg8::SegSched, D, LDH>(ring, g, S, E, F.wave); }
                { pg8::Gemm g{wsp<bf16_t>(F, WS_CQ), wsp<bf16_t>(F, WS_WUQ + (size_t)l * WUQ_SZ)};
                  pg8::SegSched S; S.init(0, 34, 4, GS, cid, 0, 12); if (!small) S.lim = 0;
                  pg8::EpiProj<1> E{pc};
                  pg8::gemm_phase<pg8::EpiProj<1>, pg8::SegSched, 768, 768>(ring, g, S, E, F.wave); }
                { pg8::Gemm g{wsp<bf16_t>(F, WS_CKV), wsp<bf16_t>(F, WS_WUK + (size_t)l * WUK_SZ)};
                  pg8::SegSched S; S.init(U1, 34, 3, GS, cid, 0, 8); if (!small) S.lim = 0;
                  pg8::EpiProj<2> E{pc};
                  pg8::gemm_phase<pg8::EpiProj<2>, pg8::SegSched, 512, 512>(ring, g, S, E, F.wave); }
                { pg8::Gemm g{wsp<bf16_t>(F, WS_WUV + (size_t)l * WUK_SZ), wsp<bf16_t>(F, WS_CKV)};
                  pg8::SegSched S; S.init(nmove == 0 ? U1 : U2, 3, 34, GS, cid, 0, 8); if (!small) S.lim = 0;
                  pg8::EpiVT<1> E{wsp<bf16_t>(F, WS_VTM), wsp<float>(F, WS_SSQ) + (size_t)(2 * l + 1) * M};
                  pg8::gemm_phase<pg8::EpiVT<1>, pg8::SegSched, 512, 512>(ring, g, S, E, F.wave); }
            } PH_END
#if PROBE_MLAUP
            PH_BEGIN {
                constexpr int U1 = 34 * 4, U2 = U1 + 34 * 3;
                { pg8::Gemm g{wsp<bf16_t>(F, WS_CQ), wsp<bf16_t>(F, WS_WUQ + (size_t)l * WUQ_SZ)};
                  pg8::SegSched S; S.init(0, 34, 4, G, cid, 0, 12);
                  pg8::EpiProj<1> E{pc};
                  pg8::gemm_phase<pg8::EpiProj<1>, pg8::SegSched, 768, 768>(ring, g, S, E, F.wave); }
                { pg8::Gemm g{wsp<bf16_t>(F, WS_CKV), wsp<bf16_t>(F, WS_WUK + (size_t)l * WUK_SZ)};
                  pg8::SegSched S; S.init(U1, 34, 3, G, cid, 0, 8);
                  pg8::EpiProj<2> E{pc};
                  pg8::gemm_phase<pg8::EpiProj<2>, pg8::SegSched, 512, 512>(ring, g, S, E, F.wave); }
                { pg8::Gemm g{wsp<bf16_t>(F, WS_WUV + (size_t)l * WUK_SZ), wsp<bf16_t>(F, WS_CKV)};
                  pg8::SegSched S; S.init(U2, 3, 34, G, cid, 0, 8);
                  pg8::EpiVT<1> E{wsp<bf16_t>(F, WS_VTM), wsp<float>(F, WS_SSQ) + (size_t)(2 * l + 1) * M};
                  pg8::gemm_phase<pg8::EpiVT<1>, pg8::SegSched, 512, 512>(ring, g, S, E, F.wave); }
            } PH_END
#endif
#define MAKE_ACTX() \
                const float lambda_init = (l == 0) ? 0.2f : 0.35550907f;        \
                const float* dl = args.in[I_DLAM] + (size_t)l * 256; \
                const int ln = (tid_of(F.wave) & 63); \
                const float s01 = wave_sum(dl[ln] * dl[64 + ln]), s23 = wave_sum(dl[128 + ln] * dl[192 + ln]); \
                AttnCtx A{wsp<bf16_t>(F, WS_NAQ), wsp<bf16_t>(F, WS_NAK), wsp<bf16_t>(F, WS_DQ), wsp<bf16_t>(F, WS_DK), wsp<bf16_t>(F, WS_MQ), wsp<bf16_t>(F, WS_MK), \
                          wsp<bf16_t>(F, WS_VTIN), wsp<bf16_t>(F, WS_VTM), wsp<bf16_t>(F, WS_OMIX), args.in[I_RPB] + (size_t)l * 6 * 15 * 31, args.in[I_SUBLN] + (size_t)l * 128, \
                          expf(s01) - expf(s23) + lambda_init, 1.0f - lambda_init};
#if ATTN_NAIVE
            PH_BEGIN { MAKE_ACTX() attn_naive_phase(F, A, !last); } PH_END
#else
            PH_BEGIN { MAKE_ACTX()
                       for (int it = ((cid >> 3) < WCV_CONV) ? 0 : 1; it < 2; ++it) {
                           if (it == 1) attn_mfma_phase(F, A, !last, F.ctl + CW_AQ + 512 * l);
                           for (int q = (l == 0 ? 0 : 1); q < 2; ++q)
                               convert_fill(F, args, q, q == 0 ? 1 : l, F.ctl + CW_WCV + (q == 0 ? 1536 : 512 * l), 0, q == 0 ? wcv::NH1 : (l == 0 ? wcv::NH0 : wcv::NH1 - wcv::I_FO) - WCV_RES); } } PH_END
#if PROBE_ATTN
            PH_BEGIN { MAKE_ACTX() attn_mfma_phase(F, A, !last, F.ctl + CW_AQ + 512 * (l + 2), PROBE_ATTN); } PH_END
#endif
            PH_BEGIN { MAKE_ACTX() diff_combine_phase(F, A, last ? ML : M, !last); } PH_END
#endif
#undef MAKE_ACTX
            PH_BEGIN {
                pg8::Gemm g{wsp<bf16_t>(F, WS_OMIX), wsp<bf16_t>(F, WS_WBR + (size_t)l * WSQ_SZ)};
                pg8::MergeSched S; S.init(G, cid, nM_o == 34);
                pg8::EpiMerge E{F.ws};
                pg8::gemm_phase<pg8::EpiMerge, pg8::MergeSched, D, D>(ring, g, S, E, F.wave);
            } PH_END
            PH_BEGIN {
                pg8::Gemm g{wsp<bf16_t>(F, WS_Y), wsp<bf16_t>(F, WS_WO + (size_t)l * WSQ_SZ)};
                pg8::ResidSched<8, 256> S; S.init(D / 256, G, cid, D / 64, nM_o == 34);
                pg8::EpiResidNorm E{F.ws, modl + 5 * D, args.in[I_NORMW] + (size_t)(l * 3 + 2) * D, modl + 6 * D, nullptr, nullptr, 1.0f, 3 * l + 1};
                pg8::gemm_phase<pg8::EpiResidNorm, pg8::ResidSched<8, 256>, D, D>(ring, g, S, E, F.wave);
            } PH_END
        }
    }
#if PROBE_BAR
    for (int pb = 0; pb < 32; ++pb) { PH_BEGIN PH_END }
#endif
#undef PH_BEGIN
#undef PH_END
}
constexpr int N_PHASES = 1 + 2 * DEPTH * 3 + DEPTH * (ATTN_NAIVE ? 6 : 7) + 1;

extern "C" void kernel_launch(void* const* d_in, const int* in_sizes, int n_in, void* d_out, int out_size, void* d_ws, size_t ws_size, hipStream_t stream) {
    static int grid = 0;
    if (grid == 0) {
        if (n_in != 20 || in_sizes[0] != ML * D || out_size != ML * D || ws_size < WS_END) { fprintf(stderr, "kernel_launch: unexpected shapes (n_in %d, in0 %d, out %d, ws %zu < %zu); nothing launched\n", n_in, n_in > 0 ? in_sizes[0] : -1, out_size, ws_size, (size_t)WS_END); grid = -1; return; }
        int dev = 0, cus = 0, per_cu = 0;
        if (hipGetDevice(&dev) != hipSuccess || hipDeviceGetAttribute(&cus, hipDeviceAttributeMultiprocessorCount, dev) != hipSuccess) { grid = -1; return; }
        if (hipFuncSetAttribute((const void*)dit_fwd, hipFuncAttributeMaxDynamicSharedMemorySize, LDS_BYTES) != hipSuccess) { fprintf(stderr, "kernel_launch: hipFuncSetAttribute failed\n"); grid = -1; return; }
        if (hipOccupancyMaxActiveBlocksPerMultiprocessor(&per_cu, (const void*)dit_fwd, NTHREADS, LDS_BYTES) != hipSuccess || per_cu < 1)
            fprintf(stderr, "kernel_launch: note: occupancy query reports %d workgroups per CU\n", per_cu);
        (void)hipGetLastError();
        grid = cus;
    }
    if (grid < 0) return;
    if (hipMemsetAsync((char*)d_ws + WS_CTL, 0, CTL_ZERO_BYTES, stream) != hipSuccess) { fprintf(stderr, "kernel_launch: hipMemsetAsync failed\n"); return; }
    Args a{};
    for (int i = 0; i < 20; ++i) a.in[i] = (const float*)d_in[i];
    a.out = (float*)d_out; a.ws = (unsigned char*)d_ws;
#if MK_SPLIT
    for (int p = 0; p < N_PHASES; ++p) { a.ph_lo = p; a.ph_hi = p + 1; hipLaunchKernelGGL(dit_fwd, dim3(grid), dim3(NTHREADS), LDS_BYTES, stream, a); }
#else
    a.ph_lo = 0; a.ph_hi = 1 << 20;
    hipLaunchKernelGGL(dit_fwd, dim3(grid), dim3(NTHREADS), LDS_BYTES, stream, a);
    const hipError_t le = hipPeekAtLastError();
    if (le != hipSuccess) fprintf(stderr, "kernel_launch: launch failed: %s\n", hipGetErrorName(le));
#endif
}
```

```cpp
#include <hip/hip_runtime.h>
#include <cstdio>
#include <cstdint>

#define GAS __attribute__((address_space(1)))
#define LAS __attribute__((address_space(3)))
typedef unsigned short bf16_t;
typedef short bf16x8 __attribute__((ext_vector_type(8)));
typedef float f32x4 __attribute__((ext_vector_type(4)));
typedef float f32x2 __attribute__((ext_vector_type(2)));
typedef unsigned u32x4 __attribute__((ext_vector_type(4)));
typedef unsigned u32x2 __attribute__((ext_vector_type(2)));

constexpr int D = 2048, NBATCH = 2, SEQ = 4096, DEPTH = 2, CTXL = 256, FF = 5632, NMOD = 9, GRIDW = 64;
constexpr int ML = NBATCH * SEQ;
constexpr int MC = NBATCH * CTXL;
constexpr int M = ML + MC;
constexpr int INW = 11712, MODLD = NMOD * D;
constexpr int NA_W = 768, MLA_W = 640, DF_W = 640, QRANK = 768, KVRANK = 512;
constexpr int H_NA = 6, H_MLA = 5, H_DF = 5;
constexpr float NORM_EPS = 1e-6f, LOG2E = 1.4426950408889634f;
constexpr float NA_SCALE = 0.08838834764831845f, MLA_SCALE = 0.07216878364870322f, DF_SCALE = 0.125f;
constexpr int NWAVES = 8, NTHREADS = 512;
constexpr int LDH = D + 64;
constexpr int LDX = D + 32;

constexpr size_t al256(size_t x) { return (x + 255) & ~(size_t)255; }
constexpr size_t WS_CTL = 0, CTL_ZERO_BYTES = 1u << 20;
constexpr int CW_TMO = 0, CW_AQ = 1024, CW_BAR = 4096, CW_WCV = 8192, CW_DC = 12288;
constexpr size_t WS_MOD = 65536;
constexpr size_t WS_SSQ = 524288;
constexpr int NFUSE = 3 * DEPTH;
constexpr size_t WS_SSQX = WS_SSQ + (size_t)DEPTH * 2 * M * 4;
constexpr size_t WS_PCNT = WS_SSQX + (size_t)NFUSE * ML * 4;
static_assert(WS_MOD + (size_t)DEPTH * 3 * MODLD * 4 <= WS_SSQ && WS_SSQX % 256 == 0 && WS_PCNT % 256 == 0 && WS_PCNT + (size_t)NFUSE * 32 * 256 <= CTL_ZERO_BYTES, "ctl map");
constexpr size_t WS_ROPE = CTL_ZERO_BYTES;
constexpr size_t WS_XS   = WS_ROPE + 8192;
constexpr size_t WS_H    = WS_XS   + al256((size_t)M * LDX * 4);
constexpr size_t WS_U    = WS_H    + al256((size_t)M * LDH * 2);
constexpr size_t WS_NAQ  = WS_U    + al256((size_t)M * FF * 2);
constexpr size_t WS_NAK  = WS_NAQ  + al256((size_t)M * 768 * 2);
constexpr size_t WS_CQ   = WS_NAK  + al256((size_t)M * 768 * 2);
constexpr size_t WS_CKV  = WS_CQ   + al256((size_t)M * 768 * 2);
constexpr size_t WS_DQ   = WS_CKV  + al256((size_t)M * 512 * 2);
constexpr size_t WS_DK   = WS_DQ   + al256((size_t)M * 640 * 2);
constexpr size_t WS_G    = WS_DK   + al256((size_t)M * 640 * 2);
constexpr size_t WS_VTIN = WS_G    + al256((size_t)M * 6144 * 2);
constexpr size_t WS_MQ   = WS_VTIN + al256((size_t)1536 * M * 2);
constexpr size_t WS_MK   = WS_MQ   + al256((size_t)M * 1024 * 2);
constexpr size_t WS_VTM  = WS_MK   + al256((size_t)M * 960 * 2);
constexpr size_t WS_OMIX = WS_VTM  + al256((size_t)768 * M * 2);
constexpr size_t WS_YF   = WS_OMIX + al256((size_t)M * D * 2);
constexpr size_t WS_Y    = WS_YF   + al256((size_t)M * LDX * 4);
constexpr size_t WS_WFI  = WS_Y    + al256((size_t)M * D * 2);
constexpr size_t WFI_SZ = (size_t)2 * FF * D * 2, WFO_SZ = (size_t)D * FF * 2, WIN_ROWS = 10496, WIN_SZ = WIN_ROWS * D * 2, WVT_SZ = (size_t)1536 * D * 2;
constexpr size_t WUQ_SZ = (size_t)1024 * 768 * 2, WUK_SZ = (size_t)768 * 512 * 2, WSQ_SZ = (size_t)D * D * 2;
constexpr size_t WS_WFO  = WS_WFI + 4 * WFI_SZ;
constexpr size_t WS_WIN  = WS_WFO + 4 * WFO_SZ;
constexpr size_t WS_WVT  = WS_WIN + 2 * WIN_SZ;
constexpr size_t WS_WUQ  = WS_WVT + 2 * WVT_SZ;
constexpr size_t WS_WUK  = WS_WUQ + 2 * WUQ_SZ;
constexpr size_t WS_WUV  = WS_WUK + 2 * WUK_SZ;
constexpr size_t WS_WBR  = WS_WUV + 2 * WUK_SZ;
constexpr size_t WS_WO   = WS_WBR + 2 * WSQ_SZ;
constexpr size_t WS_PART = WS_WO  + 2 * WSQ_SZ;
constexpr int LDXH = D + 64, LDXL = D + 128;
constexpr size_t WS_XH   = WS_PART + (size_t)11 * MC * LDX * 4;
constexpr size_t WS_XL   = WS_XH + (size_t)ML * LDXH * 2;
constexpr size_t WS_END  = WS_XL + (size_t)ML * LDXL;

constexpr int RING_OFF = 0, RING_BYTES = 131072;
constexpr int LDSCTL_OFF = RING_BYTES, MISC_OFF = LDSCTL_OFF + 320;
constexpr int ROPE_LDS = LDSCTL_OFF + 1024;
constexpr int LDS_BYTES = 147456;

typedef GAS unsigned gu32;
#define RLX_AGENT __ATOMIC_RELAXED, __HIP_MEMORY_SCOPE_AGENT
#define LDS_WAIT() asm volatile("s_waitcnt lgkmcnt(0)" ::: "memory")
#define VM_WAIT() asm volatile("s_waitcnt vmcnt(0)" ::: "memory")
__device__ __forceinline__ unsigned f2bf(float f) { unsigned u = __builtin_bit_cast(unsigned, f); return (u + 0x7fffu + ((u >> 16) & 1u)) >> 16; }
__device__ __forceinline__ unsigned pk2(float lo, float hi) { return f2bf(lo) | (f2bf(hi) << 16); }
__device__ __forceinline__ float bf2f(unsigned short b) { return __builtin_bit_cast(float, ((unsigned)b) << 16); }
__device__ __forceinline__ float bflo(unsigned w) { return __builtin_bit_cast(float, w << 16); }
__device__ __forceinline__ float bfhi(unsigned w) { return __builtin_bit_cast(float, w & 0xffff0000u); }
__device__ __forceinline__ unsigned cvt_pk_bf16(float lo, float hi) { unsigned r; asm volatile("v_cvt_pk_bf16_f32 %0, %1, %2" : "=v"(r) : "v"(lo), "v"(hi)); return r; }
template <int X> __device__ __forceinline__ float xor_lane(float v) {
    static_assert(X == 1 || X == 2 || X == 4 || X == 8 || X == 16, "xor_lane: within a 32-lane half (ds_swizzle bit mode)");
    return __builtin_bit_cast(float, __builtin_amdgcn_ds_swizzle(__builtin_bit_cast(int, v), (X << 10) | 0x1F));
}
__device__ __forceinline__ float half_sum(float v) { const unsigned u = __builtin_bit_cast(unsigned, v); auto rr = __builtin_amdgcn_permlane32_swap(u, u, false, false); return __builtin_bit_cast(float, (unsigned)rr[0]) + __builtin_bit_cast(float, (unsigned)rr[1]); }
__device__ __forceinline__ float half_max(float v) { const unsigned u = __builtin_bit_cast(unsigned, v); auto rr = __builtin_amdgcn_permlane32_swap(u, u, false, false); return fmaxf(__builtin_bit_cast(float, (unsigned)rr[0]), __builtin_bit_cast(float, (unsigned)rr[1])); }
__device__ __forceinline__ float wave_sum(float v) {
    v += xor_lane<1>(v); v += xor_lane<2>(v); v += xor_lane<4>(v); v += xor_lane<8>(v); v += xor_lane<16>(v); return half_sum(v);
}
__device__ __forceinline__ float wave_max(float v) {
    v = fmaxf(v, xor_lane<1>(v)); v = fmaxf(v, xor_lane<2>(v)); v = fmaxf(v, xor_lane<4>(v)); v = fmaxf(v, xor_lane<8>(v)); v = fmaxf(v, xor_lane<16>(v)); return half_max(v);
}
__device__ __forceinline__ float fast_exp2(float x) { return __builtin_amdgcn_exp2f(x); }
__device__ __forceinline__ float fast_rcp(float x) { return __builtin_amdgcn_rcpf(x); }
__device__ __forceinline__ float silu_f(float a) { return a * fast_rcp(1.0f + fast_exp2(-a * LOG2E)); }
__device__ __forceinline__ float sigmoid_f(float a) { return fast_rcp(1.0f + fast_exp2(-a * LOG2E)); }
__device__ __forceinline__ void atomic_add_f32(float* p, float v) { unsafeAtomicAdd(p, v); }
__device__ __forceinline__ int opaque_v(int x) { asm volatile("" : "+v"(x)); return x; }
__device__ __forceinline__ int opaque_s(int x) { asm volatile("" : "+s"(x)); return x; }
__device__ __forceinline__ int lane_id() { int r; asm volatile("v_mbcnt_lo_u32_b32 %0, -1, 0\n\tv_mbcnt_hi_u32_b32 %0, -1, %0" : "=v"(r)); return r; }
__device__ __forceinline__ int tid_of(int wave) { return wave * 64 + lane_id(); }
#define XB_TMO      128
#define XB_XCNT(j)  (256  + 64 * (j))
#define XB_XSUB(j)  (1280 + 64 * (j))
#define XB_XGEN(j)  (2304 + 64 * (j))
#define XB_TOP      3328
#define XB_TOPGEN   3392
#define XCD_BAR_WORDS 3456
#define XB_SPIN_CAP (1u << 23)

__device__ __forceinline__ unsigned xb_ld(unsigned* p)              { return __hip_atomic_load(p, __ATOMIC_RELAXED, __HIP_MEMORY_SCOPE_AGENT); }
__device__ __forceinline__ unsigned xb_add(unsigned* p, unsigned v) { return __hip_atomic_fetch_add(p, v, __ATOMIC_RELAXED, __HIP_MEMORY_SCOPE_AGENT); }
__device__ __forceinline__ unsigned xb_xcc_id() { return (unsigned)__builtin_amdgcn_s_getreg((3 << 11) | 20) & 0xFu; }
#define XB_SPIN(cond, bar) do { unsigned _sp = 0; while (cond) { __builtin_amdgcn_s_sleep(1); \
    if ((++_sp & 255u) == 0u) { if (xb_ld(&(bar)[XB_TMO])) break; if (_sp > XB_SPIN_CAP) { atomicAdd(&(bar)[XB_TMO], 1u); break; } } } } while (0)

struct XcdBarrier {
    unsigned* bar; unsigned x; int wave;
    volatile LAS unsigned* st;
};

__device__ __forceinline__ XcdBarrier xcd_barrier_post(unsigned* bar, volatile LAS unsigned* st, int wave) {
    XcdBarrier b; b.bar = bar; b.x = xb_xcc_id(); b.st = st; b.wave = wave;
    if (threadIdx.x == 0) (void)xb_add(&bar[XB_XCNT(b.x)], 1u);
    return b;
}
__device__ __forceinline__ void xcd_barrier_complete(unsigned* bar, unsigned x, unsigned& nloc, unsigned& nx) {
    const unsigned G = gridDim.x * gridDim.y * gridDim.z;
    unsigned sum, cnt, mine, sp = 0u;
    for (;;) {
        sum = 0u; cnt = 0u; mine = 0u;
#pragma unroll
        for (unsigned j = 0; j < 16; ++j) { const unsigned c = xb_ld(&bar[XB_XCNT(j)]); sum += c; cnt += (c > 0u) ? 1u : 0u; mine = (j == x) ? c : mine; }
        if (sum == G) break;
        __builtin_amdgcn_s_sleep(1);
        if ((++sp & 255u) == 0u) { if (xb_ld(&bar[XB_TMO])) break; if (sp > XB_SPIN_CAP) { atomicAdd(&bar[XB_TMO], 1u); break; } }
    }
    nloc = mine > 0u ? mine : 1u; nx = cnt > 0u ? cnt : 1u;
}

__device__ __forceinline__ void xcd_barrier(const XcdBarrier& b) {
    asm volatile("s_waitcnt vmcnt(0)" ::: "memory");
    __syncthreads();
    if (b.wave == 0 && lane_id() == 0) {
        unsigned* bar = b.bar;
        __builtin_amdgcn_s_waitcnt(0);
        unsigned nloc = b.st[0], nx = b.st[1];
        if (nloc == 0u) { xcd_barrier_complete(bar, b.x, nloc, nx); b.st[0] = nloc; b.st[1] = nx; }
        const unsigned old = xb_add(&bar[XB_XSUB(b.x)], 1u);
        const unsigned gen = old / nloc;
        if (old + 1u == (gen + 1u) * nloc) {
            __builtin_amdgcn_fence(__ATOMIC_RELEASE, "agent");
            asm volatile("s_waitcnt vmcnt(0)" ::: "memory");
            const unsigned og = xb_add(&bar[XB_TOP], 1u);
            const unsigned tg = og / nx;
            if (og + 1u == (tg + 1u) * nx) xb_add(&bar[XB_TOPGEN], 1u);
            else XB_SPIN(xb_ld(&bar[XB_TOPGEN]) == tg, bar);
            __builtin_amdgcn_fence(__ATOMIC_ACQUIRE, "agent");
            xb_add(&bar[XB_XGEN(b.x)], 1u);
            asm volatile("s_waitcnt vmcnt(0)" ::: "memory");
        } else {
            XB_SPIN(xb_ld(&bar[XB_XGEN(b.x)]) == gen, bar);
            __builtin_amdgcn_fence(__ATOMIC_ACQUIRE, "agent");
            asm volatile("s_waitcnt vmcnt(0)" ::: "memory");
        }
    }
    __syncthreads();
}

#ifndef MERGE_CTX_ATOMIC
#define MERGE_CTX_ATOMIC 1
#endif
namespace pg8 {
constexpr int BM = 256, BK = 64, HALF = 128, HTB = HALF * BK * 2, STAGE_BYTES = 8 * HTB, NXCD = 8, WGM = 8;
__host__ __device__ __forceinline__ int lds_byte(int r, int c) { const int st = (r >> 4) * 2 + (c >> 5), rr = r & 15, cc = c & 31, ob = rr * 64 + cc * 2; return st * 1024 + (ob ^ (((ob >> 9) & 1) << 5)); }
__host__ __device__ __forceinline__ void stage_rc(int b, int& R, int& C) { const int st = b / 1024, sb = b % 1024, swz = sb ^ (((sb >> 9) & 1) << 5); R = (st >> 1) * 16 + swz / 64; C = (st & 1) * 32 + (swz % 64) / 2; }
__host__ __device__ __forceinline__ int perm32(int rho) { const int n = rho >> 4, i = rho & 15; return 8 * (i >> 2) + 4 * n + (i & 3); }

struct Unit { int pm, pn, kofs, nkt, aux; };
struct Gemm { const bf16_t* A; const bf16_t* Bt; };

struct SegSched {
    int n, nM, nN, G, first, kofs, nkt, lim;
    __device__ __forceinline__ void init(int lo, int nM_, int nN_, int G_, int c, int kofs_, int nkt_) {
        nM = nM_; nN = nN_; n = nM * nN; G = G_; kofs = kofs_; nkt = nkt_; lim = n;
        int f = (c - lo) % G; if (f < 0) f += G; first = f;
    }
    __device__ __forceinline__ bool next(int i, Unit& u) const {
        const long L = (long)first + (long)i * G; if (L >= lim) return false;
        int wgid = (int)L; { const int q = n / NXCD, r = n % NXCD, xcd = wgid % NXCD, off = wgid / NXCD; wgid = (xcd < r ? xcd * (q + 1) : r * (q + 1) + (xcd - r) * q) + off; }
        const int nig = WGM * nN, gid = wgid / nig, fm = gid * WGM, gsz = (nM - fm) < WGM ? (nM - fm) : WGM;
        u.pm = fm + ((wgid % nig) % gsz); u.pn = (wgid % nig) / gsz; u.kofs = kofs; u.nkt = nkt; u.aux = 0; return true;
    }
};
template <int NSPLIT, int KCHUNK> struct ResidSched {
    SegSched lat; int G, c, nctx;
    __device__ __forceinline__ void init(int nN, int G_, int c_, int nkt_full, bool with_ctx) { lat.init(0, 32, nN, G_, c_, 0, nkt_full); G = G_; c = c_; nctx = with_ctx ? 2 * nN * NSPLIT : 0; }
    __device__ __forceinline__ bool next(int i, Unit& u) const {
        const long L = (long)c + (long)i * G;
        if (L < lat.n) return lat.next(i, u);
        const int x = (int)(L - lat.n); if (x >= nctx) return false;
        const int t = x / NSPLIT, ks = x - t * NSPLIT;
        u.pm = 32 + (t >> 3); u.pn = t & 7; u.kofs = ks * KCHUNK;        u.nkt = KCHUNK / BK; u.aux = 1 + ks; return true;
    }
};
struct InProjSched {
    SegSched a; int G, c, nctx;
    __device__ __forceinline__ void init(bool last, int G_, int c_) { a.init(0, last ? 32 : 34, 41, G_, c_, 0, 32); G = G_; c = c_; nctx = last ? 18 : 0; }
    __device__ __forceinline__ int total() const { return a.n + nctx; }
    __device__ __forceinline__ bool next(int i, Unit& u) const {
        const long L = (long)c + (long)i * G;
        if (L < a.n) return a.next(i, u);
        const int x = (int)(L - a.n); if (x >= nctx) return false;
        const int p = x / 9, j = x - 9 * p;
        u.pm = 32 + p; u.pn = j < 3 ? 3 + j : (j < 5 ? 6 + j : 8 + j); u.kofs = 0; u.nkt = 32; u.aux = 0; return true;
    }
};
struct MergeSched {
    SegSched s; int G, c, ntl, nctx;
    __device__ __forceinline__ void init(int G_, int c_, bool with_ctx) {
#if MERGE_CTX_ATOMIC
        s.init(0, 32, 8, G_, c_, 0, 0); G = G_; c = c_; ntl = c_ < 256 ? (256 - c_ + G_ - 1) / G_ : 0; nctx = with_ctx ? 48 : 0;
#else
        const int nt_ = with_ctx ? 272 : 256; s.init(0, with_ctx ? 34 : 32, 8, G_, c_, 0, 0); G = G_; c = c_; ntl = c_ < nt_ ? (nt_ - c_ + G_ - 1) / G_ : 0; nctx = 0;
#endif
    }
    __device__ __forceinline__ bool next(int i, Unit& u) const {
        int br;
        if (i < 3 * ntl) { const int t = i / 3; br = i - 3 * t; if (!s.next(t, u)) return false; u.aux = br; }
        else { const int x = c + (i - 3 * ntl) * G; if (x >= nctx) return false; const int t = x / 3; br = x - 3 * t; u.pm = 32 + (t >> 3); u.pn = t & 7; u.aux = 4 + br; }
        u.kofs = br == 0 ? 0 : (br == 1 ? 768 : 1408); u.nkt = br == 0 ? 12 : 10; return true;
    }
};

template <class Epi, class Sched, int LDA, int LDB, bool ALIGN_EPI = true>
__device__ __forceinline__ void gemm_phase(LAS unsigned char* lds, const Gemm g, const Sched& S, const Epi& E, int wave) {
    const int tid = tid_of(wave), wid = wave, lane = tid & 63, wr = wid >> 2, wc = wid & 3, fr = lane & 15, fq = lane >> 4;
    unsigned voffA[2], voffB[2];
#pragma unroll
    for (int i = 0; i < 2; ++i) { int R, C; stage_rc(tid * 16 + i * 8192, R, C); const int Rb = Epi::PERM ? ((R & ~31) + perm32(R & 31)) : R;
        voffA[i] = (unsigned)(R * LDA + C) * 2u; voffB[i] = (unsigned)(Rb * LDB + C) * 2u; }
    constexpr size_t kstep = (size_t)(BK * 2);
    constexpr size_t hstepA = (size_t)HALF * LDA * 2, hstepB = (size_t)HALF * LDB * 2;
    constexpr size_t tstepA = 2 * hstepA, tstepB = 2 * hstepB;
    const unsigned ldsw = (unsigned)wid * 1024u;
    const int aoff = lds_byte(wr * 64 + fr, fq * 8), boff = lds_byte(wc * 32 + fr, fq * 8);
#define PG8_SA(b, h) (((b) * 2 + (h)) * HTB)
#define PG8_SB(b, h) ((4 + (b) * 2 + (h)) * HTB)
#define PG8_STAGE(bufoff, gbase, voff) do { _Pragma("unroll") for (int _i = 0; _i < 2; ++_i) \
        __builtin_amdgcn_global_load_lds((const unsigned*)((const char*)(gbase) + (voff)[_i]), (LAS unsigned*)(lds + (bufoff) + ldsw + _i * 8192), 16, 0, 0); } while (0)
#define PG8_LDA(dst, b, h) do { _Pragma("unroll") for (int m = 0; m < 4; ++m) _Pragma("unroll") for (int k = 0; k < 2; ++k) dst[m][k] = *(const LAS bf16x8*)(lds + PG8_SA(b, h) + aoff + m * 2048 + k * 1024); } while (0)
#define PG8_LDB(dst, b, h) do { _Pragma("unroll") for (int n = 0; n < 2; ++n) _Pragma("unroll") for (int k = 0; k < 2; ++k) dst[n][k] = *(const LAS bf16x8*)(lds + PG8_SB(b, h) + boff + n * 2048 + k * 1024); } while (0)
#define PG8_MMA(ai, bj, At, Bt) do { __builtin_amdgcn_s_setprio(1); _Pragma("unroll") for (int m = 0; m < 4; ++m) _Pragma("unroll") for (int n = 0; n < 2; ++n) _Pragma("unroll") for (int k = 0; k < 2; ++k) \
        acc[ai][bj][m][n] = __builtin_amdgcn_mfma_f32_16x16x32_bf16(Bt[n][k], At[m][k], acc[ai][bj][m][n], 0, 0, 0); __builtin_amdgcn_s_setprio(0); } while (0)
#define PG8_WAIT_V(n) asm volatile("s_waitcnt vmcnt(" #n ")" ::: "memory")
#define PG8_WAIT_L(n) asm volatile("s_waitcnt lgkmcnt(" #n ")" ::: "memory")
#define PG8_BAR __builtin_amdgcn_s_barrier()
#define PG8_SCHED __builtin_amdgcn_sched_barrier(0)
    Unit cur, nxt; int ui = 0;
    if (!S.next(0, cur)) return;
    f32x4 acc[2][2][4][2];
#pragma unroll
    for (int a = 0; a < 2; ++a)
#pragma unroll
        for (int b = 0; b < 2; ++b)
#pragma unroll
            for (int m = 0; m < 4; ++m)
#pragma unroll
                for (int n = 0; n < 2; ++n) acc[a][b][m][n] = (f32x4){0.f, 0.f, 0.f, 0.f};
    bf16x8 At[4][2], B0[2][2], B1[2][2];
    const char* cA = (const char*)g.A + (size_t)cur.pm * tstepA + (size_t)cur.kofs * 2; const char* cB = (const char*)g.Bt + (size_t)cur.pn * tstepB + (size_t)cur.kofs * 2;
    PG8_STAGE(PG8_SB(0, 0), cB, voffB); PG8_STAGE(PG8_SB(0, 1), cB + hstepB, voffB); PG8_STAGE(PG8_SA(0, 0), cA, voffA); PG8_STAGE(PG8_SA(0, 1), cA + hstepA, voffA);
    if (wr == 1) PG8_BAR;
    PG8_WAIT_V(2); PG8_BAR;
    PG8_STAGE(PG8_SB(1, 0), cB + kstep, voffB); PG8_STAGE(PG8_SA(1, 0), cA + kstep, voffA); PG8_STAGE(PG8_SB(1, 1), cB + hstepB + kstep, voffB);
    PG8_WAIT_V(6); PG8_BAR;
    for (;;) {
        const bool has_next = S.next(ui + 1, nxt);
        const char* nA = has_next ? (const char*)g.A + (size_t)nxt.pm * tstepA + (size_t)nxt.kofs * 2 : cA; const char* nB = has_next ? (const char*)g.Bt + (size_t)nxt.pn * tstepB + (size_t)nxt.kofs * 2 : cB;
        const int nt = cur.nkt;
        for (int t = 0; t < nt; t += 2) {
            const bool last = (t == nt - 2);
            const char* a1 = cA + (size_t)(t + 1) * kstep;
            const char* a2 = last ? nA : cA + (size_t)(t + 2) * kstep; const char* b2 = last ? nB : cB + (size_t)(t + 2) * kstep;
            const char* a3 = a2 + kstep; const char* b3 = b2 + kstep;
            PG8_LDB(B0, 0, 0); PG8_LDB(B1, 0, 1); PG8_SCHED; PG8_LDA(At, 0, 0); PG8_STAGE(PG8_SA(1, 1), a1 + hstepA, voffA);
            PG8_WAIT_V(8); PG8_WAIT_L(0); PG8_BAR; PG8_MMA(0, 0, At, B0); PG8_MMA(0, 1, At, B1); PG8_BAR; PG8_SCHED;
            PG8_LDA(At, 0, 1); PG8_STAGE(PG8_SB(0, 0), b2, voffB); PG8_STAGE(PG8_SB(0, 1), b2 + hstepB, voffB); PG8_STAGE(PG8_SA(0, 0), a2, voffA);
            PG8_WAIT_V(8); PG8_WAIT_L(0); PG8_BAR; PG8_MMA(1, 0, At, B0); PG8_MMA(1, 1, At, B1); PG8_BAR; PG8_SCHED;
            PG8_LDB(B0, 1, 0); PG8_LDB(B1, 1, 1); PG8_SCHED; PG8_LDA(At, 1, 0); PG8_STAGE(PG8_SA(0, 1), a2 + hstepA, voffA);
            PG8_WAIT_V(8); PG8_WAIT_L(0); PG8_BAR; PG8_MMA(0, 0, At, B0); PG8_MMA(0, 1, At, B1); PG8_BAR; PG8_SCHED;
            PG8_LDA(At, 1, 1); PG8_STAGE(PG8_SB(1, 0), b3, voffB); PG8_STAGE(PG8_SB(1, 1), b3 + hstepB, voffB); PG8_STAGE(PG8_SA(1, 0), a3, voffA);
            PG8_WAIT_V(8); PG8_WAIT_L(0); PG8_BAR; PG8_MMA(1, 0, At, B0); PG8_MMA(1, 1, At, B1); PG8_BAR; PG8_SCHED;
        }
        if constexpr (ALIGN_EPI) { if (wr == 0) PG8_BAR; }
        E(acc, cur, wr, wc, fr, fq);
        if (!has_next) break;
#pragma unroll
        for (int a = 0; a < 2; ++a)
#pragma unroll
            for (int b = 0; b < 2; ++b)
#pragma unroll
                for (int m = 0; m < 4; ++m)
#pragma unroll
                    for (int n = 0; n < 2; ++n) acc[a][b][m][n] = (f32x4){0.f, 0.f, 0.f, 0.f};
        cur = nxt; cA = nA; cB = nB; ++ui;
        if constexpr (ALIGN_EPI) { if (wr == 1) PG8_BAR; }
    }
    PG8_WAIT_V(0);
    if constexpr (!ALIGN_EPI) { if (wr == 0) PG8_BAR; }
    PG8_BAR;
#undef PG8_SA
#undef PG8_SB
#undef PG8_STAGE
#undef PG8_LDA
#undef PG8_LDB
#undef PG8_MMA
#undef PG8_WAIT_V
#undef PG8_WAIT_L
#undef PG8_BAR
#undef PG8_SCHED
}
}
namespace pg8 {
__device__ __forceinline__ int mod_row(int pm) { return pm < 16 ? 0 : (pm < 32 ? 1 : 2); }

struct EpiSwiGLU {
    static constexpr bool PERM = true;
    bf16_t* U;
    __device__ __forceinline__ void operator()(const f32x4 (&acc)[2][2][4][2], const Unit& u, int wr, int wc, int fr, int fq) const {
        const int row0 = u.pm * BM + wr * 64 + fr, col0 = u.pn * HALF + wc * 32 + 8 * fq;
#pragma unroll
        for (int ai = 0; ai < 2; ++ai)
#pragma unroll
            for (int m = 0; m < 4; ++m) { bf16_t* p = U + (size_t)(row0 + ai * HALF + m * 16) * FF + col0;
                const f32x4 a0 = acc[ai][0][m][0], a1 = acc[ai][0][m][1], b0 = acc[ai][1][m][0], b1 = acc[ai][1][m][1];
                float v[8];
#pragma unroll
                for (int e = 0; e < 4; ++e) { v[e] = silu_f(a0[e]) * b0[e]; v[4 + e] = silu_f(a1[e]) * b1[e]; }
                u32x4 w; w.x = cvt_pk_bf16(v[0], v[1]); w.y = cvt_pk_bf16(v[2], v[3]); w.z = cvt_pk_bf16(v[4], v[5]); w.w = cvt_pk_bf16(v[6], v[7]);
                *(u32x4*)p = w; }
    }
};

struct EpiNull {
    static constexpr bool PERM = true;
    float* dummy;
    __device__ __forceinline__ void operator()(const f32x4 (&acc)[2][2][4][2], const Unit& u, int wr, int wc, int fr, int fq) const {
        f32x4 s = {0.f, 0.f, 0.f, 0.f};
#pragma unroll
        for (int ai = 0; ai < 2; ++ai)
#pragma unroll
            for (int bj = 0; bj < 2; ++bj)
#pragma unroll
                for (int m = 0; m < 4; ++m)
#pragma unroll
                    for (int n = 0; n < 2; ++n) s = s + acc[ai][bj][m][n];
        dummy[(size_t)(u.pm * 64 + u.pn) * 512 + (wr * 4 + wc) * 64 + fq * 16 + fr] = (s[0] + s[1]) + (s[2] + s[3]);
    }
};

struct EpiResidNorm {
    static constexpr bool PERM = true;
    unsigned char* ws; const float* gate; const float* g; const float* shift; float* out; const float* xin; float gs; int fs;
    __device__ __forceinline__ void operator()(const f32x4 (&acc)[2][2][4][2], const Unit& u, int wr, int wc, int fr, int fq) const {
        const int row0 = u.pm * BM + wr * 64 + fr, col0 = u.pn * BM + wc * 32 + 8 * fq, mr = mod_row(u.pm);
        const float* gp = gate + (size_t)mr * MODLD + col0;
        f32x4 gv[2][2];
#pragma unroll
        for (int bj = 0; bj < 2; ++bj)
#pragma unroll
            for (int n = 0; n < 2; ++n) gv[bj][n] = *(const f32x4*)(gp + bj * HALF + n * 4) * gs;
        if (u.aux == 0) {
            bf16_t* XH = (bf16_t*)(ws + WS_XH); unsigned char* XL = ws + WS_XL; float* ssq = (float*)(ws + WS_SSQX) + (size_t)fs * ML; unsigned* cnt = (unsigned*)(ws + WS_PCNT) + (size_t)(fs * 32 + u.pm) * 64;
            const bool fin = out != nullptr;
            f32x4 xn[2][4][2][2];
#pragma unroll
            for (int ai = 0; ai < 2; ++ai)
#pragma unroll
                for (int m = 0; m < 4; ++m) { const int row = row0 + ai * HALF + m * 16; bf16_t* rowh = XH + (size_t)row * LDXH + col0; unsigned char* rowl = XL + (size_t)row * LDXL + col0; float ss = 0.f;
#pragma unroll
                    for (int bj = 0; bj < 2; ++bj) { f32x4 x0, x1;
                        if (xin) { const float* rin = xin + (size_t)row * D + col0 + bj * HALF; x0 = *(const f32x4*)rin; x1 = *(const f32x4*)(rin + 4); }
                        else { const u32x4 hw = *(const u32x4*)(rowh + bj * HALF); const u32x2 lw = *(const u32x2*)(rowl + bj * HALF);
#define XUNP(h, l, k) __builtin_bit_cast(float, __builtin_amdgcn_perm((h), (l), ((k) & 1) ? (0x07060000u | ((unsigned)((k) & 3) << 8) | 0x0cu) : (0x05040000u | ((unsigned)((k) & 3) << 8) | 0x0cu)))
                            x0 = (f32x4){XUNP(hw.x, lw.x, 0), XUNP(hw.x, lw.x, 1), XUNP(hw.y, lw.x, 2), XUNP(hw.y, lw.x, 3)};
                            x1 = (f32x4){XUNP(hw.z, lw.y, 4), XUNP(hw.z, lw.y, 5), XUNP(hw.w, lw.y, 6), XUNP(hw.w, lw.y, 7)};
#undef XUNP
                        }
                        const f32x4 t0 = x0 + gv[bj][0] * acc[ai][bj][m][0], t1 = x1 + gv[bj][1] * acc[ai][bj][m][1];
                        if (!fin) {
                            unsigned b[8];
#pragma unroll
                            for (int e = 0; e < 4; ++e) { const float f0 = t0[e], f1 = t1[e]; b[e] = __builtin_bit_cast(unsigned, f0); b[4 + e] = __builtin_bit_cast(unsigned, f1); }
                            u32x4 hw; hw.x = __builtin_amdgcn_perm(b[1], b[0], 0x07060302u); hw.y = __builtin_amdgcn_perm(b[3], b[2], 0x07060302u); hw.z = __builtin_amdgcn_perm(b[5], b[4], 0x07060302u); hw.w = __builtin_amdgcn_perm(b[7], b[6], 0x07060302u);
                            u32x2 lw; lw.x = __builtin_amdgcn_perm(__builtin_amdgcn_perm(b[3], b[2], 0x0c0c0501u), __builtin_amdgcn_perm(b[1], b[0], 0x0c0c0501u), 0x05040100u);
                            lw.y = __builtin_amdgcn_perm(__builtin_amdgcn_perm(b[7], b[6], 0x0c0c0501u), __builtin_amdgcn_perm(b[5], b[4], 0x0c0c0501u), 0x05040100u);
                            *(u32x4*)(rowh + bj * HALF) = hw; *(u32x2*)(rowl + bj * HALF) = lw; }
                        xn[ai][m][bj][0] = t0; xn[ai][m][bj][1] = t1;
                        ss += ((t0[0] * t0[0] + t0[1] * t0[1]) + (t0[2] * t0[2] + t0[3] * t0[3])) + ((t1[0] * t1[0] + t1[1] * t1[1]) + (t1[2] * t1[2] + t1[3] * t1[3])); }
                    ss += xor_lane<16>(ss); ss = half_sum(ss);
                    if (fq == 0) atomic_add_f32(ssq + row, ss);
                    asm volatile("" ::: "memory"); }
            f32x4 gm[2][2], sh[2][2];
#pragma unroll
            for (int bj = 0; bj < 2; ++bj)
#pragma unroll
                for (int n = 0; n < 2; ++n) { const int c = col0 + bj * HALF + n * 4; const f32x4 gw = *(const f32x4*)(g + c);
                    if (fin) { gm[bj][n] = gw; sh[bj][n] = (f32x4){0.f, 0.f, 0.f, 0.f}; }
                    else { gm[bj][n] = gw * (*(const f32x4*)(shift + (size_t)mr * MODLD + D + c) + 1.0f); sh[bj][n] = *(const f32x4*)(shift + (size_t)mr * MODLD + c); } }
            asm volatile("s_waitcnt vmcnt(0)" ::: "memory");
            if (lane_id() == 0) (void)xb_add(cnt, 1u);
            { unsigned sp = 0; unsigned* tmo = (unsigned*)(ws + WS_CTL) + CW_BAR + XB_TMO;
              while ((unsigned)__builtin_amdgcn_readfirstlane((int)xb_ld(cnt)) < 64u) { __builtin_amdgcn_s_sleep(2);
                  if ((++sp & 255u) == 0u) { if (xb_ld(tmo)) break; if (sp > XB_SPIN_CAP) { atomicAdd(tmo, 1u); break; } } } }
            float rs[2][4];
#pragma unroll
            for (int ai = 0; ai < 2; ++ai)
#pragma unroll
                for (int m = 0; m < 4; ++m) rs[ai][m] = __hip_atomic_load(ssq + row0 + ai * HALF + m * 16, __ATOMIC_RELAXED, __HIP_MEMORY_SCOPE_AGENT);
#pragma unroll
            for (int ai = 0; ai < 2; ++ai)
#pragma unroll
                for (int m = 0; m < 4; ++m) { const int row = row0 + ai * HALF + m * 16; const float rstd = 1.0f / sqrtf(rs[ai][m] * (1.0f / D) + NORM_EPS);
#pragma unroll
                    for (int bj = 0; bj < 2; ++bj) { const f32x4 y0 = xn[ai][m][bj][0] * rstd * gm[bj][0] + sh[bj][0], y1 = xn[ai][m][bj][1] * rstd * gm[bj][1] + sh[bj][1];
                        if (fin) { float* o = out + (size_t)row * D + col0 + bj * HALF; *(f32x4*)o = y0; *(f32x4*)(o + 4) = y1; }
                        else { u32x4 w; w.x = cvt_pk_bf16(y0[0], y0[1]); w.y = cvt_pk_bf16(y0[2], y0[3]); w.z = cvt_pk_bf16(y1[0], y1[1]); w.w = cvt_pk_bf16(y1[2], y1[3]);
                            *(u32x4*)((bf16_t*)(ws + WS_H) + (size_t)row * LDH + col0 + bj * HALF) = w; } }
                    asm volatile("" ::: "memory"); }
        } else {
            float* pb = (float*)(ws + WS_PART) + (size_t)(u.aux - 1) * MC * LDX;
#pragma unroll
            for (int ai = 0; ai < 2; ++ai)
#pragma unroll
                for (int m = 0; m < 4; ++m) { float* rowp = pb + (size_t)(row0 + ai * HALF + m * 16 - ML) * LDX + col0;
#pragma unroll
                    for (int bj = 0; bj < 2; ++bj)
#pragma unroll
                        for (int n = 0; n < 2; ++n) *(f32x4*)(rowp + bj * HALF + n * 4) = gv[bj][n] * acc[ai][bj][m][n]; }
        }
    }
};

struct ProjCtx { unsigned char* ws; int l; int probe; LAS unsigned char* lds; };
template <class T> __device__ __forceinline__ T* pws(const ProjCtx& c, size_t off) { return (T*)(c.ws + off); }
template <int LD, bool SSQ, bool RS, bool ACT, bool ROPE, int NCOPY>
__device__ __forceinline__ void proj_group(const f32x4 (&acc)[2][2][4][2], const int bj, bf16_t* p0, const float cs, float* ssq_out, const float* ssq_in, const float inv_n,
                                           const int rk, const int row0, const int fq, const LAS unsigned char* ldsb) {
    float sqv[2][4];
    if constexpr (RS) {
#pragma unroll
        for (int ai = 0; ai < 2; ++ai)
#pragma unroll
            for (int m = 0; m < 4; ++m) sqv[ai][m] = ssq_in[ai * HALF + m * 16];
    }
#pragma unroll
    for (int ai = 0; ai < 2; ++ai)
#pragma unroll
        for (int m = 0; m < 4; ++m) {
            const int ro = ai * HALF + m * 16;
            f32x4 v0 = acc[ai][bj][m][0], v1 = acc[ai][bj][m][1];
            if constexpr (SSQ) {
                float ss = (v0[0] * v0[0] + v0[1] * v0[1]) + (v0[2] * v0[2] + v0[3] * v0[3]) + (v1[0] * v1[0] + v1[1] * v1[1]) + (v1[2] * v1[2] + v1[3] * v1[3]);
                ss += xor_lane<16>(ss); ss = half_sum(ss);
                if (fq == 0) atomic_add_f32(ssq_out + ro, ss);
            }
            if constexpr (RS) { const float rs = cs * (1.0f / sqrtf(sqv[ai][m] * inv_n + NORM_EPS)); v0 = v0 * rs; v1 = v1 * rs; }
            else if constexpr (!SSQ && !ACT) { v0 = v0 * cs; v1 = v1 * cs; }
            if constexpr (ACT) {
#pragma unroll
                for (int e = 0; e < 4; ++e) { v0[e] = sigmoid_f(v0[e]); v1[e] = sigmoid_f(v1[e]); }
            }
            if constexpr (ROPE) {
                if (rk != 0) {
                    const int t = (row0 + ro) & (SEQ - 1), pos = (rk == 1) ? (t >> 6) : (t & 63);
                    const LAS float* tb = (const LAS float*)(ldsb + ROPE_LDS) + pos * 16 + 8 * (fq & 1);
                    const f32x4 c0 = *(const LAS f32x4*)tb, c1 = *(const LAS f32x4*)(tb + 4), s0 = *(const LAS f32x4*)(tb + 1024), s1 = *(const LAS f32x4*)(tb + 1028);
                    const bool lowh = fq < 2;
#pragma unroll
                    for (int e = 0; e < 4; ++e) {
                        { const float f = v0[e]; const unsigned w = __builtin_bit_cast(unsigned, f); auto rr = __builtin_amdgcn_permlane32_swap(w, w, false, false);
                          const float x1 = __builtin_bit_cast(float, (unsigned)rr[0]), x2 = __builtin_bit_cast(float, (unsigned)rr[1]);
                          v0[e] = lowh ? x1 * c0[e] - x2 * s0[e] : x1 * s0[e] + x2 * c0[e]; }
                        { const float f = v1[e]; const unsigned w = __builtin_bit_cast(unsigned, f); auto rr = __builtin_amdgcn_permlane32_swap(w, w, false, false);
                          const float x1 = __builtin_bit_cast(float, (unsigned)rr[0]), x2 = __builtin_bit_cast(float, (unsigned)rr[1]);
                          v1[e] = lowh ? x1 * c1[e] - x2 * s1[e] : x1 * s1[e] + x2 * c1[e]; }
                    }
                }
            }
            if constexpr (ACT) {
                unsigned g0 = 0u, g1 = 0u;
                g0 = __builtin_amdgcn_cvt_pk_u8_f32(__builtin_rintf(v0[0] * 255.0f), 0, g0); g0 = __builtin_amdgcn_cvt_pk_u8_f32(__builtin_rintf(v0[1] * 255.0f), 1, g0); g0 = __builtin_amdgcn_cvt_pk_u8_f32(__builtin_rintf(v0[2] * 255.0f), 2, g0); g0 = __builtin_amdgcn_cvt_pk_u8_f32(__builtin_rintf(v0[3] * 255.0f), 3, g0);
                g1 = __builtin_amdgcn_cvt_pk_u8_f32(__builtin_rintf(v1[0] * 255.0f), 0, g1); g1 = __builtin_amdgcn_cvt_pk_u8_f32(__builtin_rintf(v1[1] * 255.0f), 1, g1); g1 = __builtin_amdgcn_cvt_pk_u8_f32(__builtin_rintf(v1[2] * 255.0f), 2, g1); g1 = __builtin_amdgcn_cvt_pk_u8_f32(__builtin_rintf(v1[3] * 255.0f), 3, g1);
                u32x2 w; w.x = g0; w.y = g1;
                *(u32x2*)((unsigned char*)p0 + (size_t)ro * LD) = w;
            } else {
            u32x4 w; w.x = cvt_pk_bf16(v0[0], v0[1]); w.y = cvt_pk_bf16(v0[2], v0[3]); w.z = cvt_pk_bf16(v1[0], v1[1]); w.w = cvt_pk_bf16(v1[2], v1[3]);
            bf16_t* p = p0 + (size_t)ro * LD;
#pragma unroll
            for (int cp = 0; cp < NCOPY; ++cp) *(u32x4*)(p + cp * 192) = w;
            }
        }
}
template <int KIND> struct EpiProj {
    static constexpr bool PERM = true;
    ProjCtx c;
    __device__ __forceinline__ void operator()(const f32x4 (&acc)[2][2][4][2], const Unit& u, int wr, int wc, int fr, int fq) const {
        const int row0 = u.pm * BM + wr * 64 + fr, lc = wc * 32 + 8 * fq;
        const LAS unsigned char* tab = c.lds;
        if constexpr (KIND == 0) {
            if (u.pn >= 17) {
#pragma unroll
                for (int bj = 0; bj < 2; ++bj) proj_group<256, false, false, true, false, 1>(acc, bj, (bf16_t*)(pws<unsigned char>(c, WS_G) + ((size_t)(u.pm * 24 + u.pn - 17) << 16) + (row0 & 255) * 256 + bj * 128 + lc), 1.f, nullptr, nullptr, 0.f, 0, row0, fq, tab);
            } else if (u.pn < 6) {
                bf16_t* base = pws<bf16_t>(c, u.pn < 3 ? WS_NAQ : WS_NAK) + (size_t)row0 * 768 + (u.pn < 3 ? u.pn : u.pn - 3) * 256 + lc;
                const float cs = u.pn < 3 ? NA_SCALE * LOG2E : 1.f;
#pragma unroll
                for (int bj = 0; bj < 2; ++bj) proj_group<768, false, false, false, false, 1>(acc, bj, base + bj * 128, cs, nullptr, nullptr, 0.f, 0, row0, fq, tab);
            } else if (u.pn < 9) {
                bf16_t* base = pws<bf16_t>(c, WS_CQ) + (size_t)row0 * 768 + (u.pn - 6) * 256 + lc; float* sq = (c.probe ? pws<float>(c, WS_PART) : pws<float>(c, WS_SSQ) + (size_t)(2 * c.l) * M) + row0;
#pragma unroll
                for (int bj = 0; bj < 2; ++bj) proj_group<768, true, false, false, false, 1>(acc, bj, base + bj * 128, 1.f, sq, nullptr, 0.f, 0, row0, fq, tab);
            } else if (u.pn < 11) {
                bf16_t* base = pws<bf16_t>(c, WS_CKV) + (size_t)row0 * 512 + (u.pn - 9) * 256 + lc; float* sq = (c.probe ? pws<float>(c, WS_PART) : pws<float>(c, WS_SSQ) + (size_t)(2 * c.l + 1) * M) + row0;
#pragma unroll
                for (int bj = 0; bj < 2; ++bj) proj_group<512, true, false, false, false, 1>(acc, bj, base + bj * 128, 1.f, sq, nullptr, 0.f, 0, row0, fq, tab);
            } else if (u.pn < 16) {
                const int rk = row0 < ML ? 1 + (wc & 1) : 0;
#pragma unroll
                for (int bj = 0; bj < 2; ++bj) { const int g = 2 * u.pn + bj; const bool q = g < 27;
                    bf16_t* p0 = pws<bf16_t>(c, q ? WS_DQ : WS_DK) + (size_t)row0 * 640 + (q ? g - 22 : g - 27) * 128 + lc;
                    proj_group<640, false, false, false, true, 1>(acc, bj, p0, q ? DF_SCALE * LOG2E : 1.f, nullptr, nullptr, 0.f, rk, row0, fq, tab); }
            } else {
                if (wc < 2) proj_group<960, false, false, false, true, 5>(acc, 0, pws<bf16_t>(c, WS_MK) + (size_t)row0 * 960 + 128 + lc, 1.f, nullptr, nullptr, 0.f, row0 < ML ? 1 + (wc & 1) : 0, row0, fq, tab);
            }
        } else if constexpr (KIND == 1) {
            const float* sq = pws<float>(c, WS_SSQ) + (size_t)(2 * c.l) * M + row0;
#pragma unroll
            for (int bj = 0; bj < 2; ++bj) { const int g = 2 * u.pn + bj, b32 = 4 * g + wc, bb = b32 % 6;
                if (b32 >= 30) continue;
                bf16_t* p0 = pws<bf16_t>(c, WS_MQ) + (size_t)row0 * 960 + g * 128 + lc;
                if (bb >= 4) proj_group<960, false, true, false, true, 1>(acc, bj, p0, MLA_SCALE * LOG2E, nullptr, sq, 1.0f / 768.0f, row0 < ML ? bb - 3 : 0, row0, fq, tab);
                else proj_group<960, false, true, false, false, 1>(acc, bj, p0, MLA_SCALE * LOG2E, nullptr, sq, 1.0f / 768.0f, 0, row0, fq, tab); }
        } else {
            const float* sq = pws<float>(c, WS_SSQ) + (size_t)(2 * c.l + 1) * M + row0;
#pragma unroll
            for (int bj = 0; bj < 2; ++bj) { const int g = 2 * u.pn + bj; if (g >= 5) continue;
                proj_group<960, false, true, false, false, 1>(acc, bj, pws<bf16_t>(c, WS_MK) + (size_t)row0 * 960 + g * 192 + lc, 1.f, nullptr, sq, 1.0f / 512.0f, 0, row0, fq, tab); }
        }
    }
};

template <int KIND> struct EpiVT {
    static constexpr bool PERM = true;
    bf16_t* VT; const float* ssq;
    __device__ __forceinline__ void operator()(const f32x4 (&acc)[2][2][4][2], const Unit& u, int wr, int wc, int fr, int fq) const {
        const int ch0 = u.pm * BM + wr * 64 + fr, tok0 = u.pn * BM + wc * 32 + 8 * fq;
        constexpr int NCH = KIND == 0 ? 1408 : 640;
        f32x4 sc[2][2];
#pragma unroll
        for (int bj = 0; bj < 2; ++bj)
#pragma unroll
            for (int n = 0; n < 2; ++n) {
                if constexpr (KIND == 1) { const f32x4 s = *(const f32x4*)(ssq + tok0 + bj * HALF + 4 * n);
#pragma unroll
                    for (int e = 0; e < 4; ++e) sc[bj][n][e] = 1.0f / sqrtf(s[e] * (1.0f / 512.0f) + NORM_EPS); }
                else sc[bj][n] = (f32x4){1.f, 1.f, 1.f, 1.f};
            }
#pragma unroll
        for (int ai = 0; ai < 2; ++ai)
#pragma unroll
            for (int m = 0; m < 4; ++m) { const int ch = ch0 + ai * HALF + m * 16; if (ch >= NCH) continue;
                bf16_t* rowp = VT + (size_t)ch * M + tok0;
#pragma unroll
                for (int bj = 0; bj < 2; ++bj) { const f32x4 v0 = acc[ai][bj][m][0] * sc[bj][0], v1 = acc[ai][bj][m][1] * sc[bj][1];
                    u32x4 w; w.x = cvt_pk_bf16(v0[0], v0[1]); w.y = cvt_pk_bf16(v0[2], v0[3]); w.z = cvt_pk_bf16(v1[0], v1[1]); w.w = cvt_pk_bf16(v1[2], v1[3]);
                    *(u32x4*)(rowp + bj * HALF) = w; } }
    }
};

struct EpiMerge {
    static constexpr bool PERM = true;
    unsigned char* ws;
    __device__ __forceinline__ void operator()(const f32x4 (&acc)[2][2][4][2], const Unit& u, int wr, int wc, int fr, int fq) const {
        const int row0 = u.pm * BM + wr * 64 + fr, col0 = u.pn * BM + wc * 32 + 8 * fq, br = u.aux & 3; const bool atom = u.aux >= 4;
        const bf16_t* G = (const bf16_t*)(ws + WS_G); bf16_t* Y = (bf16_t*)(ws + WS_Y);
#pragma unroll
        for (int ai = 0; ai < 2; ++ai)
#pragma unroll
            for (int m = 0; m < 4; ++m) { const int row = row0 + ai * HALF + m * 16;
#pragma unroll
                for (int bj = 0; bj < 2; ++bj) { const int col = col0 + bj * HALF;
                    const u32x2 gw = *(const u32x2*)((const unsigned char*)G + ((size_t)(u.pm * 24 + br * 8 + u.pn) << 16) + (row & 255) * 256 + (col & 255));
                    f32x4 v0 = acc[ai][bj][m][0] * (1.0f / 255.0f), v1 = acc[ai][bj][m][1] * (1.0f / 255.0f);
                    v0[0] *= (float)(gw.x & 0xffu); v0[1] *= (float)((gw.x >> 8) & 0xffu); v0[2] *= (float)((gw.x >> 16) & 0xffu); v0[3] *= (float)(gw.x >> 24);
                    v1[0] *= (float)(gw.y & 0xffu); v1[1] *= (float)((gw.y >> 8) & 0xffu); v1[2] *= (float)((gw.y >> 16) & 0xffu); v1[3] *= (float)(gw.y >> 24);
                    bf16_t* yp = Y + (size_t)row * D + col;
                    if (!atom && br != 0) { const u32x4 yw = *(const u32x4*)yp;
                        v0[0] += bflo(yw.x); v0[1] += bfhi(yw.x); v0[2] += bflo(yw.y); v0[3] += bfhi(yw.y);
                        v1[0] += bflo(yw.z); v1[1] += bfhi(yw.z); v1[2] += bflo(yw.w); v1[3] += bfhi(yw.w); }
                    const unsigned a0 = cvt_pk_bf16(v0[0], v0[1]), a1 = cvt_pk_bf16(v0[2], v0[3]), a2 = cvt_pk_bf16(v1[0], v1[1]), a3 = cvt_pk_bf16(v1[2], v1[3]);
                    if (!atom) { u32x4 w; w.x = a0; w.y = a1; w.z = a2; w.w = a3; *(u32x4*)yp = w; }
                    else { typedef short s16x2 __attribute__((ext_vector_type(2))); GAS s16x2* ap = (GAS s16x2*)yp;
                        s16x2 b0 = __builtin_bit_cast(s16x2, a0), b1 = __builtin_bit_cast(s16x2, a1), b2 = __builtin_bit_cast(s16x2, a2), b3 = __builtin_bit_cast(s16x2, a3);
                        __builtin_amdgcn_global_atomic_fadd_v2bf16(ap, b0); __builtin_amdgcn_global_atomic_fadd_v2bf16(ap + 1, b1);
                        __builtin_amdgcn_global_atomic_fadd_v2bf16(ap + 2, b2); __builtin_amdgcn_global_atomic_fadd_v2bf16(ap + 3, b3); } }
                asm volatile("" ::: "memory"); }
    }
};
}
struct Frame {
    LAS unsigned char* lds;
    volatile LAS unsigned* MISC;
    gu32* ctl;
    unsigned char* ws;
    int wave, vcu, G;
};
struct Args { const float* in[20]; float* out; unsigned char* ws; int ph_lo, ph_hi; };
enum { I_X = 0, I_C, I_CTX, I_CCTX, I_WADA, I_BADA, I_NORMW, I_FFNIN, I_FFNOUT, I_WIN, I_RPB, I_QNORM, I_KVNORM, I_WUQ, I_WUKV, I_DLAM, I_SUBLN, I_WBR, I_WOUT, I_FNORM };
template <class T> __device__ __forceinline__ T* wsp(const Frame& F, size_t off) { return (T*)(F.ws + off); }

__device__ __forceinline__ bf16_t* dest_row(const Frame& F, int mat, int li, int n) {
    switch (mat) {
    case 0: { const int half = n >= FF ? 1 : 0, jj = n - half * FF; return wsp<bf16_t>(F, WS_WFI + (size_t)li * WFI_SZ) + (size_t)(256 * (jj >> 7) + 128 * half + (jj & 127)) * D; }
    case 1: return wsp<bf16_t>(F, WS_WFO + (size_t)li * WFO_SZ) + (size_t)n * FF;
    case 2: { bf16_t* win = wsp<bf16_t>(F, WS_WIN + (size_t)li * WIN_SZ); bf16_t* wvt = wsp<bf16_t>(F, WS_WVT + (size_t)li * WVT_SZ);
        if (n < 1536) return win + (size_t)n * D;
        if (n < 2304) return wvt + (size_t)(n - 1536) * D;
        if (n < 3584) return win + (size_t)(n - 2304 + 1536) * D;
        if (n < 3648) return win + (size_t)(n - 3584 + 4096) * D;
        if (n < 4928) return win + (size_t)(n - 3648 + 2816) * D;
        if (n < 5568) return wvt + (size_t)(n - 4928 + 768) * D;
        return win + (size_t)(n - 5568 + 4352) * D; }
    case 3: return wsp<bf16_t>(F, WS_WUQ + (size_t)li * WUQ_SZ) + (size_t)n * 768;
    case 4: { const int h = n >> 8, r = n & 255; return r < 128 ? wsp<bf16_t>(F, WS_WUK + (size_t)li * WUK_SZ) + (size_t)(h * 128 + r) * 512 : wsp<bf16_t>(F, WS_WUV + (size_t)li * WUK_SZ) + (size_t)(h * 128 + r - 128) * 512; }
    case 5: return wsp<bf16_t>(F, WS_WBR + (size_t)li * WSQ_SZ) + (size_t)n * D;
    default: return wsp<bf16_t>(F, WS_WO + (size_t)li * WSQ_SZ) + (size_t)n * D;
    }
}
__device__ __forceinline__ void transpose_item(const Frame& F, const float* W, int N, const float* gk, int mat, int li, LAS float* scr, int kb, int nb, int lane) {
    const int k0 = 64 * kb, n0 = 32 * nb, kr = lane >> 3, c4 = 4 * (lane & 7);
    f32x4 v[8];
#pragma unroll
    for (int i = 0; i < 8; ++i) v[i] = *(const f32x4*)(W + (size_t)(k0 + 8 * i + kr) * N + n0 + c4);
#pragma unroll
    for (int i = 0; i < 8; ++i) { const int kk = 8 * i + kr; f32x4 x = v[i]; if (gk) x = x * gk[k0 + kk];
        LAS float* d = scr + kk * 33 + c4; d[0] = x[0]; d[1] = x[1]; d[2] = x[2]; d[3] = x[3]; }
    LDS_WAIT(); asm volatile("" ::: "memory");
    const int c = lane & 7;
#pragma unroll
    for (int j = 0; j < 4; ++j) { const int n = (lane >> 3) + 8 * j; const LAS float* s = scr + (8 * c) * 33 + n;
        u32x4 o; o.x = pk2(s[0 * 33], s[1 * 33]); o.y = pk2(s[2 * 33], s[3 * 33]); o.z = pk2(s[4 * 33], s[5 * 33]); o.w = pk2(s[6 * 33], s[7 * 33]);
        bf16_t* dr = dest_row(F, mat, li, n0 + n);
        *(GAS u32x4*)(dr + k0 + 8 * c) = o; }
    LDS_WAIT(); asm volatile("" ::: "memory");
}
__device__ __forceinline__ void zero_rows(bf16_t* p, size_t nelem, int gtid, int gthreads) {
    const u32x4 z = {0u, 0u, 0u, 0u};
    for (size_t i = (size_t)gtid; i < nelem / 8; i += gthreads) ((u32x4*)p)[i] = z;
}
constexpr int WCV_TAKE = 12;
namespace wcv {
constexpr int I_FI = (D / 64) * (2 * FF / 32), I_FO = (FF / 64) * (D / 32), I_IN = (D / 64) * (INW / 32), I_UQ = (768 / 64) * (960 / 32), I_UKV = (512 / 64) * (1280 / 32), I_SQ = (D / 64) * (D / 32);
constexpr int NH0 = I_FI + I_FO + I_IN + I_UQ + I_UKV, NH1 = I_FI + I_FO + 2 * I_SQ;
__host__ __device__ constexpr int nitems(int half) { return half == 0 ? NH0 : NH1; }
}
__device__ __forceinline__ void convert_item(const Frame& F, const Args& args, int L, int half, int j, LAS float* scr, int lane) {
    using namespace wcv;
    int r = j, mat, li = L, N, nbs; const float* W; const float* gk = nullptr;
    if (r < I_FI) { li = 2 * L + half; mat = 0; W = args.in[I_FFNIN] + (size_t)li * D * 2 * FF; N = 2 * FF; nbs = 2 * FF / 32; }
    else if (half == 0) {
        if ((r -= I_FI) < I_FO) { li = 2 * L; mat = 1; W = args.in[I_FFNOUT] + (size_t)li * FF * D; N = D; nbs = D / 32; }
        else if ((r -= I_FO) < I_IN) { mat = 2; W = args.in[I_WIN] + (size_t)L * D * INW; N = INW; nbs = INW / 32; }
        else if ((r -= I_IN) < I_UQ) { mat = 3; W = args.in[I_WUQ] + (size_t)L * 768 * 960; N = 960; nbs = 30; gk = args.in[I_QNORM] + L * 768; }
        else { r -= I_UQ; mat = 4; W = args.in[I_WUKV] + (size_t)L * 512 * 1280; N = 1280; nbs = 40; gk = args.in[I_KVNORM] + L * 512; }
    } else {
        if ((r -= I_FI) < I_SQ) { mat = 5; W = args.in[I_WBR] + (size_t)L * D * D; N = D; nbs = 64; }
        else if ((r -= I_SQ) < I_SQ) { mat = 6; W = args.in[I_WOUT] + (size_t)L * D * D; N = D; nbs = 64; }
        else { r -= I_SQ; li = 2 * L + 1; mat = 1; W = args.in[I_FFNOUT] + (size_t)li * FF * D; N = D; nbs = D / 32; }
    }
    transpose_item(F, W, N, gk, mat, li, scr, r / nbs, r % nbs, lane);
}
struct CvItem { const float* W; const float* gk; int N, mat, li, kb, nb; };
__device__ __forceinline__ CvItem convert_decode(const Args& args, int L, int half, int j) {
    using namespace wcv;
    int r = j, mat, li = L, N, nbs; const float* W; const float* gk = nullptr;
    if (r < I_FI) { li = 2 * L + half; mat = 0; W = args.in[I_FFNIN] + (size_t)li * D * 2 * FF; N = 2 * FF; nbs = 2 * FF / 32; }
    else if (half == 0) {
        if ((r -= I_FI) < I_FO) { li = 2 * L; mat = 1; W = args.in[I_FFNOUT] + (size_t)li * FF * D; N = D; nbs = D / 32; }
        else if ((r -= I_FO) < I_IN) { mat = 2; W = args.in[I_WIN] + (size_t)L * D * INW; N = INW; nbs = INW / 32; }
        else if ((r -= I_IN) < I_UQ) { mat = 3; W = args.in[I_WUQ] + (size_t)L * 768 * 960; N = 960; nbs = 30; gk = args.in[I_QNORM] + L * 768; }
        else { r -= I_UQ; mat = 4; W = args.in[I_WUKV] + (size_t)L * 512 * 1280; N = 1280; nbs = 40; gk = args.in[I_KVNORM] + L * 512; }
    } else {
        if ((r -= I_FI) < I_SQ) { mat = 5; W = args.in[I_WBR] + (size_t)L * D * D; N = D; nbs = 64; }
        else if ((r -= I_SQ) < I_SQ) { mat = 6; W = args.in[I_WOUT] + (size_t)L * D * D; N = D; nbs = 64; }
        else { r -= I_SQ; li = 2 * L + 1; mat = 1; W = args.in[I_FFNOUT] + (size_t)li * FF * D; N = D; nbs = D / 32; }
    }
    CvItem c; c.W = W; c.gk = gk; c.N = N; c.mat = mat; c.li = li; c.kb = r / nbs; c.nb = r % nbs; return c;
}
__device__ __forceinline__ void cv_load(const CvItem& c, int lane, f32x4 (&v)[8]) {
    const int k0 = 64 * c.kb, n0 = 32 * c.nb, kr = lane >> 3, c4 = 4 * (lane & 7);
#pragma unroll
    for (int i = 0; i < 8; ++i) v[i] = __builtin_nontemporal_load((const f32x4*)(c.W + (size_t)(k0 + 8 * i + kr) * c.N + n0 + c4));
}
__device__ __forceinline__ void cv_finish(const Frame& F, const CvItem& c, LAS float* scr, int lane, const f32x4 (&v)[8]) {
    const int k0 = 64 * c.kb, n0 = 32 * c.nb, kr = lane >> 3, c4 = 4 * (lane & 7);
#pragma unroll
    for (int i = 0; i < 8; ++i) { const int kk = 8 * i + kr; f32x4 x = v[i]; if (c.gk) x = x * c.gk[k0 + kk];
        LAS float* d = scr + kk * 33 + c4; d[0] = x[0]; d[1] = x[1]; d[2] = x[2]; d[3] = x[3]; }
    LDS_WAIT(); asm volatile("" ::: "memory");
    const int cc = lane & 7;
#pragma unroll
    for (int j = 0; j < 4; ++j) { const int n = (lane >> 3) + 8 * j; const LAS float* sp = scr + (8 * cc) * 33 + n;
        u32x4 o; o.x = pk2(sp[0 * 33], sp[1 * 33]); o.y = pk2(sp[2 * 33], sp[3 * 33]); o.z = pk2(sp[4 * 33], sp[5 * 33]); o.w = pk2(sp[6 * 33], sp[7 * 33]);
        bf16_t* dr = dest_row(F, c.mat, c.li, n0 + n);
        __builtin_nontemporal_store(o, (u32x4*)(dr + k0 + 8 * cc)); }
    LDS_WAIT(); asm volatile("" ::: "memory");
}
__device__ __forceinline__ void convert_fill(const Frame& F, const Args& args, int L, int half, gu32* ctr, int jlo, int jhi) {
    LAS float* scr = (LAS float*)(F.lds + RING_OFF + F.wave * 16384);
    const int lane = (tid_of(F.wave) & 63), x0 = (int)(xb_xcc_id() & 7u);
    const int NI = jhi - jlo, NLC = (NI + 7) / 8;
    unsigned long long live;
    { const int xl = lane & 7, lol = xl * NLC, nl = (lol + NLC <= NI) ? NLC : (NI - lol);
      const unsigned cv = __hip_atomic_load(ctr + 64 * xl, RLX_AGENT);
      live = __builtin_amdgcn_ballot_w64((int)cv < nl); }
    for (int k = 0; k < 8; ++k) {
        const int x = (x0 + k) & 7, lo = x * NLC, n = (lo + NLC <= NI) ? NLC : (NI - lo);
        if (!((live >> x) & 1ull)) continue;
        for (;;) {
            unsigned b = 0u;
            if (lane == 0) b = __hip_atomic_fetch_add(ctr + 64 * x, (unsigned)WCV_TAKE, RLX_AGENT);
            b = (unsigned)__builtin_amdgcn_readfirstlane((int)b);
            if ((int)b >= n) break;
            const int cnt = (n - (int)b < WCV_TAKE) ? n - (int)b : WCV_TAKE, j0 = jlo + lo + (int)b;
            f32x4 va[8], vb[8], vc[8];
            if (cnt == WCV_TAKE) {
                CvItem ca = convert_decode(args, L, half, j0), cb = convert_decode(args, L, half, j0 + 1), cc = ca;
                cv_load(ca, lane, va); cv_load(cb, lane, vb);
                int i = 0;
                for (; i + 5 < WCV_TAKE; i += 3) {
                    cc = convert_decode(args, L, half, j0 + i + 2); cv_load(cc, lane, vc); cv_finish(F, ca, scr, lane, va);
                    ca = convert_decode(args, L, half, j0 + i + 3); cv_load(ca, lane, va); cv_finish(F, cb, scr, lane, vb);
                    cb = convert_decode(args, L, half, j0 + i + 4); cv_load(cb, lane, vb); cv_finish(F, cc, scr, lane, vc);
                }
                cc = convert_decode(args, L, half, j0 + WCV_TAKE - 1); cv_load(cc, lane, vc);
                cv_finish(F, ca, scr, lane, va); cv_finish(F, cb, scr, lane, vb); cv_finish(F, cc, scr, lane, vc);
            } else {
                for (int i = 0; i < cnt; ++i) { const CvItem ca = convert_decode(args, L, half, j0 + i); cv_load(ca, lane, va); cv_finish(F, ca, scr, lane, va); }
            }
        }
    }
}
__device__ __forceinline__ void p0_prologue(Frame& F, const Args& args, bool with_mod) {
    LAS float* scr = (LAS float*)(F.lds + RING_OFF + F.wave * 16384);
    const int gw = F.vcu * NWAVES + F.wave, NGW = F.G * NWAVES, lane = (tid_of(F.wave) & 63);
    if (with_mod)
    {
        float* mod = wsp<float>(F, WS_MOD);
        LAS float* red = (LAS float*)(F.lds + RING_OFF);
        constexpr int NCH = MODLD / 256, NKG = D / 256, NGRP = DEPTH * NKG * NCH;
        const int tid = tid_of(F.wave);
        for (int gi = F.vcu; gi < NGRP; gi += F.G) {
            const int l = gi / (NKG * NCH), r = gi % (NKG * NCH), kg = r / NCH, cc = r % NCH, n = cc * 256 + 4 * lane, ks = kg * 8 + F.wave;
            f32x4 a0 = {0.f, 0.f, 0.f, 0.f}, a1 = a0, a2 = a0;
            const float* wp = args.in[I_WADA] + ((size_t)l * D + (size_t)ks * 32) * MODLD + n;
#pragma unroll 16
            for (int kk = 0; kk < 32; ++kk) { const int k = ks * 32 + kk; const f32x4 w = *(const f32x4*)(wp + (size_t)kk * MODLD);
                const float s0 = silu_f(args.in[I_C][k]), s1 = silu_f(args.in[I_C][D + k]), s2 = silu_f(args.in[I_CCTX][k]);
                a0 = a0 + w * s0; a1 = a1 + w * s1; a2 = a2 + w * s2; }
            LAS float* rw = red + F.wave * 768 + 4 * lane;
            *(LAS f32x4*)rw = a0; *(LAS f32x4*)(rw + 256) = a1; *(LAS f32x4*)(rw + 512) = a2;
            __syncthreads();
            for (int v = tid; v < 768; v += NTHREADS) {
                float sum = 0.f;
#pragma unroll
                for (int w = 0; w < NWAVES; ++w) sum += red[w * 768 + v];
                const int row = v >> 8, col = cc * 256 + (v & 255);
                if (kg == 0) sum += args.in[I_BADA][(size_t)l * MODLD + col];
                atomic_add_f32(mod + (size_t)l * 3 * MODLD + (size_t)row * MODLD + col, sum);
            }
            __syncthreads();
        }
    }
        for (int j = gw; j < wcv::NH0; j += NGW) convert_item(F, args, 0, 0, j, scr, lane);
    {
        const int gtid = (F.vcu * NWAVES + F.wave) * 64 + lane, gth = F.G * NTHREADS;
        for (int l = 0; l < DEPTH; ++l) {
            zero_rows(wsp<bf16_t>(F, WS_WIN + (size_t)l * WIN_SZ) + (size_t)4160 * D, (size_t)192 * D, gtid, gth);
            zero_rows(wsp<bf16_t>(F, WS_WVT + (size_t)l * WVT_SZ) + (size_t)1408 * D, (size_t)128 * D, gtid, gth);
            zero_rows(wsp<bf16_t>(F, WS_WUQ + (size_t)l * WUQ_SZ) + (size_t)960 * 768, (size_t)64 * 768, gtid, gth);
            zero_rows(wsp<bf16_t>(F, WS_WUK + (size_t)l * WUK_SZ) + (size_t)640 * 512, (size_t)128 * 512, gtid, gth);
            zero_rows(wsp<bf16_t>(F, WS_WUV + (size_t)l * WUK_SZ) + (size_t)640 * 512, (size_t)128 * 512, gtid, gth);
        }
    }
}

__device__ __forceinline__ void norm_mod_phase(Frame& F, const float* g, const float* shift0, const float* scale0, int row_lo, int nrows, int nsplit, const float* xin_lat = nullptr, const float* xin_ctx = nullptr) {
    const int gw = F.vcu * NWAVES + F.wave, NGW = F.G * NWAVES, lane = (tid_of(F.wave) & 63);
    float* xs = wsp<float>(F, WS_XS); bf16_t* H = wsp<bf16_t>(F, WS_H);
    for (int m = row_lo + gw; m < nrows; m += NGW) {
        const int mr = m < SEQ ? 0 : (m < ML ? 1 : 2);
        const f32x4* xr = (const f32x4*)(xin_lat ? (m < ML ? xin_lat + (size_t)m * D : xin_ctx + (size_t)(m - ML) * D) : xs + (size_t)m * LDX) + lane;
        const f32x4* g4 = (const f32x4*)g + lane; const f32x4* sh4 = (const f32x4*)(shift0 + (size_t)mr * MODLD) + lane; const f32x4* sc4 = (const f32x4*)(scale0 + (size_t)mr * MODLD) + lane;
        f32x4 v[8], gv[8], shv[8], scv[8]; float s = 0.f;
#pragma unroll
        for (int j = 0; j < 8; ++j) v[j] = xr[64 * j];
#pragma unroll
        for (int j = 0; j < 8; ++j) { gv[j] = g4[64 * j]; shv[j] = sh4[64 * j]; scv[j] = sc4[64 * j]; }
        if (m >= ML && (nsplit > 0 || xin_lat)) {
            const f32x4* pr = (const f32x4*)(wsp<float>(F, WS_PART) + (size_t)(m - ML) * LDX) + lane;
            for (int sp = 0; sp < nsplit; ++sp) {
#pragma unroll
                for (int j = 0; j < 8; ++j) v[j] = v[j] + pr[(size_t)sp * (MC * LDX / 4) + 64 * j]; }
            f32x4* xw = (f32x4*)(xs + (size_t)m * LDX) + lane;
#pragma unroll
            for (int j = 0; j < 8; ++j) xw[64 * j] = v[j];
        }
#pragma unroll
        for (int j = 0; j < 8; ++j) s += (v[j][0] * v[j][0] + v[j][1] * v[j][1]) + (v[j][2] * v[j][2] + v[j][3] * v[j][3]);
        const float rstd = 1.0f / sqrtf(wave_sum(s) * (1.0f / D) + NORM_EPS);
        u32x2* o8 = (u32x2*)(H + (size_t)m * LDH) + lane;
#pragma unroll
        for (int j = 0; j < 8; ++j) { const f32x4 gg = gv[j], sh = shv[j], sc = scv[j];
            const f32x4 y = v[j] * rstd * gg * (sc + 1.0f) + sh;
            u32x2 w; w.x = pk2(y[0], y[1]); w.y = pk2(y[2], y[3]); o8[64 * j] = w; }
    }
}
template <int NSPLIT>
__device__ __forceinline__ void ctx_norm_phase(Frame& F, const float* g, const float* shift0, const float* scale0) {
    const int lane = (tid_of(F.wave) & 63), q = F.wave & 3, col = 512 * q + 4 * lane;
    LAS float* red = (LAS float*)(F.lds + RING_OFF);
    float* xs = wsp<float>(F, WS_XS); bf16_t* H = wsp<bf16_t>(F, WS_H);
    for (int r0 = 2 * F.vcu; r0 < MC; r0 += 2 * F.G) {
        const int rc = r0 + (F.wave >> 2), m = ML + rc;
        float* xr = xs + (size_t)m * LDX + col; const float* pr = wsp<float>(F, WS_PART) + (size_t)rc * LDX + col;
        f32x4 v0 = *(const f32x4*)xr, v1 = *(const f32x4*)(xr + 256), p0[NSPLIT], p1[NSPLIT];
#pragma unroll
        for (int sp = 0; sp < NSPLIT; ++sp) { p0[sp] = *(const f32x4*)(pr + (size_t)sp * MC * LDX); p1[sp] = *(const f32x4*)(pr + (size_t)sp * MC * LDX + 256); }
        const f32x4 g0 = *(const f32x4*)(g + col), g1 = *(const f32x4*)(g + col + 256);
        const f32x4 sh0 = *(const f32x4*)(shift0 + (size_t)2 * MODLD + col), sh1 = *(const f32x4*)(shift0 + (size_t)2 * MODLD + col + 256);
        const f32x4 sc0 = *(const f32x4*)(scale0 + (size_t)2 * MODLD + col), sc1 = *(const f32x4*)(scale0 + (size_t)2 * MODLD + col + 256);
#pragma unroll
        for (int sp = 0; sp < NSPLIT; ++sp) { v0 = v0 + p0[sp]; v1 = v1 + p1[sp]; }
        *(f32x4*)xr = v0; *(f32x4*)(xr + 256) = v1;
        const float ssum = wave_sum(((v0[0] * v0[0] + v0[1] * v0[1]) + (v0[2] * v0[2] + v0[3] * v0[3])) + ((v1[0] * v1[0] + v1[1] * v1[1]) + (v1[2] * v1[2] + v1[3] * v1[3])));
        if (lane == 0) red[F.wave] = ssum;
        __syncthreads();
        const int wb = F.wave & 4;
        const float rstd = 1.0f / sqrtf(((red[wb] + red[wb + 1]) + (red[wb + 2] + red[wb + 3])) * (1.0f / D) + NORM_EPS);
        const f32x4 y0 = v0 * rstd * g0 * (sc0 + 1.0f) + sh0, y1 = v1 * rstd * g1 * (sc1 + 1.0f) + sh1;
        u32x2 w0, w1; w0.x = pk2(y0[0], y0[1]); w0.y = pk2(y0[2], y0[3]); w1.x = pk2(y1[0], y1[1]); w1.y = pk2(y1[2], y1[3]);
        *(u32x2*)(H + (size_t)m * LDH + col) = w0; *(u32x2*)(H + (size_t)m * LDH + col + 256) = w1;
        __syncthreads();
    }
}
struct AttnCtx {
    const bf16_t *naq, *nak, *dq, *dk, *mq, *mk, *vtin, *vtm; bf16_t* omix;
    const float* rpb;
    const float* subln;
    float lam, one_m_li;
};
constexpr int ANQ = 4;
template <int TYPE>
__device__ __forceinline__ void attn_naive_task(const AttnCtx& A, LAS float* Qs, LAS float* Ps, int lane, int b, int h, int qrow0  , bool is_ctx) {
    constexpr int DQ = TYPE == 1 ? 192 : 128;
    constexpr int NS = TYPE == 2 ? 2 : 1;
    const bf16_t* Q; const bf16_t* K; const bf16_t* VT; int ldq, ocol;
    if (TYPE == 0) { Q = A.naq + h * 128; K = A.nak + h * 128; ldq = 768; VT = A.vtin + (size_t)(h * 128) * M; ocol = h * 128; }
    else if (TYPE == 1) { Q = A.mq + h * 192; K = A.mk + h * 192; ldq = 960; VT = A.vtm + (size_t)(h * 128) * M; ocol = 768 + h * 128; }
    else { Q = A.dq + h * 128; K = A.dk + h * 128; ldq = 640; VT = A.vtin + (size_t)(768 + h * 128) * M; ocol = 1408 + h * 128; }
#pragma unroll
    for (int q = 0; q < ANQ; ++q)
#pragma unroll
        for (int d = lane; d < DQ; d += 64) Qs[q * 192 + d] = bf2f(Q[(size_t)(qrow0 + q) * ldq + d]);
    LDS_WAIT(); __builtin_amdgcn_wave_barrier(); asm volatile("" ::: "memory");
    const int t_in = qrow0 & (SEQ - 1), gr = t_in >> 6, qc0 = t_in & 63;
    int r0 = gr - 4; r0 = r0 < 0 ? 0 : (r0 > 56 ? 56 : r0);
    const int nlat = is_ctx ? 0 : (TYPE == 0 ? 8 : 64), ntiles = 4 + nlat;
    float mrun[NS][ANQ], lrun[NS][ANQ], o[NS][ANQ][2];
#pragma unroll
    for (int s = 0; s < NS; ++s)
#pragma unroll
        for (int q = 0; q < ANQ; ++q) { mrun[s][q] = -1e30f; lrun[s][q] = 0.f; o[s][q][0] = 0.f; o[s][q][1] = 0.f; }
    for (int ti = 0; ti < ntiles; ++ti) {
        int tok0, kr = 0; bool local = false;
        if (ti < 4) tok0 = ML + b * CTXL + 64 * ti;
        else if (TYPE == 0) { kr = r0 + (ti - 4); tok0 = b * SEQ + 64 * kr; local = true; }
        else tok0 = b * SEQ + 64 * (ti - 4);
        float s[NS][ANQ];
#pragma unroll
        for (int ss = 0; ss < NS; ++ss)
#pragma unroll
            for (int q = 0; q < ANQ; ++q) s[ss][q] = 0.f;
        const bf16_t* kp = K + (size_t)(tok0 + lane) * ldq;
#pragma unroll 1
        for (int c8 = 0; c8 < DQ / 8; ++c8) {
            const u32x4 kw = *(const u32x4*)(kp + 8 * c8);
            const float k0 = bflo(kw.x), k1 = bfhi(kw.x), k2 = bflo(kw.y), k3 = bfhi(kw.y), k4 = bflo(kw.z), k5 = bfhi(kw.z), k6 = bflo(kw.w), k7 = bfhi(kw.w);
            const int ss = (TYPE == 2 && c8 >= 8) ? 1 : 0;
#pragma unroll
            for (int q = 0; q < ANQ; ++q) { const f32x4 qa = *(const LAS f32x4*)(Qs + q * 192 + 8 * c8), qb = *(const LAS f32x4*)(Qs + q * 192 + 8 * c8 + 4);
                const float dsum = (qa[0] * k0 + qa[1] * k1) + (qa[2] * k2 + qa[3] * k3) + (qb[0] * k4 + qb[1] * k5) + (qb[2] * k6 + qb[3] * k7);
                if (NS == 2) { if (ss == 0) s[0][q] += dsum; else s[NS - 1][q] += dsum; } else s[0][q] += dsum; }
        }
        if (TYPE == 0 && local) {
#pragma unroll
            for (int q = 0; q < ANQ; ++q) { const int qc = qc0 + q; int c0 = qc - 8; c0 = c0 < 0 ? 0 : (c0 > 48 ? 48 : c0);
                const bool ok = lane >= c0 && lane < c0 + 16;
                int co = lane - qc; co = co < -15 ? -15 : (co > 15 ? 15 : co);
                const float bias = A.rpb[(h * 15 + (kr - gr + 7)) * 31 + co + 15] * LOG2E;
                s[0][q] = ok ? s[0][q] + bias : -1e30f; }
        }
#pragma unroll
        for (int ss = 0; ss < NS; ++ss)
#pragma unroll
            for (int q = 0; q < ANQ; ++q) {
                const float tm = wave_max(s[ss][q]); const float mn = fmaxf(mrun[ss][q], tm); const float alpha = fast_exp2(mrun[ss][q] - mn);
                const float p = fast_exp2(s[ss][q] - mn); lrun[ss][q] = lrun[ss][q] * alpha + wave_sum(p); mrun[ss][q] = mn;
                o[ss][q][0] *= alpha; o[ss][q][1] *= alpha;
                Ps[(ss * ANQ + q) * 64 + lane] = p; }
        LDS_WAIT(); __builtin_amdgcn_wave_barrier(); asm volatile("" ::: "memory");
        const bf16_t* v0p = VT + (size_t)(2 * lane) * M + tok0; const bf16_t* v1p = v0p + M;
#pragma unroll 1
        for (int jc = 0; jc < 8; ++jc) {
            const u32x4 a = *(const u32x4*)(v0p + 8 * jc), bq = *(const u32x4*)(v1p + 8 * jc);
            const float va[8] = {bflo(a.x), bfhi(a.x), bflo(a.y), bfhi(a.y), bflo(a.z), bfhi(a.z), bflo(a.w), bfhi(a.w)};
            const float vb[8] = {bflo(bq.x), bfhi(bq.x), bflo(bq.y), bfhi(bq.y), bflo(bq.z), bfhi(bq.z), bflo(bq.w), bfhi(bq.w)};
#pragma unroll
            for (int ss = 0; ss < NS; ++ss)
#pragma unroll
                for (int q = 0; q < ANQ; ++q) { const f32x4 pa = *(const LAS f32x4*)(Ps + (ss * ANQ + q) * 64 + 8 * jc), pb = *(const LAS f32x4*)(Ps + (ss * ANQ + q) * 64 + 8 * jc + 4);
                    o[ss][q][0] += (pa[0] * va[0] + pa[1] * va[1]) + (pa[2] * va[2] + pa[3] * va[3]) + (pb[0] * va[4] + pb[1] * va[5]) + (pb[2] * va[6] + pb[3] * va[7]);
                    o[ss][q][1] += (pa[0] * vb[0] + pa[1] * vb[1]) + (pa[2] * vb[2] + pa[3] * vb[3]) + (pb[0] * vb[4] + pb[1] * vb[5]) + (pb[2] * vb[6] + pb[3] * vb[7]); }
        }
        LDS_WAIT(); __builtin_amdgcn_wave_barrier(); asm volatile("" ::: "memory");
    }
#pragma unroll
    for (int q = 0; q < ANQ; ++q) {
        float r0v, r1v;
        if (NS == 1) { const float il = 1.0f / lrun[0][q]; r0v = o[0][q][0] * il; r1v = o[0][q][1] * il; }
        else { const float i1 = 1.0f / lrun[0][q], i2 = A.lam / lrun[NS - 1][q]; r0v = o[0][q][0] * i1 - o[NS - 1][q][0] * i2; r1v = o[0][q][1] * i1 - o[NS - 1][q][1] * i2;
            const float ssq = wave_sum(r0v * r0v + r1v * r1v); const float rr = (1.0f / sqrtf(ssq * (1.0f / 128.0f) + NORM_EPS)) * A.one_m_li;
            r0v *= rr * A.subln[2 * lane]; r1v *= rr * A.subln[2 * lane + 1]; }
        *(unsigned*)(A.omix + (size_t)(qrow0 + q) * D + ocol + 2 * lane) = pk2(r0v, r1v);
    }
}
__device__ __forceinline__ void attn_naive_phase(Frame& F, const AttnCtx& A, bool with_ctx) {
    const int gw = F.vcu * NWAVES + F.wave, NGW = F.G * NWAVES, lane = (tid_of(F.wave) & 63);
    LAS float* Qs = (LAS float*)(F.lds + RING_OFF + F.wave * 8192); LAS float* Ps = Qs + ANQ * 192;
    constexpr int GPB = SEQ / ANQ, CGPB = CTXL / ANQ;
    constexpr int T_MLA = NBATCH * H_MLA * GPB, T_DF = NBATCH * H_DF * GPB, T_NA = NBATCH * H_NA * GPB, T_LAT = T_MLA + T_DF + T_NA;
    constexpr int C_MLA = NBATCH * H_MLA * CGPB, C_DF = NBATCH * H_DF * CGPB, C_NA = NBATCH * H_NA * CGPB;
    const int total = T_LAT + (with_ctx ? C_MLA + C_DF + C_NA : 0);
    for (int t = gw; t < total; t += NGW) {
        int r = t, type, b, h, g; bool isc = false;
        if (r < T_MLA) { type = 1; b = r / (H_MLA * GPB); h = (r / GPB) % H_MLA; g = r % GPB; }
        else if ((r -= T_MLA) < T_DF) { type = 2; b = r / (H_DF * GPB); h = (r / GPB) % H_DF; g = r % GPB; }
        else if ((r -= T_DF) < T_NA) { type = 0; b = r / (H_NA * GPB); h = (r / GPB) % H_NA; g = r % GPB; }
        else if ((r -= T_NA) < C_MLA) { type = 1; isc = true; b = r / (H_MLA * CGPB); h = (r / CGPB) % H_MLA; g = r % CGPB; }
        else if ((r -= C_MLA) < C_DF) { type = 2; isc = true; b = r / (H_DF * CGPB); h = (r / CGPB) % H_DF; g = r % CGPB; }
        else { r -= C_DF; type = 0; isc = true; b = r / (H_NA * CGPB); h = (r / CGPB) % H_NA; g = r % CGPB; }
        const int qrow0 = isc ? ML + b * CTXL + ANQ * g : b * SEQ + ANQ * g;
        if (type == 1) attn_naive_task<1>(A, Qs, Ps, lane, b, h, qrow0, isc);
        else if (type == 2) attn_naive_task<2>(A, Qs, Ps, lane, b, h, qrow0, isc);
        else attn_naive_task<0>(A, Qs, Ps, lane, b, h, qrow0, isc);
    }
}
typedef float f32x16 __attribute__((ext_vector_type(16)));
typedef __bf16 bf16x2_t __attribute__((ext_vector_type(2)));
__device__ __forceinline__ unsigned cvtpk_c(float lo, float hi) { f32x2 v = {lo, hi}; return __builtin_bit_cast(unsigned, __builtin_convertvector(v, bf16x2_t)); }
template <int DQK> __device__ __forceinline__ int k_off(int r, int c) { return r * (DQK * 2) + 16 * (DQK == 128 ? (c ^ (r & 15)) : (c ^ ((r >> 1) & 7))); }
__device__ __forceinline__ int v_off(int r, int c) { return r * 128 + 16 * (c ^ ((r >> 1) & 7)); }
__device__ __forceinline__ int swap23(int k) { return (k & ~12) | ((k & 4) << 1) | ((k & 8) >> 1); }
constexpr int ATT_KB0 = 0, ATT_KB1 = 24576, ATT_VB0 = 49152, ATT_VB1 = 65536, ATT_RPB = 81920, ATT_LDS_END = 81920 + 2048;
constexpr size_t WS_DTMP = WS_U;
static_assert((size_t)2 * M * 640 * 4 <= (size_t)M * FF * 2, "DTMP fits in U");

struct AUnit { int type, b, h, pass, qrow0, isctx, g; };

template <int TYPE>
__device__ __forceinline__ void attn_mfma_unit(const AttnCtx& A, unsigned char* ws, LAS unsigned char* lds, int tid, const AUnit& u) {
    constexpr int DQK = TYPE == 1 ? 192 : (TYPE == 0 ? 128 : 64);
    constexpr int NKK = DQK / 16, NKC = DQK / 8, KPT = NKC / 8;
    const int w = __builtin_amdgcn_readfirstlane(tid >> 6), lane = tid & 63, q_ = lane & 31, h2_ = lane >> 5;
    const bf16_t* Qg; const bf16_t* Kg; const bf16_t* VTg; int ld;
    if (TYPE == 0) { Qg = A.naq + u.h * 128; Kg = A.nak + u.h * 128; ld = 768; VTg = A.vtin + (size_t)(u.h * 128) * M; }
    else if (TYPE == 1) { Qg = A.mq + u.h * 192; Kg = A.mk + u.h * 192; ld = 960; VTg = A.vtm + (size_t)(u.h * 128) * M; }
    else { Qg = A.dq + u.h * 128 + 64 * u.pass; Kg = A.dk + u.h * 128 + 64 * u.pass; ld = 640; VTg = A.vtin + (size_t)(768 + u.h * 128) * M; }
    const int qrow = u.qrow0 + 32 * w + q_;
    bf16x8 qf[NKK];
#pragma unroll
    for (int kk = 0; kk < NKK; ++kk) qf[kk] = *(const bf16x8*)(Qg + (size_t)qrow * ld + 16 * kk + 8 * h2_);
    int lo = 0, nlat = u.isctx ? 0 : 64, qr = 0, qc = 0, r0w = 0, c0 = 0;
    if (TYPE == 0 && !u.isctx) {
        int a = 4 * u.g - 4; lo = a < 0 ? 0 : (a > 56 ? 56 : a); int hb = 4 * u.g + 3 - 4; hb = hb < 0 ? 0 : (hb > 56 ? 56 : hb); nlat = hb + 8 - lo;
        qr = 4 * u.g + (w >> 1); qc = 32 * (w & 1) + q_; int t = qr - 4; r0w = t < 0 ? 0 : (t > 56 ? 56 : t); t = qc - 8; c0 = t < 0 ? 0 : (t > 48 ? 48 : t);
        LAS float* rp = (LAS float*)(lds + ATT_RPB);
        if (tid < 465) rp[tid] = A.rpb[u.h * 465 + tid] * LOG2E;
    }
    const int nt = 4 + nlat;
    int kgo[KPT], klo[KPT], vgo[2], vlo[2];
#pragma unroll
    for (int i = 0; i < KPT; ++i) { const int ci = tid + 512 * i, row = ci / NKC, c = ci % NKC; kgo[i] = row * ld + 8 * c; klo[i] = k_off<DQK>(swap23(row), c); }
#pragma unroll
    for (int i = 0; i < 2; ++i) { const int ci = tid + 512 * i, ch = ci >> 3, c = ci & 7; vgo[i] = ch * M + 8 * c; vlo[i] = v_off(ch, c); }
    u32x4 kst[KPT], vst[2];
#define ATT_TOK0(ti) ((ti) < 4 ? ML + u.b * CTXL + 64 * (ti) : (TYPE == 0 ? u.b * SEQ + 64 * (lo + (ti) - 4) : u.b * SEQ + 64 * ((ti) - 4)))
#define ATT_LOAD(ti) do { const int _t0 = ATT_TOK0(ti); const bf16_t* _kb = Kg + (size_t)_t0 * ld; const bf16_t* _vb = VTg + _t0; \
        _Pragma("unroll") for (int _i = 0; _i < KPT; ++_i) kst[_i] = *(const u32x4*)(_kb + kgo[_i]); \
        _Pragma("unroll") for (int _i = 0; _i < 2; ++_i) vst[_i] = *(const u32x4*)(_vb + vgo[_i]); } while (0)
#define ATT_WRITE(buf) do { LAS unsigned char* _k = lds + ((buf) ? ATT_KB1 : ATT_KB0); LAS unsigned char* _v = lds + ((buf) ? ATT_VB1 : ATT_VB0); \
        _Pragma("unroll") for (int _i = 0; _i < KPT; ++_i) *(LAS u32x4*)(_k + klo[_i]) = kst[_i]; \
        _Pragma("unroll") for (int _i = 0; _i < 2; ++_i) *(LAS u32x4*)(_v + vlo[_i]) = vst[_i]; } while (0)
    f32x16 o[4];
#pragma unroll
    for (int d0 = 0; d0 < 4; ++d0)
#pragma unroll
        for (int r = 0; r < 16; ++r) o[d0][r] = 0.f;
    float mrun = -1e30f, lrun = 0.f;
    ATT_LOAD(0); ATT_WRITE(0);
    __syncthreads();
    for (int ti = 0; ti < nt; ++ti) {
        const int buf = ti & 1;
        if (ti + 1 < nt) ATT_LOAD(ti + 1);
        bool active = true; int kr = 0;
        if (TYPE == 0 && ti >= 4) { kr = lo + ti - 4; active = (kr >= r0w) && (kr < r0w + 8); }
        if (active) {
            const int q = opaque_v(q_), h2 = opaque_v(h2_);
            const LAS unsigned char* kb = lds + (buf ? ATT_KB1 : ATT_KB0); const LAS unsigned char* vb = lds + (buf ? ATT_VB1 : ATT_VB0);
            f32x16 s0, s1;
#pragma unroll
            for (int r = 0; r < 16; ++r) { s0[r] = 0.f; s1[r] = 0.f; }
#pragma unroll
            for (int kk = 0; kk < NKK; ++kk) {
                const bf16x8 a0 = *(const LAS bf16x8*)(kb + k_off<DQK>(q, 2 * kk + h2));
                const bf16x8 a1 = *(const LAS bf16x8*)(kb + k_off<DQK>(32 + q, 2 * kk + h2));
                s0 = __builtin_amdgcn_mfma_f32_32x32x16_bf16(a0, qf[kk], s0, 0, 0, 0);
                s1 = __builtin_amdgcn_mfma_f32_32x32x16_bf16(a1, qf[kk], s1, 0, 0, 0);
            }
            if (TYPE == 0 && ti >= 4) {
                const LAS float* rp = (const LAS float*)(lds + ATT_RPB) + (kr - qr + 7) * 31 + 15;
#pragma unroll
                for (int r = 0; r < 16; ++r) {
                    const int k0c = 16 * (r >> 3) + 8 * h2 + 4 * ((r >> 2) & 1) + (r & 3), k1c = 32 + k0c;
                    const bool ok0 = (k0c >= c0) && (k0c < c0 + 16), ok1 = (k1c >= c0) && (k1c < c0 + 16);
                    int i0 = k0c - qc; i0 = i0 < -15 ? -15 : (i0 > 15 ? 15 : i0); int i1 = k1c - qc; i1 = i1 < -15 ? -15 : (i1 > 15 ? 15 : i1);
                    const float b0 = rp[i0], b1 = rp[i1];
                    s0[r] = ok0 ? s0[r] + b0 : -1e30f; s1[r] = ok1 ? s1[r] + b1 : -1e30f;
                }
            }
            float tm = s0[0];
#pragma unroll
            for (int r = 1; r < 16; ++r) tm = fmaxf(tm, s0[r]);
#pragma unroll
            for (int r = 0; r < 16; ++r) tm = fmaxf(tm, s1[r]);
            tm = half_max(tm);
            const float mn = fmaxf(mrun, tm), alpha = fast_exp2(mrun - mn);
            float ps = 0.f;
#pragma unroll
            for (int r = 0; r < 16; ++r) { s0[r] = fast_exp2(s0[r] - mn); s1[r] = fast_exp2(s1[r] - mn); ps += s0[r] + s1[r]; }
            ps = half_sum(ps);
            lrun = lrun * alpha + ps; mrun = mn;
#pragma unroll
            for (int d0 = 0; d0 < 4; ++d0)
#pragma unroll
                for (int r = 0; r < 16; ++r) o[d0][r] *= alpha;
            bf16x8 pf[4];
#pragma unroll
            for (int s = 0; s < 2; ++s) {
                u32x4 t0, t1;
                t0.x = cvtpk_c(s0[8 * s + 0], s0[8 * s + 1]); t0.y = cvtpk_c(s0[8 * s + 2], s0[8 * s + 3]); t0.z = cvtpk_c(s0[8 * s + 4], s0[8 * s + 5]); t0.w = cvtpk_c(s0[8 * s + 6], s0[8 * s + 7]);
                t1.x = cvtpk_c(s1[8 * s + 0], s1[8 * s + 1]); t1.y = cvtpk_c(s1[8 * s + 2], s1[8 * s + 3]); t1.z = cvtpk_c(s1[8 * s + 4], s1[8 * s + 5]); t1.w = cvtpk_c(s1[8 * s + 6], s1[8 * s + 7]);
                pf[s] = __builtin_bit_cast(bf16x8, t0); pf[2 + s] = __builtin_bit_cast(bf16x8, t1);
            }
#pragma unroll
            for (int d0 = 0; d0 < 4; ++d0)
#pragma unroll
                for (int ks = 0; ks < 4; ++ks) {
                    const bf16x8 av = *(const LAS bf16x8*)(vb + v_off(32 * d0 + q, 2 * ks + h2));
                    o[d0] = __builtin_amdgcn_mfma_f32_32x32x16_bf16(av, pf[ks], o[d0], 0, 0, 0);
                }
        }
        if (ti + 1 < nt) ATT_WRITE(buf ^ 1);
        __syncthreads();
    }
#undef ATT_TOK0
#undef ATT_LOAD
#undef ATT_WRITE
    const int h2 = h2_;
    const float il = 1.0f / lrun;
    if (TYPE == 2) {
        float* dst = (float*)(ws + WS_DTMP) + ((size_t)u.pass * M + qrow) * 640 + u.h * 128 + 4 * h2;
#pragma unroll
        for (int d0 = 0; d0 < 4; ++d0)
#pragma unroll
            for (int i = 0; i < 4; ++i) { f32x4 v = {o[d0][4 * i] * il, o[d0][4 * i + 1] * il, o[d0][4 * i + 2] * il, o[d0][4 * i + 3] * il}; *(f32x4*)(dst + 32 * d0 + 8 * i) = v; }
    } else {
        bf16_t* dst = A.omix + (size_t)qrow * D + (TYPE == 0 ? 0 : 768) + u.h * 128 + 4 * h2;
#pragma unroll
        for (int d0 = 0; d0 < 4; ++d0)
#pragma unroll
            for (int i = 0; i < 4; ++i) { u32x2 v; v.x = cvtpk_c(o[d0][4 * i] * il, o[d0][4 * i + 1] * il); v.y = cvtpk_c(o[d0][4 * i + 2] * il, o[d0][4 * i + 3] * il); *(u32x2*)(dst + 32 * d0 + 8 * i) = v; }
    }
}

#ifndef ATTN_PRIO
#define ATTN_PRIO 1
#endif
#ifndef ATTN_ALLLATE
#define ATTN_ALLLATE 1
#endif
#ifndef ATTN_PIPE_MASK
#define ATTN_PIPE_MASK 0
#endif
constexpr float ATT_THR = 8.0f;
constexpr int A2_RPB = 122880;

template <int TYPE>
__device__ __forceinline__ void attn_mfma_unit2(const AttnCtx& A, unsigned char* ws, LAS unsigned char* lds, int tid, const AUnit& u) {
    constexpr int DQK = TYPE == 1 ? 192 : (TYPE == 0 ? 128 : 64);
    constexpr int NKK = DQK / 16, NKC = DQK / 8, PITCH = DQK * 2, KB = 64 * PITCH;
    constexpr int NIK = KB / 8192, NIW = NIK + 2;
    constexpr int NKB = DQK == 128 ? 8 : 4;
    constexpr int STG = KB + 16384;
    const int w = __builtin_amdgcn_readfirstlane(tid >> 6), lane = tid & 63, q = lane & 31, h2 = lane >> 5;
    const bf16_t* Qg; const bf16_t* Kg; const bf16_t* VTg; int ld;
    if (TYPE == 0) { Qg = A.naq + u.h * 128; Kg = A.nak + u.h * 128; ld = 768; VTg = A.vtin + (size_t)(u.h * 128) * M; }
    else if (TYPE == 1) { Qg = A.mq + u.h * 192; Kg = A.mk + u.h * 192; ld = 960; VTg = A.vtm + (size_t)(u.h * 128) * M; }
    else { Qg = A.dq + u.h * 128 + 64 * u.pass; Kg = A.dk + u.h * 128 + 64 * u.pass; ld = 640; VTg = A.vtin + (size_t)(768 + u.h * 128) * M; }
#if ATTN_PRIO
    if (w < 4) __builtin_amdgcn_s_setprio(2); else __builtin_amdgcn_s_setprio(0);
#endif
    const int qrow = u.qrow0 + 32 * w + q;
    bf16x8 qf[NKK];
#pragma unroll
    for (int kk = 0; kk < NKK; ++kk) qf[kk] = *(const bf16x8*)(Qg + (size_t)qrow * ld + 16 * kk + 8 * h2);
    int lo = 0, nlat = u.isctx ? 0 : 64, qr = 0, qc = 0, r0w = 0, c0 = 0;
    if (TYPE == 0 && !u.isctx) {
        int a = 4 * u.g - 4; lo = a < 0 ? 0 : (a > 56 ? 56 : a); int hb = 4 * u.g + 3 - 4; hb = hb < 0 ? 0 : (hb > 56 ? 56 : hb); nlat = hb + 8 - lo;
        qr = 4 * u.g + (w >> 1); qc = 32 * (w & 1) + q; int t = qr - 4; r0w = t < 0 ? 0 : (t > 56 ? 56 : t); t = qc - 8; c0 = t < 0 ? 0 : (t > 48 ? 48 : t);
        LAS float* rp = (LAS float*)(lds + A2_RPB);
        if (tid < 465) rp[tid] = A.rpb[u.h * 465 + tid] * LOG2E;
    }
    const int nt = 4 + nlat;
    unsigned goff[NIW];
#pragma unroll
    for (int m = 0; m < NIW; ++m) {
        if (m < NIK) { const int p = 64 * (w + 8 * m) + lane, row = p / NKC, slot = p % NKC; const int c = DQK == 128 ? (slot ^ (row & 15)) : (slot ^ ((row >> 1) & 7)); goff[m] = (unsigned)(swap23(row) * ld + 8 * c); }
        else { const int p = 64 * (w + 8 * (m - NIK)) + lane, ch = p >> 3, slot = p & 7; const int c = slot ^ ((ch >> 1) & 7); goff[m] = (unsigned)(ch * M + 8 * c); }
    }
    const unsigned ldsw = (unsigned)w * 1024u;
    unsigned kbase[NKB], vbase[4];
#pragma unroll
    for (int i = 0; i < NKB; ++i) kbase[i] = (unsigned)(q * PITCH + 16 * (DQK == 128 ? ((2 * i + h2) ^ (q & 15)) : ((2 * i + h2) ^ ((q >> 1) & 7))));
#pragma unroll
    for (int i = 0; i < 4; ++i) vbase[i] = (unsigned)(KB + q * 128 + 16 * ((2 * i + h2) ^ ((q >> 1) & 7)));
#define A2_TOK0(ti) ((ti) < 4 ? ML + u.b * CTXL + 64 * (ti) : (TYPE == 0 ? u.b * SEQ + 64 * (lo + (ti) - 4) : u.b * SEQ + 64 * ((ti) - 4)))
#define A2_DMA(ti, SOFF) do { const int _t0 = A2_TOK0(ti); const bf16_t* _kb = Kg + (size_t)_t0 * ld; const bf16_t* _vb = VTg + _t0; \
        _Pragma("unroll") for (int _m = 0; _m < NIK; ++_m) __builtin_amdgcn_global_load_lds((const unsigned*)(_kb + goff[_m]), (LAS unsigned*)(lds + (SOFF) + ldsw + _m * 8192), 16, 0, 0); \
        _Pragma("unroll") for (int _m = 0; _m < 2; ++_m) __builtin_amdgcn_global_load_lds((const unsigned*)(_vb + goff[NIK + _m]), (LAS unsigned*)(lds + (SOFF) + KB + ldsw + _m * 8192), 16, 0, 0); } while (0)
#define A2_WAITN(n) asm volatile("s_waitcnt vmcnt(%0)" :: "n"(n) : "memory")
#define A2_BAR() do { __builtin_amdgcn_s_barrier(); asm volatile("" ::: "memory"); } while (0)
#define A2_KRD(kk, blk, KBUF) (*(const LAS bf16x8*)(lds + (DQK == 128 ? kc[kk] : kc[(kk) & 3]) + ((blk) * 32 * PITCH + (DQK == 128 ? 0 : 128 * ((kk) >> 2)))))
#define A2_VRD(d0, ks, VBUF) (*(const LAS bf16x8*)(lds + vc[ks] + (4096 * (d0))))
    f32x16 o[4];
#pragma unroll
    for (int d0 = 0; d0 < 4; ++d0)
#pragma unroll
        for (int r = 0; r < 16; ++r) o[d0][r] = 0.f;
    float mref = 0.f, lrun = 0.f; bool first = true;
    constexpr bool PIPE = (ATTN_PIPE_MASK >> TYPE) & 1;
    f32x16 sA0, sA1, sB0, sB1; bool actA = true, actB = true; bf16x8 pf[4], fa[4], fb[4];
#define A2_ACTIVE(ti) (!(TYPE == 0 && (ti) >= 4) || ((lo + (ti) - 4 >= r0w) && (lo + (ti) - 4 < r0w + 8)))
#define A2_LDK4(dst, p, KBUF) do { dst[0] = A2_KRD(2 * (p), 0, KBUF); dst[1] = A2_KRD(2 * (p), 1, KBUF); dst[2] = A2_KRD(2 * (p) + 1, 0, KBUF); dst[3] = A2_KRD(2 * (p) + 1, 1, KBUF); } while (0)
#define A2_MMK4(src, p, S0, S1) do { S0 = __builtin_amdgcn_mfma_f32_32x32x16_bf16(src[0], qf[2 * (p)], S0, 0, 0, 0); S1 = __builtin_amdgcn_mfma_f32_32x32x16_bf16(src[1], qf[2 * (p)], S1, 0, 0, 0); \
        S0 = __builtin_amdgcn_mfma_f32_32x32x16_bf16(src[2], qf[2 * (p) + 1], S0, 0, 0, 0); S1 = __builtin_amdgcn_mfma_f32_32x32x16_bf16(src[3], qf[2 * (p) + 1], S1, 0, 0, 0); } while (0)
#define A2_SCHED() __builtin_amdgcn_sched_barrier(0)
#define A2_QK(S0, S1, ti, KBUF) do { \
        { const float _nm = -mref;        \
        _Pragma("unroll") for (int _r = 0; _r < 16; ++_r) { S0[_r] = _nm; S1[_r] = _nm; } } \
        if constexpr (TYPE == 0) {        \
            _Pragma("unroll") for (int _p = 0; _p < NKK / 2; ++_p) { A2_LDK4(fa, _p, KBUF); A2_MMK4(fa, _p, S0, S1); } \
        } else { \
        A2_LDK4(fa, 0, KBUF); \
        _Pragma("unroll") for (int _p = 0; _p < NKK / 2; _p += 2) { \
            A2_LDK4(fb, _p + 1, KBUF); A2_SCHED(); A2_MMK4(fa, _p, S0, S1); A2_SCHED(); \
            if (_p + 2 < NKK / 2) A2_LDK4(fa, _p + 2, KBUF); A2_SCHED(); A2_MMK4(fb, _p + 1, S0, S1); A2_SCHED(); } } \
        if (TYPE == 0 && (ti) >= 4) { const int _kr = lo + (ti) - 4; \
            const int _lb = opaque_v(c0 - 8 * h2);                        \
            const LAS float* _rp = (const LAS float*)(lds + A2_RPB) + ((_kr - qr + 7) * 31 + 15) + opaque_v(8 * h2 - qc); \
            _Pragma("unroll") for (int _r = 0; _r < 16; ++_r) { const int _k0 = 16 * (_r >> 3) + 4 * ((_r >> 2) & 1) + (_r & 3), _k1 = 32 + _k0; \
                const bool _ok0 = (unsigned)(_k0 - _lb) < 16u, _ok1 = (unsigned)(_k1 - _lb) < 16u; \
                S0[_r] = _ok0 ? S0[_r] + _rp[_k0] : -1e30f; S1[_r] = _ok1 ? S1[_r] + _rp[_k1] : -1e30f; } } } while (0)
#define A2_PSM(S0, S1) do { \
        float _tm = S0[0]; \
        _Pragma("unroll") for (int _r = 1; _r < 16; ++_r) _tm = fmaxf(_tm, S0[_r]); \
        _Pragma("unroll") for (int _r = 0; _r < 16; ++_r) _tm = fmaxf(_tm, S1[_r]); \
        _tm = half_max(_tm); \
        if (first || !__all(_tm <= ATT_THR)) { \
            const float _sh = first ? _tm : fmaxf(_tm, 0.f), _al = first ? 0.f : fast_exp2(-_sh); \
            mref += _sh; lrun *= _al; first = false; \
            _Pragma("unroll") for (int _d = 0; _d < 4; ++_d) _Pragma("unroll") for (int _r = 0; _r < 16; ++_r) o[_d][_r] *= _al; \
            _Pragma("unroll") for (int _r = 0; _r < 16; ++_r) { S0[_r] -= _sh; S1[_r] -= _sh; } } } while (0)
#define A2_LDV4(dst, d0, VBUF) do { dst[0] = A2_VRD(d0, 0, VBUF); dst[1] = A2_VRD(d0, 1, VBUF); dst[2] = A2_VRD(d0, 2, VBUF); dst[3] = A2_VRD(d0, 3, VBUF); } while (0)
#define A2_MMV4(src, d0) do { _Pragma("unroll") for (int _ks = 0; _ks < 4; ++_ks) o[d0] = __builtin_amdgcn_mfma_f32_32x32x16_bf16(src[_ks], pf[_ks], o[d0], 0, 0, 0); } while (0)
#define A2_LDVK(dst, ks) do { dst[0] = A2_VRD(0, ks, 0); dst[1] = A2_VRD(1, ks, 0); dst[2] = A2_VRD(2, ks, 0); dst[3] = A2_VRD(3, ks, 0); } while (0)
#define A2_MMVK(src, ks) do { _Pragma("unroll") for (int _d = 0; _d < 4; ++_d) o[_d] = __builtin_amdgcn_mfma_f32_32x32x16_bf16(src[_d], pf[ks], o[_d], 0, 0, 0); } while (0)
#define A2_EXP8(S, off, ks) do { \
        _Pragma("unroll") for (int _r = 0; _r < 8; ++_r) { S[(off) + _r] = fast_exp2(S[(off) + _r]); } \
        _ps += ((S[(off) + 0] + S[(off) + 1]) + (S[(off) + 2] + S[(off) + 3])) + ((S[(off) + 4] + S[(off) + 5]) + (S[(off) + 6] + S[(off) + 7])); \
        u32x4 _t; _t.x = cvtpk_c(S[(off) + 0], S[(off) + 1]); _t.y = cvtpk_c(S[(off) + 2], S[(off) + 3]); _t.z = cvtpk_c(S[(off) + 4], S[(off) + 5]); _t.w = cvtpk_c(S[(off) + 6], S[(off) + 7]); \
        pf[ks] = __builtin_bit_cast(bf16x8, _t); } while (0)
#define A2_FSM_PV(S0, S1, VBUF) do { float _ps = 0.f; \
        A2_LDVK(fa, 0); A2_SCHED(); \
        A2_EXP8(S0, 0, 0); A2_LDVK(fb, 1); A2_SCHED(); A2_MMVK(fa, 0); A2_SCHED(); \
        A2_EXP8(S0, 8, 1); A2_LDVK(fa, 2); A2_SCHED(); A2_MMVK(fb, 1); A2_SCHED(); \
        A2_EXP8(S1, 0, 2); A2_LDVK(fb, 3); A2_SCHED(); A2_MMVK(fa, 2); A2_SCHED(); \
        A2_EXP8(S1, 8, 3); A2_SCHED(); A2_MMVK(fb, 3); A2_SCHED(); \
        lrun += half_sum(_ps); } while (0)

    (void)PIPE; (void)actA; (void)actB; (void)sB0; (void)sB1;
    A2_DMA(0, 0);
    asm volatile("s_waitcnt lgkmcnt(0)" ::: "memory");
    A2_WAITN(0); A2_BAR();
#define A2_SETKC(SOFF) _Pragma("unroll") for (int _i = 0; _i < NKB; ++_i) kc[_i] = kbase[_i] + (unsigned)(SOFF)
#define A2_SETVC(SOFF) _Pragma("unroll") for (int _i = 0; _i < 4; ++_i) vc[_i] = vbase[_i] + (unsigned)(SOFF)
    unsigned kc[NKB], vc[4];
    int scur = 0, snxt = STG, sprv = 0;
    if (w < 4 && !ATTN_ALLLATE) {
        for (int ti = 0; ti < nt; ++ti) {
            if (ti + 1 < nt) A2_DMA(ti + 1, snxt);
            if (A2_ACTIVE(ti)) { A2_SETKC(scur); A2_SETVC(scur); A2_QK(sA0, sA1, ti, 0); A2_PSM(sA0, sA1); A2_FSM_PV(sA0, sA1, 0); }
            A2_WAITN(0); A2_BAR();
            sprv = scur; scur = snxt; snxt = snxt == 2 * STG ? 0 : snxt + STG;
        }
    } else {
        bool actP = false;
        for (int ti = 0; ti < nt; ++ti) {
            if (ti + 1 < nt) A2_DMA(ti + 1, snxt);
            if (actP) { A2_SETVC(sprv); A2_FSM_PV(sA0, sA1, 0); }
            actP = A2_ACTIVE(ti);
            if (actP) { A2_SETKC(scur); A2_QK(sA0, sA1, ti, 0); A2_PSM(sA0, sA1); }
            A2_WAITN(0); A2_BAR();
            sprv = scur; scur = snxt; snxt = snxt == 2 * STG ? 0 : snxt + STG;
        }
        if (actP) { A2_SETVC(sprv); A2_FSM_PV(sA0, sA1, 0); }
    }
#undef A2_SETKC
#undef A2_SETVC
    asm volatile("" ::: "memory"); __builtin_amdgcn_s_barrier(); asm volatile("" ::: "memory");
#undef A2_TOK0
#undef A2_DMA
#undef A2_WAITN
#undef A2_BAR
#undef A2_KRD
#undef A2_VRD
#undef A2_ACTIVE
#undef A2_QK
#undef A2_LDK4
#undef A2_MMK4
#undef A2_LDV4
#undef A2_MMV4
#undef A2_SCHED
#undef A2_PSM
#undef A2_FSM_PV
#undef A2_LDVK
#undef A2_MMVK
#undef A2_EXP8
#if ATTN_PRIO
    __builtin_amdgcn_s_setprio(0);
#endif
    const float il = 1.0f / lrun;
    const int lane_e = lane_id(), q_e = lane_e & 31, h2_e = lane_e >> 5, qrow_e = u.qrow0 + 32 * w + q_e;
    if (TYPE == 2) {
        __syncthreads();
        LAS unsigned char* tb = lds + w * 16384;
#pragma unroll
        for (int d0 = 0; d0 < 4; ++d0)
#pragma unroll
            for (int i = 0; i < 4; ++i) {
#pragma unroll
                for (int e = 0; e < 4; ++e) o[d0][4 * i + e] *= il;
                const f32x4 v = {o[d0][4 * i], o[d0][4 * i + 1], o[d0][4 * i + 2], o[d0][4 * i + 3]};
                *(LAS f32x4*)(tb + ((q_e * 32 + ((8 * d0 + 2 * i + h2_e) ^ q_e)) << 4)) = v;
            }
        LDS_WAIT(); asm volatile("" ::: "memory");
        {
            GAS unsigned long long* drow = (GAS unsigned long long*)((float*)(ws + WS_DTMP) + ((size_t)u.pass * M + u.qrow0 + 32 * w) * 640 + u.h * 128) + lane_e;
#pragma unroll
            for (int r = 0; r < 32; ++r) {
                const unsigned long long x = *(const LAS unsigned long long*)(tb + ((r * 32 + ((lane_e >> 1) ^ r)) << 4) + 8 * (lane_e & 1));
                __hip_atomic_store(drow + (size_t)r * 320, x, RLX_AGENT);
            }
        }
        asm volatile("s_waitcnt vmcnt(0)" ::: "memory");
        __syncthreads();
        volatile LAS unsigned* misc = (volatile LAS unsigned*)(lds + MISC_OFF);
        if (w == 0 && lane_e == 0) {
            gu32* cnt = (gu32*)(ws + WS_CTL) + CW_DC + (u.isctx ? 160 + u.b * 5 + u.h : (u.b * 5 + u.h) * 16 + ((u.qrow0 - u.b * SEQ) >> 8));
            misc[1] = __hip_atomic_fetch_add(cnt, 1u, RLX_AGENT);
        }
        __syncthreads();
        if (misc[1] & 1u) {
            GAS unsigned long long* orow = (GAS unsigned long long*)((float*)(ws + WS_DTMP) + ((size_t)(1 - u.pass) * M + u.qrow0 + 32 * w) * 640 + u.h * 128) + lane_e;
#pragma unroll
            for (int hh = 0; hh < 2; ++hh) {
                unsigned long long t[16];
#pragma unroll
                for (int r = 0; r < 16; ++r) t[r] = __hip_atomic_load(orow + (size_t)(16 * hh + r) * 320, RLX_AGENT);
#pragma unroll
                for (int r = 0; r < 16; ++r) { const int rr_ = 16 * hh + r; *(LAS unsigned long long*)(tb + ((rr_ * 32 + ((lane_e >> 1) ^ rr_)) << 4) + 8 * (lane_e & 1)) = t[r]; }
            }
            LDS_WAIT(); asm volatile("" ::: "memory");
            const float ca = u.pass == 0 ? 1.0f : -A.lam, cb = u.pass == 0 ? -A.lam : 1.0f;
            float ssq = 0.f;
#pragma unroll
            for (int d0 = 0; d0 < 4; ++d0)
#pragma unroll
                for (int i = 0; i < 4; ++i) { const f32x4 t = *(const LAS f32x4*)(tb + ((q_e * 32 + ((8 * d0 + 2 * i + h2_e) ^ q_e)) << 4));
#pragma unroll
                    for (int e = 0; e < 4; ++e) { const float r = ca * o[d0][4 * i + e] + cb * t[e]; o[d0][4 * i + e] = r; ssq += r * r; } }
            ssq += __shfl_xor(ssq, 32);
            const float rr = (1.0f / sqrtf(ssq * (1.0f / 128.0f) + NORM_EPS)) * A.one_m_li;
            bf16_t* od = A.omix + (size_t)qrow_e * D + 1408 + u.h * 128 + 4 * h2_e; const float* gp = A.subln + 4 * h2_e;
#pragma unroll
            for (int d0 = 0; d0 < 4; ++d0)
#pragma unroll
                for (int i = 0; i < 4; ++i) { const f32x4 g = *(const f32x4*)(gp + 32 * d0 + 8 * i);
                    u32x2 v; v.x = pk2(o[d0][4 * i] * rr * g[0], o[d0][4 * i + 1] * rr * g[1]); v.y = pk2(o[d0][4 * i + 2] * rr * g[2], o[d0][4 * i + 3] * rr * g[3]); *(u32x2*)(od + 32 * d0 + 8 * i) = v; }
        }
        __syncthreads();
    } else {
        bf16_t* dst = A.omix + (size_t)qrow_e * D + (TYPE == 0 ? 0 : 768) + u.h * 128 + 4 * h2_e;
#pragma unroll
        for (int d0 = 0; d0 < 4; ++d0)
#pragma unroll
            for (int i = 0; i < 4; ++i) { u32x2 v; v.x = cvtpk_c(o[d0][4 * i] * il, o[d0][4 * i + 1] * il); v.y = cvtpk_c(o[d0][4 * i + 2] * il, o[d0][4 * i + 3] * il); *(u32x2*)(dst + 32 * d0 + 8 * i) = v; }
    }
}
#ifndef ATTN_V2
#define ATTN_V2 1
#endif
__device__ __forceinline__ bool attn_unit_decode(int x, int i, bool with_ctx, AUnit& u) {
    u.pass = 0; u.isctx = 0; u.g = 0;
    if (i < 20) { const int item = 5 * x + (i >> 2), pair = item >> 2, qb = 4 * (item & 3) + (i & 3); u.type = 1; u.b = pair / 5; u.h = pair % 5; u.qrow0 = u.b * SEQ + 256 * qb; return true; } i -= 20;
    if (i < 40) { const int item = 5 * x + (i >> 3), pair = item >> 2, qb = 4 * (item & 3) + ((i & 7) >> 1); u.type = 2; u.b = pair / 5; u.h = pair % 5; u.pass = i & 1; u.qrow0 = u.b * SEQ + 256 * qb; return true; } i -= 40;
    if (i < 24) { const int item = 6 * x + (i >> 2), pair = item >> 2, g = 4 * (item & 3) + (i & 3); u.type = 0; u.b = pair / 6; u.h = pair % 6; u.g = g; u.qrow0 = u.b * SEQ + 256 * g; return true; } i -= 24;
    if (!with_ctx) return false;
    int c = x + 8 * i; u.isctx = 1;
    if (c < 10) { u.type = 1; u.b = c / 5; u.h = c % 5; u.qrow0 = ML + u.b * CTXL; return true; } c -= 10;
    if (c < 20) { u.type = 2; u.b = c / 10; u.h = (c >> 1) % 5; u.pass = c & 1; u.qrow0 = ML + u.b * CTXL; return true; } c -= 20;
    if (c < 12) { u.type = 0; u.b = c / 6; u.h = c % 6; u.qrow0 = ML + u.b * CTXL; return true; }
    return false;
}
__device__ __forceinline__ void attn_mfma_phase(Frame& F, const AttnCtx& A, bool with_ctx, gu32* qheads, int type_mask = 7) {
    volatile LAS unsigned* slot = F.MISC;
    const int x0 = (int)(xb_xcc_id() & 7u);
    for (int k = 0; k < 8; ++k) {
        const int x = (x0 + k) & 7;
        if (k == 1) {
            const int t = tid_of(F.wave);
            if (t < 8) { const unsigned hv = __hip_atomic_load(qheads + 64 * t, RLX_AGENT); slot[32 + t] = ((int)hv < 84 + (with_ctx ? (t < 2 ? 6 : 5) : 0)) ? 1u : 0u; }
            __syncthreads();
        }
        if (k >= 1 && slot[32 + x] == 0u) continue;
        for (;;) {
            if (tid_of(F.wave) == 0) slot[0] = __hip_atomic_fetch_add(qheads + 64 * x, 1u, RLX_AGENT);
            __syncthreads();
            const int ui = (int)slot[0];
            AUnit u;
            const bool ok = attn_unit_decode(x, ui, with_ctx, u);
            if (ok && ((type_mask >> u.type) & 1)) {
#if ATTN_V2
                if (u.type == 1) attn_mfma_unit2<1>(A, F.ws, F.lds + RING_OFF, tid_of(F.wave), u);
                else if (u.type == 2) attn_mfma_unit2<2>(A, F.ws, F.lds + RING_OFF, tid_of(F.wave), u);
                else attn_mfma_unit2<0>(A, F.ws, F.lds + RING_OFF, tid_of(F.wave), u);
#else
                if (u.type == 1) attn_mfma_unit<1>(A, F.ws, F.lds + RING_OFF, tid_of(F.wave), u);
                else if (u.type == 2) attn_mfma_unit<2>(A, F.ws, F.lds + RING_OFF, tid_of(F.wave), u);
                else attn_mfma_unit<0>(A, F.ws, F.lds + RING_OFF, tid_of(F.wave), u);
#endif
            }
            __syncthreads();
            if (!ok) break;
        }
    }
}
__device__ __forceinline__ void zero_ctx_y_rows(Frame& F) {
    const int gw = F.vcu * NWAVES + F.wave, NGW = F.G * NWAVES, lane = (tid_of(F.wave) & 63);
    unsigned long long* yz = (unsigned long long*)(F.ws + WS_Y + (size_t)ML * D * 2);
    const unsigned long long z = (unsigned long long)(unsigned)opaque_v(0);
    for (int i = gw * 64 + lane; i < MC * D * 2 / 8; i += NGW * 64) __hip_atomic_store(yz + i, z, __ATOMIC_RELAXED, __HIP_MEMORY_SCOPE_AGENT);
}
#ifndef PROBE_PRO
#define PROBE_PRO 0
#endif
#ifndef PROBE_FFNIN
#define PROBE_FFNIN 0
#endif
#ifndef PROBE_ATTN
#define PROBE_ATTN 0
#endif
#ifndef PROBE_NULLEPI
#define PROBE_NULLEPI 0
#endif
#ifndef PROBE_FFNOUT
#define PROBE_FFNOUT 0
#endif
#ifndef PROBE_NORM
#define PROBE_NORM 0
#endif
#ifndef PROBE_INPROJ
#define PROBE_INPROJ 0
#endif
#ifndef PROBE_MLAUP
#define PROBE_MLAUP 0
#endif
#ifndef PROBE_MERGE
#define PROBE_MERGE 0
#endif
#ifndef PROBE_BAR
#define PROBE_BAR 0
#endif
#ifndef ATTN_NAIVE
#define ATTN_NAIVE 0
#endif
#ifndef WCV_CONV
#define WCV_CONV 8
#endif
#ifndef MK_SPLIT
#define MK_SPLIT 0
#endif
__global__ void __launch_bounds__(NTHREADS, 2) dit_fwd(Args args) {
    extern __shared__ __attribute__((aligned(16))) unsigned char lds[];
    Frame F;
    F.lds = (LAS unsigned char*)lds;
    F.MISC = (volatile LAS unsigned*)(F.lds + MISC_OFF);
    F.wave = __builtin_amdgcn_readfirstlane((int)threadIdx.x >> 6);
    F.G = gridDim.x; { const int bx = blockIdx.x; F.vcu = (F.G % 8 == 0) ? (bx % 8) * (F.G / 8) + bx / 8 : bx; }
    F.ws = args.ws; F.ctl = (gu32*)(args.ws + WS_CTL);
    for (int u = (int)threadIdx.x; u < (LDS_BYTES - LDSCTL_OFF) / 4; u += NTHREADS) ((LAS unsigned*)(F.lds + LDSCTL_OFF))[u] = 0u;
    __syncthreads();
    { LAS float* rc = (LAS float*)(F.lds + ROPE_LDS);
      for (int i = (int)threadIdx.x; i < 1024; i += NTHREADS) { const int pos = i >> 4, fi = i & 15; const float fr = powf(10000.0f, -(float)fi / 16.0f); const float ang = (float)pos * fr; rc[i] = cosf(ang); rc[1024 + i] = sinf(ang); } }
    XcdBarrier bar; bar.bar = (unsigned*)(F.ctl + CW_BAR); bar.x = 0; bar.st = nullptr; bar.wave = F.wave;
    if (!MK_SPLIT) bar = xcd_barrier_post((unsigned*)(F.ctl + CW_BAR), F.MISC + 8, F.wave);
    const int lo = args.ph_lo, hi = args.ph_hi; int ph = 0;
#define PH_BEGIN if (lo <= ph && ph < hi) {
#define PH_END   if (!MK_SPLIT) xcd_barrier(bar); } ++ph;

    float* mod = wsp<float>(F, WS_MOD);
    const int G = F.G, cid = (int)blockIdx.x;
    LAS unsigned char* ring = F.lds + RING_OFF;

    PH_BEGIN p0_prologue(F, args, true); PH_END
#if PROBE_PRO
    PH_BEGIN p0_prologue(F, args, false); PH_END
#endif

    for (int s = 0; s < 2 * DEPTH; ++s) {
        const int l = s >> 1, j = s & 1, li = s;
        const bool last = (l == DEPTH - 1);
        const float* modl = mod + (size_t)l * 3 * MODLD;
        const int nM_f = (j == 1 && last) ? 32 : 34;
        if (s == 0) { PH_BEGIN norm_mod_phase(F, args.in[I_NORMW] + (size_t)(l * 3) * D, modl, modl + D, 0, M, 0, args.in[I_X], args.in[I_CTX]); PH_END }
        else if (nM_f == 34) { PH_BEGIN { if (j == 0) ctx_norm_phase<11>(F, args.in[I_NORMW] + (size_t)(l * 3) * D, modl, modl + D); else ctx_norm_phase<8>(F, args.in[I_NORMW] + (size_t)(l * 3 + 2) * D, modl + 6 * D, modl + 7 * D); } PH_END }
        PH_BEGIN {
            pg8::Gemm g{wsp<bf16_t>(F, WS_H), wsp<bf16_t>(F, WS_WFI + (size_t)li * WFI_SZ)};
            pg8::SegSched S; S.init(0, nM_f, FF / 128, G, cid, 0, D / 64);
            pg8::EpiSwiGLU E{wsp<bf16_t>(F, WS_U)};
            pg8::gemm_phase<pg8::EpiSwiGLU, pg8::SegSched, LDH, D>(ring, g, S, E, F.wave);
            if (s == 2 * DEPTH - 1) convert_fill(F, args, DEPTH - 1, 1, F.ctl + CW_WCV + 1024, wcv::NH1 - wcv::I_FO, wcv::NH1);
        } PH_END
#if PROBE_FFNIN
        PH_BEGIN {
            pg8::Gemm g{wsp<bf16_t>(F, WS_H), wsp<bf16_t>(F, WS_WFI + (size_t)li * WFI_SZ)};
            pg8::SegSched S; S.init(0, nM_f, FF / 128, G, cid, 0, PROBE_FFNIN);
#if PROBE_NULLEPI
            pg8::EpiNull E{wsp<float>(F, WS_YF)};
            pg8::gemm_phase<pg8::EpiNull, pg8::SegSched, LDH, D>(ring, g, S, E, F.wave);
#else
            pg8::EpiSwiGLU E{wsp<bf16_t>(F, WS_YF)};
            pg8::gemm_phase<pg8::EpiSwiGLU, pg8::SegSched, LDH, D>(ring, g, S, E, F.wave);
#endif
        } PH_END
#endif
        PH_BEGIN {
            pg8::Gemm g{wsp<bf16_t>(F, WS_U), wsp<bf16_t>(F, WS_WFO + (size_t)li * WFO_SZ)};
            pg8::ResidSched<11, 512> S; S.init(D / 256, G, cid, FF / 64, nM_f == 34);
            const bool fin = (j == 1 && last);
            const float* ng = fin ? args.in[I_FNORM] : (j == 0 ? args.in[I_NORMW] + (size_t)(l * 3 + 1) * D : args.in[I_NORMW] + (size_t)((l + 1) * 3) * D);
            const float* nsh = j == 0 ? modl + 3 * D : (fin ? modl : mod + (size_t)(l + 1) * 3 * MODLD);
            pg8::EpiResidNorm E{F.ws, modl + (j ? 8 : 2) * D, ng, nsh, fin ? args.out : nullptr, s == 0 ? args.in[I_X] : nullptr, 0.5f, 3 * l + (j ? 2 : 0)};
            pg8::gemm_phase<pg8::EpiResidNorm, pg8::ResidSched<11, 512>, FF, FF>(ring, g, S, E, F.wave);
        } PH_END
        if (j == 0) {
            const int nM_o = last ? 32 : 34;
            pg8::ProjCtx pc{F.ws, l, 0, F.lds};
            PH_BEGIN ctx_norm_phase<11>(F, args.in[I_NORMW] + (size_t)(l * 3 + 1) * D, modl + 3 * D, modl + 4 * D); PH_END
            int nmove; { const int tot = (last ? 32 : 34) * 41 + (last ? 18 : 0) + 204, ex = tot % G; nmove = (tot > G && ex > 0 && ex <= 204 && 3 * ex <= G) ? ex : 0; }
            PH_BEGIN {
                pg8::InProjSched S1; S1.init(last, G, cid); const int U1 = S1.total();
                { pg8::Gemm g{wsp<bf16_t>(F, WS_H), wsp<bf16_t>(F, WS_WIN + (size_t)l * WIN_SZ)};
                  pg8::EpiProj<0> E{pc};
                  pg8::gemm_phase<pg8::EpiProj<0>, pg8::InProjSched, LDH, D>(ring, g, S1, E, F.wave); }
                { pg8::Gemm g{wsp<bf16_t>(F, WS_WVT + (size_t)l * WVT_SZ), wsp<bf16_t>(F, WS_H)};
                  pg8::SegSched S; S.init(U1, 6, 34, G, cid, 0, D / 64); S.lim = 204 - nmove;
                  pg8::EpiVT<0> E{wsp<bf16_t>(F, WS_VTIN), nullptr};
                  pg8::gemm_phase<pg8::EpiVT<0>, pg8::SegSched, D, LDH>(ring, g, S, E, F.wave); }
            } PH_END
#if PROBE_INPROJ
            PH_BEGIN {
                pg8::InProjSched S1; S1.init(last, G, cid); const int U1 = S1.total();
                { pg8::Gemm g{wsp<bf16_t>(F, WS_H), wsp<bf16_t>(F, WS_WIN + (size_t)l * WIN_SZ)};
                  pg8::ProjCtx pcp{F.ws, l, 1, F.lds}; pg8::EpiProj<0> E{pcp};
                  pg8::gemm_phase<pg8::EpiProj<0>, pg8::InProjSched, LDH, D>(ring, g, S1, E, F.wave); }
                { pg8::Gemm g{wsp<bf16_t>(F, WS_WVT + (size_t)l * WVT_SZ), wsp<bf16_t>(F, WS_H)};
                  pg8::SegSched S; S.init(U1, 6, 34, G, cid, 0, D / 64);
                  pg8::EpiVT<0> E{wsp<bf16_t>(F, WS_VTIN), nullptr};
                  pg8::gemm_phase<pg8::EpiVT<0>, pg8::SegSched, D, LDH>(ring, g, S, E, F.wave); }
            } PH_END
#endif
            PH_BEGIN {
                constexpr int U1 = 34 * 4, U2 = U1 + 34 * 3;
                const int GS = G - nmove; const bool small = cid < GS;
                { pg8::Gemm g{wsp<bf16_t>(F, WS_WVT + (size_t)l * WVT_SZ), wsp<bf16_t>(F, WS_H)};
                  pg8::SegSched S; S.init(cid - (204 - nmove + cid - GS), 6, 34, G, cid, 0, D / 64); if (small) S.lim = 0;
                  pg8::EpiVT<0> E{wsp<bf16_t>(F, WS_VTIN), nullptr};
                  pg8::gemm_phase<pg8::EpiVT<0>, pg8::SegSched, D, LDH>(ring, g, S, E, F.wave); }
                { pg8::Gemm g{wsp<bf16_t>(F, WS_CQ), wsp<bf16_t>(F, WS_WUQ + (size_t)l * WUQ_SZ)};
                  pg8::SegSched S; S.init(0, 34, 4, GS, cid, 0, 12); if (!small) S.lim = 0;
                  pg8::EpiProj<1> E{pc};
                  pg8::gemm_phase<pg8::EpiProj<1>, pg8::SegSched, 768, 768>(ring, g, S, E, F.wave); }
                { pg8::Gemm g{wsp<bf16_t>(F, WS_CKV), wsp<bf16_t>(F, WS_WUK + (size_t)l * WUK_SZ)};
                  pg8::SegSched S; S.init(U1, 34, 3, GS, cid, 0, 8); if (!small) S.lim = 0;
                  pg8::EpiProj<2> E{pc};
                  pg8::gemm_phase<pg8::EpiProj<2>, pg8::SegSched, 512, 512>(ring, g, S, E, F.wave); }
                { pg8::Gemm g{wsp<bf16_t>(F, WS_WUV + (size_t)l * WUK_SZ), wsp<bf16_t>(F, WS_CKV)};
                  pg8::SegSched S; S.init(nmove == 0 ? U1 : U2, 3, 34, GS, cid, 0, 8); if (!small) S.lim = 0;
                  pg8::EpiVT<1> E{wsp<bf16_t>(F, WS_VTM), wsp<float>(F, WS_SSQ) + (size_t)(2 * l + 1) * M};
                  pg8::gemm_phase<pg8::EpiVT<1>, pg8::SegSched, 512, 512>(ring, g, S, E, F.wave); }
            } PH_END
#if PROBE_MLAUP
            PH_BEGIN {
                constexpr int U1 = 34 * 4, U2 = U1 + 34 * 3;
                { pg8::Gemm g{wsp<bf16_t>(F, WS_CQ), wsp<bf16_t>(F, WS_WUQ + (size_t)l * WUQ_SZ)};
                  pg8::SegSched S; S.init(0, 34, 4, G, cid, 0, 12);
                  pg8::EpiProj<1> E{pc};
                  pg8::gemm_phase<pg8::EpiProj<1>, pg8::SegSched, 768, 768>(ring, g, S, E, F.wave); }
                { pg8::Gemm g{wsp<bf16_t>(F, WS_CKV), wsp<bf16_t>(F, WS_WUK + (size_t)l * WUK_SZ)};
                  pg8::SegSched S; S.init(U1, 34, 3, G, cid, 0, 8);
                  pg8::EpiProj<2> E{pc};
                  pg8::gemm_phase<pg8::EpiProj<2>, pg8::SegSched, 512, 512>(ring, g, S, E, F.wave); }
                { pg8::Gemm g{wsp<bf16_t>(F, WS_WUV + (size_t)l * WUK_SZ), wsp<bf16_t>(F, WS_CKV)};
                  pg8::SegSched S; S.init(U2, 3, 34, G, cid, 0, 8);
                  pg8::EpiVT<1> E{wsp<bf16_t>(F, WS_VTM), wsp<float>(F, WS_SSQ) + (size_t)(2 * l + 1) * M};
                  pg8::gemm_phase<pg8::EpiVT<1>, pg8::SegSched, 512, 512>(ring, g, S, E, F.wave); }
            } PH_END
#endif
#define MAKE_ACTX() \
                const float lambda_init = (l == 0) ? 0.2f : 0.35550907f;        \
                const float* dl = args.in[I_DLAM] + (size_t)l * 256; \
                const int ln = (tid_of(F.wave) & 63); \
                const float s01 = wave_sum(dl[ln] * dl[64 + ln]), s23 = wave_sum(dl[128 + ln] * dl[192 + ln]); \
                AttnCtx A{wsp<bf16_t>(F, WS_NAQ), wsp<bf16_t>(F, WS_NAK), wsp<bf16_t>(F, WS_DQ), wsp<bf16_t>(F, WS_DK), wsp<bf16_t>(F, WS_MQ), wsp<bf16_t>(F, WS_MK), \
                          wsp<bf16_t>(F, WS_VTIN), wsp<bf16_t>(F, WS_VTM), wsp<bf16_t>(F, WS_OMIX), args.in[I_RPB] + (size_t)l * 6 * 15 * 31, args.in[I_SUBLN] + (size_t)l * 128, \
                          expf(s01) - expf(s23) + lambda_init, 1.0f - lambda_init};
#if ATTN_NAIVE
            PH_BEGIN { MAKE_ACTX() attn_naive_phase(F, A, !last); } PH_END
#else
            PH_BEGIN { MAKE_ACTX()
                       if (!last) zero_ctx_y_rows(F);
                       for (int it = ((cid >> 3) < WCV_CONV) ? 0 : 1; it < 2; ++it) {
                           if (it == 1) attn_mfma_phase(F, A, !last, F.ctl + CW_AQ + 512 * l);
                           for (int q = (l == 0 ? 0 : 1); q < 2; ++q)
                               convert_fill(F, args, q, q == 0 ? 1 : l, F.ctl + CW_WCV + (q == 0 ? 1536 : 512 * l), 0, q == 0 ? wcv::NH1 : (l == 0 ? wcv::NH0 : wcv::NH1 - wcv::I_FO)); } } PH_END
#if PROBE_ATTN
            PH_BEGIN { MAKE_ACTX() attn_mfma_phase(F, A, !last, F.ctl + CW_AQ + 512 * (l + 2), PROBE_ATTN); } PH_END
#endif
#endif
#undef MAKE_ACTX
            PH_BEGIN {
                pg8::Gemm g{wsp<bf16_t>(F, WS_OMIX), wsp<bf16_t>(F, WS_WBR + (size_t)l * WSQ_SZ)};
                pg8::MergeSched S; S.init(G, cid, nM_o == 34);
                pg8::EpiMerge E{F.ws};
                pg8::gemm_phase<pg8::EpiMerge, pg8::MergeSched, D, D>(ring, g, S, E, F.wave);
            } PH_END
            PH_BEGIN {
                pg8::Gemm g{wsp<bf16_t>(F, WS_Y), wsp<bf16_t>(F, WS_WO + (size_t)l * WSQ_SZ)};
                pg8::ResidSched<8, 256> S; S.init(D / 256, G, cid, D / 64, nM_o == 34);
                pg8::EpiResidNorm E{F.ws, modl + 5 * D, args.in[I_NORMW] + (size_t)(l * 3 + 2) * D, modl + 6 * D, nullptr, nullptr, 1.0f, 3 * l + 1};
                pg8::gemm_phase<pg8::EpiResidNorm, pg8::ResidSched<8, 256>, D, D>(ring, g, S, E, F.wave);
            } PH_END
        }
    }
#if PROBE_BAR
    for (int pb = 0; pb < 32; ++pb) { PH_BEGIN PH_END }
#endif
#undef PH_BEGIN
#undef PH_END
}
constexpr int N_PHASES = 1 + 2 * DEPTH * 3 + DEPTH * 6 + 1;

extern "C" void kernel_launch(void* const* d_in, const int* in_sizes, int n_in, void* d_out, int out_size, void* d_ws, size_t ws_size, hipStream_t stream) {
    static int grid = 0;
    if (grid == 0) {
        if (n_in != 20 || in_sizes[0] != ML * D || out_size != ML * D || ws_size < WS_END) { fprintf(stderr, "kernel_launch: unexpected shapes (n_in %d, in0 %d, out %d, ws %zu < %zu); nothing launched\n", n_in, n_in > 0 ? in_sizes[0] : -1, out_size, ws_size, (size_t)WS_END); grid = -1; return; }
        int dev = 0, cus = 0, per_cu = 0;
        if (hipGetDevice(&dev) != hipSuccess || hipDeviceGetAttribute(&cus, hipDeviceAttributeMultiprocessorCount, dev) != hipSuccess) { grid = -1; return; }
        if (hipFuncSetAttribute((const void*)dit_fwd, hipFuncAttributeMaxDynamicSharedMemorySize, LDS_BYTES) != hipSuccess) { fprintf(stderr, "kernel_launch: hipFuncSetAttribute failed\n"); grid = -1; return; }
        if (hipOccupancyMaxActiveBlocksPerMultiprocessor(&per_cu, (const void*)dit_fwd, NTHREADS, LDS_BYTES) != hipSuccess || per_cu < 1)
            fprintf(stderr, "kernel_launch: note: occupancy query reports %d workgroups per CU\n", per_cu);
        (void)hipGetLastError();
        grid = cus;
    }
    if (grid < 0) return;
    if (hipMemsetAsync((char*)d_ws + WS_CTL, 0, CTL_ZERO_BYTES, stream) != hipSuccess) { fprintf(stderr, "kernel_launch: hipMemsetAsync failed\n"); return; }
    Args a{};
    for (int i = 0; i < 20; ++i) a.in[i] = (const float*)d_in[i];
    a.out = (float*)d_out; a.ws = (unsigned char*)d_ws;
#if MK_SPLIT
    for (int p = 0; p < N_PHASES; ++p) { a.ph_lo = p; a.ph_hi = p + 1; hipLaunchKernelGGL(dit_fwd, dim3(grid), dim3(NTHREADS), LDS_BYTES, stream, a); }
#else
    a.ph_lo = 0; a.ph_hi = 1 << 20;
    hipLaunchKernelGGL(dit_fwd, dim3(grid), dim3(NTHREADS), LDS_BYTES, stream, a);
    const hipError_t le = hipPeekAtLastError();
    if (le != hipSuccess) fprintf(stderr, "kernel_launch: launch failed: %s\n", hipGetErrorName(le));
#endif
}
```
